# Optimizing an MI355X kernel written in HIP

```python
import math
import jax, jax.numpy as jnp
from jax import lax
import numpy as np

D_MODEL = 1024
BATCH = 8
SEQ = 4096
DEPTH = 1

HEAD_DIM = 64
N_HEADS = D_MODEL // HEAD_DIM
N_HEADS_A = N_HEADS // 2
N_HEADS_B = N_HEADS - N_HEADS_A
WIDTH_A = N_HEADS_A * HEAD_DIM
WIDTH_B = N_HEADS_B * HEAD_DIM
DILATED_PAIRS = ((128, 1), (512, 4), (2048, 16))
MOBA_BLOCK = 256
MOBA_TOPK = 3
MOBA_QUERY_CHUNK = 16
D_FF = 4 * D_MODEL
PLE_DIM = 256
EPS = 1e-6

kernel_name = 'hybrid_dilated_moba_block'


def alibi_slopes(n):
    return jnp.asarray(np.array([2.0 ** (-8.0 * (i + 1) / n) for i in range(n)], dtype=np.float32))


def rmsnorm(x, g):
    xf = x.astype(jnp.float32)
    y = xf * lax.rsqrt(jnp.mean(xf * xf, axis=-1, keepdims=True) + EPS)
    return (y * g.astype(jnp.float32)).astype(x.dtype)


def dilated_branch(q, k, v, slopes, window, dilation):
    b, h, s, hd = q.shape
    nk = window // dilation
    c = nk
    span = dilation * c
    s_pad = -(-s // span) * span
    L = s_pad // dilation
    nc = L // c

    def to_sub(t):
        t = jnp.pad(t, ((0, 0), (0, 0), (0, s_pad - s), (0, 0))).reshape(b, h, L, dilation, hd)
        return jnp.swapaxes(t, 2, 3).reshape(b, h, dilation, nc, c, hd)

    def with_prev(t):
        prev = jnp.pad(t[:, :, :, :-1], ((0, 0), (0, 0), (0, 0), (1, 0), (0, 0), (0, 0)))
        return jnp.concatenate([prev, t], axis=4)

    qs, ks, vs = to_sub(q), to_sub(k), to_sub(v)
    kk, vv = with_prev(ks), with_prev(vs)
    scores = jnp.einsum('bhrnqd,bhrnkd->bhrnqk', qs, kk,
                        preferred_element_type=jnp.float32) * (hd ** -0.5)
    qi = jnp.arange(c)[:, None]
    ki = jnp.arange(2 * c)[None, :]
    m = c + qi - ki
    key_sub = jnp.arange(nc)[:, None, None] * c + ki[None] - c
    valid = (m >= 0) & (m <= nk) & (key_sub >= 0)
    bias = -slopes[None, :, None, None, None, None] * (m * dilation).astype(jnp.float32)
    scores = jnp.where(valid, scores + bias, -jnp.inf)
    lse = jax.nn.logsumexp(scores, axis=-1)
    probs = jnp.exp(scores - lse[..., None])
    out = jnp.einsum('bhrnqk,bhrnkd->bhrnqd', probs, vv, preferred_element_type=jnp.float32)

    def from_sub(t):
        rest = t.shape[5:]
        t = jnp.swapaxes(t.reshape((b, h, dilation, L) + rest), 2, 3)
        return t.reshape((b, h, s_pad) + rest)[:, :, :s]

    return from_sub(out), from_sub(lse)


def dilated_mixture(q, k, v, slopes):
    outs, lses = [], []
    for window, dilation in DILATED_PAIRS:
        o, l = dilated_branch(q, k, v, slopes, window, dilation)
        outs.append(o)
        lses.append(l)
    w = jax.nn.softmax(jnp.stack(lses, 0), axis=0)
    return jnp.sum(w[..., None] * jnp.stack(outs, 0), axis=0)


def moba_attention(q, k, v, slopes):
    b, h, s, hd = q.shape
    bs = MOBA_BLOCK
    s_pad = -(-s // bs) * bs
    nblk = s_pad // bs
    pad = ((0, 0), (0, 0), (0, s_pad - s), (0, 0))
    q, k, v = jnp.pad(q, pad), jnp.pad(k, pad), jnp.pad(v, pad)
    kb = k.reshape(b, h, nblk, bs, hd)
    vb = v.reshape(b, h, nblk, bs, hd)
    kmean = jnp.mean(kb.astype(jnp.float32), axis=3)
    pos = jnp.arange(s_pad)
    own = pos // bs
    gate = jnp.einsum('bhsd,bhnd->bhsn', q.astype(jnp.float32), kmean)
    past = jnp.arange(nblk)[None, :] < own[:, None]
    gate = jnp.where(past, gate, -jnp.inf)
    ksel = min(MOBA_TOPK, nblk)
    _, top_idx = lax.top_k(gate, ksel)
    top_valid = top_idx < own[:, None]
    own_b = jnp.broadcast_to(own[None, None, :, None], (b, h, s_pad, 1)).astype(top_idx.dtype)
    sel = jnp.concatenate([top_idx, own_b], axis=-1)
    sel_valid = jnp.concatenate([top_valid, jnp.ones((b, h, s_pad, 1), dtype=bool)], axis=-1)
    nsel = ksel + 1
    qc = MOBA_QUERY_CHUNK
    nq = s_pad // qc
    scale = hd ** -0.5
    bi = jnp.arange(b)[:, None, None, None]
    hi = jnp.arange(h)[None, :, None, None]

    def chunkify(t):
        t = t.reshape((b, h, nq, qc) + t.shape[3:])
        return jnp.moveaxis(t, 2, 0)

    def step(args):
        q_c, sel_c, val_c, pos_c = args
        kg = kb[bi, hi, sel_c]
        vg = vb[bi, hi, sel_c]
        sc = jnp.einsum('bhqd,bhqjkd->bhqjk', q_c, kg,
                        preferred_element_type=jnp.float32) * scale
        key_pos = sel_c[..., None] * bs + jnp.arange(bs)
        dist = pos_c[None, None, :, None, None] - key_pos
        mask = val_c[..., None] & (dist >= 0)
        sc = jnp.where(mask, sc - slopes[None, :, None, None, None] * dist.astype(jnp.float32), -jnp.inf)
        pr = jax.nn.softmax(sc.reshape(b, h, qc, nsel * bs), axis=-1).reshape(b, h, qc, nsel, bs)
        return jnp.einsum('bhqjk,bhqjkd->bhqd', pr, vg, preferred_element_type=jnp.float32)

    out = lax.map(step, (chunkify(q), chunkify(sel), chunkify(sel_valid), pos.reshape(nq, qc)))
    out = jnp.moveaxis(out, 0, 2).reshape(b, h, s_pad, hd)
    return out[:, :, :s]


def split_heads(t, nh):
    b, s, _ = t.shape
    t = t.reshape(b, s, 3, nh, HEAD_DIM).transpose(2, 0, 3, 1, 4)
    return t[0], t[1], t[2]


def merge_heads(t):
    b, h, s, hd = t.shape
    return t.transpose(0, 2, 1, 3).reshape(b, s, h * hd)


def setup_inputs(seed: int = 0) -> dict:
    key = jax.random.key(seed)
    ks = jax.random.split(key, 16)
    f32 = jnp.float32

    def nrm(k, shape, fan_in):
        return jax.random.normal(k, shape, f32) * fan_in ** -0.5

    def gain(k, shape):
        return 1.0 + 0.02 * jax.random.normal(k, shape, f32)

    return {
        'x': jax.random.normal(ks[0], (BATCH, SEQ, D_MODEL), f32),
        'p': jax.random.normal(ks[1], (DEPTH, BATCH, SEQ, PLE_DIM), f32),
        'g_attn': gain(ks[2], (DEPTH, D_MODEL)),
        'w_in': nrm(ks[3], (DEPTH, D_MODEL, 3 * D_MODEL), D_MODEL),
        'g_out_a': gain(ks[4], (DEPTH, WIDTH_A)),
        'g_out_b': gain(ks[5], (DEPTH, WIDTH_B)),
        'w_out': nrm(ks[6], (DEPTH, D_MODEL, D_MODEL), D_MODEL),
        'g_mlp': gain(ks[7], (DEPTH, D_MODEL)),
        'w_up': nrm(ks[8], (DEPTH, D_MODEL, D_FF), D_MODEL),
        'w_down': nrm(ks[9], (DEPTH, D_FF, D_MODEL), D_FF),
        'g_ple': gain(ks[10], (DEPTH, D_MODEL)),
        'w_ple_gate': nrm(ks[11], (DEPTH, D_MODEL, D_MODEL), D_MODEL),
        'b_ple_gate': 0.02 * jax.random.normal(ks[12], (DEPTH, D_MODEL), f32),
        'w_ple_proj': nrm(ks[13], (DEPTH, PLE_DIM, D_MODEL), PLE_DIM),
        'g_final': gain(ks[14], (D_MODEL,)),
    }


def reference(x, p, g_attn, w_in, g_out_a, g_out_b, w_out, g_mlp, w_up, w_down,
              g_ple, w_ple_gate, b_ple_gate, w_ple_proj, g_final):
    slopes = alibi_slopes(N_HEADS)
    slopes_a = slopes[0::2]
    slopes_b = slopes[1::2]
    h = x
    for i in range(DEPTH):
        hn = rmsnorm(h, g_attn[i])
        qkv = hn @ w_in[i]
        qa, ka, va = split_heads(qkv[..., :3 * WIDTH_A], N_HEADS_A)
        qb, kb, vb = split_heads(qkv[..., 3 * WIDTH_A:], N_HEADS_B)
        ya = rmsnorm(merge_heads(dilated_mixture(qa, ka, va, slopes_a)), g_out_a[i])
        yb = rmsnorm(merge_heads(moba_attention(qb, kb, vb, slopes_b)), g_out_b[i])
        y = jnp.concatenate([ya, yb], axis=-1).astype(h.dtype) @ w_out[i]
        h = h + y
        hn = rmsnorm(h, g_mlp[i])
        h = h + jnp.square(jax.nn.relu(hn @ w_up[i])) @ w_down[i]
        gate = jax.nn.sigmoid(rmsnorm(h, g_ple[i]) @ w_ple_gate[i] + b_ple_gate[i])
        h = h + gate * (p[i] @ w_ple_proj[i])
    return rmsnorm(h, g_final)
```

```cpp
#include <hip/hip_runtime.h>
#include <cstdio>
#include <cstdint>
namespace pg8 {
#define PG8_LAS __attribute__((address_space(3)))
typedef unsigned short bf16_t;
typedef short bf16x8 __attribute__((ext_vector_type(8)));
typedef float f32x4 __attribute__((ext_vector_type(4)));
typedef unsigned u32x4 __attribute__((ext_vector_type(4)));
constexpr int BM = 256, BK = 64, HALF = 128, HTB = HALF * BK * 2  , STAGE_BYTES = 8 * HTB, NXCD = 8, WGM = 8;

__host__ __device__ __forceinline__ int lds_byte(int r, int c) { const int st = (r >> 4) * 2 + (c >> 5), rr = r & 15, cc = c & 31, ob = rr * 64 + cc * 2; return st * 1024 + (ob ^ (((ob >> 9) & 1) << 5)); }
__host__ __device__ __forceinline__ void stage_rc(int b, int& R, int& C) { const int st = b / 1024, sb = b % 1024, swz = sb ^ (((sb >> 9) & 1) << 5); R = (st >> 1) * 16 + swz / 64; C = (st & 1) * 32 + (swz % 64) / 2; }
__host__ __device__ __forceinline__ int perm32(int rho) { const int n = rho >> 4, i = rho & 15; return 8 * (i >> 2) + 4 * n + (i & 3); }

struct Unit { int pm, pn; };
struct Gemm { const bf16_t* A; const bf16_t* Bt; int M, N, K; };

struct StaticOrder {
    int nM, nN, nwg, G, c;
    __host__ __device__ void init(int M, int N, int G_, int c_) { nM = M / BM; nN = N / BM; nwg = nM * nN; G = G_; c = c_; }
    __host__ __device__ bool next(int i, Unit& u) const {
        const long L = (long)i * G + c; if (L >= nwg) return false;
        int wgid = (int)L; { const int q = nwg / NXCD, r = nwg % NXCD, xcd = wgid % NXCD, off = wgid / NXCD; wgid = (xcd < r ? xcd * (q + 1) : r * (q + 1) + (xcd - r) * q) + off; }
        const int nig = WGM * nN, gid = wgid / nig, fm = gid * WGM, gsz = (nM - fm) < WGM ? (nM - fm) : WGM;
        u.pm = fm + ((wgid % nig) % gsz); u.pn = (wgid % nig) / gsz; return true;
    }
    __device__ __forceinline__ void a_ready(const Unit&) const {}
    __device__ __forceinline__ void done(const Unit&) const {}
};

__device__ __forceinline__ unsigned cvt_pk_bf16(float lo, float hi) { unsigned r; asm volatile("v_cvt_pk_bf16_f32 %0, %1, %2" : "=v"(r) : "v"(lo), "v"(hi)); return r; }
typedef unsigned u32x2 __attribute__((ext_vector_type(2)));
constexpr float RMS_EPS = 1e-6f;
__device__ __forceinline__ float sum4(f32x4 v) { return (v[0] + v[1]) + (v[2] + v[3]); }

struct EpiBf16Plain {
    static constexpr bool PERM = true, AFTER_DRAIN = false, MID = false, TABLE = false;
    bf16_t* O; int ldc;
    __device__ __forceinline__ void operator()(f32x4 (&acc)[2][2][4][2], const Unit& u, int wr, int wc, int fr, int fq, PG8_LAS float*, int) const {
        const int row0 = u.pm * BM + wr * 64 + fr, col0 = u.pn * BM + wc * 32 + 8 * fq;
#pragma unroll
        for (int ai = 0; ai < 2; ++ai)
#pragma unroll
            for (int m = 0; m < 4; ++m) { bf16_t* rowp = O + (size_t)(row0 + ai * HALF + m * 16) * ldc + col0;
#pragma unroll
                for (int bj = 0; bj < 2; ++bj) { const f32x4 v0 = acc[ai][bj][m][0], v1 = acc[ai][bj][m][1];
                    u32x4 w; w.x = cvt_pk_bf16(v0[0], v0[1]); w.y = cvt_pk_bf16(v0[2], v0[3]); w.z = cvt_pk_bf16(v1[0], v1[1]); w.w = cvt_pk_bf16(v1[2], v1[3]);
                    *(u32x4*)(rowp + bj * HALF) = w; } }
    }
};

struct EpiQKV {
    static constexpr bool PERM = true, AFTER_DRAIN = false, MID = false, TABLE = false;
    bf16_t* Q; size_t part_stride; float* kpart; float qscale;
    __device__ __forceinline__ void operator()(f32x4 (&acc)[2][2][4][2], const Unit& u, int wr, int wc, int fr, int fq, PG8_LAS float*, int) const {
        const int part = u.pn >> 2, pc = u.pn & 3; const bool ga = pc < 2;
        bf16_t* base = Q + (size_t)part * part_stride; const float sc = part == 0 ? qscale : 1.0f;
        const int row0 = u.pm * BM + wr * 64 + fr, col0 = pc * BM + wc * 32 + 8 * fq;
#pragma unroll
        for (int ai = 0; ai < 2; ++ai)
#pragma unroll
            for (int m = 0; m < 4; ++m) { const int row = row0 + ai * HALF + m * 16;
                const int rowd = ga ? ((row & ~4095) | ((row & 3) << 10) | ((row & 4095) >> 2)) : row;
                bf16_t* rowp = base + (size_t)rowd * 1024 + col0;
#pragma unroll
                for (int bj = 0; bj < 2; ++bj) { const f32x4 v0 = acc[ai][bj][m][0] * sc, v1 = acc[ai][bj][m][1] * sc;
                    u32x4 w; w.x = cvt_pk_bf16(v0[0], v0[1]); w.y = cvt_pk_bf16(v0[2], v0[3]); w.z = cvt_pk_bf16(v1[0], v1[1]); w.w = cvt_pk_bf16(v1[2], v1[3]);
                    *(u32x4*)(rowp + bj * HALF) = w; } }
        if (part == 1 && !ga) {
#pragma unroll
            for (int bj = 0; bj < 2; ++bj) {
                f32x4 s0 = acc[0][bj][0][0], s1 = acc[0][bj][0][1];
#pragma unroll
                for (int ai = 0; ai < 2; ++ai)
#pragma unroll
                    for (int m = 0; m < 4; ++m) if (ai + m) { s0 += acc[ai][bj][m][0]; s1 += acc[ai][bj][m][1]; }
#pragma unroll
                for (int e = 0; e < 4; ++e) {
#pragma unroll
                    for (int o = 1; o < 16; o <<= 1) { s0[e] += __shfl_xor(s0[e], o); s1[e] += __shfl_xor(s1[e], o); } }
                if (fr == 0) { float* kp = kpart + (size_t)(u.pm * 2 + wr) * 512 + (pc - 2) * BM + bj * HALF + wc * 32 + 8 * fq;
                    *(f32x4*)kp = s0; *(f32x4*)(kp + 4) = s1; }
            }
        }
    }
};

template <int KIND> __device__ __forceinline__ void fill_rowscale(const float* ssq, const Unit& u, int par, PG8_LAS float* tab, int tid) {
    if (tid < 256) {
        const f32x4* p = (const f32x4*)(ssq + (size_t)(u.pm * BM + tid) * 16);
        const f32x4 a0 = p[0], a1 = p[1], b0 = p[2], b1 = p[3];
        const float sa = sum4(a0) + sum4(a1), sb = sum4(b0) + sum4(b1);
        if (KIND == 1) { tab[par * 512 + 2 * tid] = 1.0f / sqrtf((sa + sb) * (1.0f / 1024.0f) + RMS_EPS); }
        else { const float ra = 1.0f / sqrtf(sa * (1.0f / 512.0f) + RMS_EPS), rb = 1.0f / sqrtf(sb * (1.0f / 512.0f) + RMS_EPS);
            tab[par * 512 + 2 * tid] = ra / rb; tab[par * 512 + 2 * tid + 1] = rb; }
    }
}

struct EpiUp {
    static constexpr bool PERM = true, AFTER_DRAIN = false, MID = false, TABLE = true;
    bf16_t* O; int ldc; const float* ssq;
    __device__ __forceinline__ void fill(const Unit& u, int par, PG8_LAS float* tab, int tid) const { fill_rowscale<1>(ssq, u, par, tab, tid); }
    __device__ __forceinline__ void operator()(f32x4 (&acc)[2][2][4][2], const Unit& u, int wr, int wc, int fr, int fq, PG8_LAS float* tab, int par) const {
        const int row0 = u.pm * BM + wr * 64 + fr, col0 = u.pn * BM + wc * 32 + 8 * fq;
#pragma unroll
        for (int ai = 0; ai < 2; ++ai)
#pragma unroll
            for (int m = 0; m < 4; ++m) { const int r = ai * HALF + wr * 64 + m * 16 + fr; const float rs = tab[par * 512 + 2 * r];
                bf16_t* rowp = O + (size_t)(row0 + ai * HALF + m * 16) * ldc + col0;
#pragma unroll
                for (int bj = 0; bj < 2; ++bj) { f32x4 v0 = acc[ai][bj][m][0] * rs, v1 = acc[ai][bj][m][1] * rs;
#pragma unroll
                    for (int e = 0; e < 4; ++e) { const float a = fmaxf(v0[e], 0.f), b = fmaxf(v1[e], 0.f); v0[e] = a * a; v1[e] = b * b; }
                    u32x4 w; w.x = cvt_pk_bf16(v0[0], v0[1]); w.y = cvt_pk_bf16(v0[2], v0[3]); w.z = cvt_pk_bf16(v1[0], v1[1]); w.w = cvt_pk_bf16(v1[2], v1[3]);
                    *(u32x4*)(rowp + bj * HALF) = w; } }
    }
};

template <int KIND> struct EpiRes {
    static constexpr bool PERM = false, AFTER_DRAIN = false, MID = (KIND == 1), TABLE = (KIND == 1);
    const float* res; float* out; bf16_t* outb; float* ssq_out; const float* ssq_in;
    __device__ __forceinline__ void fill(const Unit& u, int par, PG8_LAS float* tab, int tid) const { fill_rowscale<2>(ssq_in, u, par, tab, tid); }
    __device__ __forceinline__ void mid(f32x4 (&acc)[2][2][4][2], int wr, int fr, PG8_LAS float* tab, int par) const {
#pragma unroll
        for (int ai = 0; ai < 2; ++ai)
#pragma unroll
            for (int m = 0; m < 4; ++m) { const float f = tab[par * 512 + 2 * (ai * HALF + wr * 64 + m * 16 + fr)];
#pragma unroll
                for (int bj = 0; bj < 2; ++bj)
#pragma unroll
                    for (int n = 0; n < 2; ++n) acc[ai][bj][m][n] *= f; }
    }
    __device__ __forceinline__ void operator()(f32x4 (&acc)[2][2][4][2], const Unit& u, int wr, int wc, int fr, int fq, PG8_LAS float* tab, int par) const {
        const int col0 = u.pn * BM + wc * 32 + 4 * fq;
#pragma unroll
        for (int ai = 0; ai < 2; ++ai)
#pragma unroll
            for (int m = 0; m < 4; ++m) { const int r = ai * HALF + wr * 64 + m * 16 + fr; const int rowg = u.pm * BM + r;
                const float rb = (KIND == 1) ? tab[par * 512 + 2 * r + 1] : 1.0f;
                const size_t off = (size_t)rowg * 1024 + col0; float ss = 0.f;
#pragma unroll
                for (int bj = 0; bj < 2; ++bj)
#pragma unroll
                    for (int n = 0; n < 2; ++n) { const size_t o = off + bj * HALF + n * 16; const f32x4 rs = *(const f32x4*)(res + o);
                        const f32x4 v = rs + acc[ai][bj][m][n] * rb; *(f32x4*)(out + o) = v;
                        u32x2 w; w.x = cvt_pk_bf16(v[0], v[1]); w.y = cvt_pk_bf16(v[2], v[3]); *(u32x2*)(outb + o) = w;
                        ss += (v[0] * v[0] + v[1] * v[1]) + (v[2] * v[2] + v[3] * v[3]); }
                ss += __shfl_xor(ss, 16); ss += __shfl_xor(ss, 32);
                if (fq == 0) ssq_out[(size_t)rowg * 16 + u.pn * 4 + wc] = ss;
                if (m & 1) asm volatile("" ::: "memory"); }
    }
};

struct EpiGate {
    static constexpr bool PERM = false, AFTER_DRAIN = false, MID = false, TABLE = true;
    const float* res; float* out; const bf16_t* pp; const float* bias; float* ssq_out; const float* ssq_in;
    __device__ __forceinline__ void fill(const Unit& u, int par, PG8_LAS float* tab, int tid) const { fill_rowscale<1>(ssq_in, u, par, tab, tid); }
    __device__ __forceinline__ void operator()(f32x4 (&acc)[2][2][4][2], const Unit& u, int wr, int wc, int fr, int fq, PG8_LAS float* tab, int par) const {
        const int col0 = u.pn * BM + wc * 32 + 4 * fq;
        f32x4 bv[2][2];
#pragma unroll
        for (int bj = 0; bj < 2; ++bj)
#pragma unroll
            for (int n = 0; n < 2; ++n) bv[bj][n] = *(const f32x4*)(bias + col0 + bj * HALF + n * 16);
#pragma unroll
        for (int ai = 0; ai < 2; ++ai)
#pragma unroll
            for (int m = 0; m < 4; ++m) { const int r = ai * HALF + wr * 64 + m * 16 + fr; const int rowg = u.pm * BM + r;
                const float rs = tab[par * 512 + 2 * r];
                const size_t off = (size_t)rowg * 1024 + col0; float ss = 0.f;
#pragma unroll
                for (int bj = 0; bj < 2; ++bj)
#pragma unroll
                    for (int n = 0; n < 2; ++n) { const size_t o = off + bj * HALF + n * 16; const f32x4 h = *(const f32x4*)(res + o); const u32x2 pw = *(const u32x2*)(pp + o);
                        const f32x4 z = acc[ai][bj][m][n] * rs + bv[bj][n]; f32x4 v;
                        const float p0 = __uint_as_float(pw.x << 16), p1 = __uint_as_float(pw.x & 0xffff0000u), p2 = __uint_as_float(pw.y << 16), p3 = __uint_as_float(pw.y & 0xffff0000u);
                        v[0] = h[0] + __builtin_amdgcn_rcpf(1.0f + __builtin_amdgcn_exp2f(-1.4426950408889634f * z[0])) * p0;
                        v[1] = h[1] + __builtin_amdgcn_rcpf(1.0f + __builtin_amdgcn_exp2f(-1.4426950408889634f * z[1])) * p1;
                        v[2] = h[2] + __builtin_amdgcn_rcpf(1.0f + __builtin_amdgcn_exp2f(-1.4426950408889634f * z[2])) * p2;
                        v[3] = h[3] + __builtin_amdgcn_rcpf(1.0f + __builtin_amdgcn_exp2f(-1.4426950408889634f * z[3])) * p3;
                        *(f32x4*)(out + o) = v;
                        ss += (v[0] * v[0] + v[1] * v[1]) + (v[2] * v[2] + v[3] * v[3]); }
                ss += __shfl_xor(ss, 16); ss += __shfl_xor(ss, 32);
                if (fq == 0) ssq_out[(size_t)rowg * 16 + u.pn * 4 + wc] = ss;
                if (m & 1) asm volatile("" ::: "memory"); }
    }
};

template <class Epi, class Sched, bool ALIGN_EPI = false, bool SP2 = false>
__device__ __forceinline__ void gemm_phase(PG8_LAS unsigned char* lds, PG8_LAS float* tab, const Gemm g, const Sched& S, const Epi& E) {
    const int tid = threadIdx.x, wid = __builtin_amdgcn_readfirstlane(tid >> 6), lane = tid & 63, wr = wid >> 2, wc = wid & 3, fr = lane & 15, fq = lane >> 4;
    const int K = g.K, nt = K / BK;
    unsigned voffA[2], voffB[2];
#pragma unroll
    for (int i = 0; i < 2; ++i) { int R, C; stage_rc(tid * 16 + i * 8192, R, C); const int Rb = Epi::PERM ? ((R & ~31) + perm32(R & 31)) : R;
        voffA[i] = (unsigned)(R * K + C) * 2u; voffB[i] = (unsigned)(Rb * K + C) * 2u; }
    const size_t kstep = (size_t)(BK * 2);
    const size_t hstep = (size_t)HALF * K * 2;
    const size_t tstep = 2 * hstep;
    const unsigned ldsw = (unsigned)wid * 1024u;
    const int aoff = lds_byte(wr * 64 + fr, fq * 8), boff = lds_byte(wc * 32 + fr, fq * 8);
#define PG8_SA(b, h) (((b) * 2 + (h)) * HTB)
#define PG8_SB(b, h) ((4 + (b) * 2 + (h)) * HTB)
#define PG8_STAGE(bufoff, gbase, voff) do { _Pragma("unroll") for (int _i = 0; _i < 2; ++_i) \
        __builtin_amdgcn_global_load_lds((const unsigned*)((const char*)(gbase) + (voff)[_i]), (PG8_LAS unsigned*)(lds + (bufoff) + ldsw + _i * 8192), 16, 0, 0); } while (0)
#define PG8_LDA(dst, b, h) do { _Pragma("unroll") for (int m = 0; m < 4; ++m) _Pragma("unroll") for (int k = 0; k < 2; ++k) dst[m][k] = *(const PG8_LAS bf16x8*)(lds + PG8_SA(b, h) + aoff + m * 2048 + k * 1024); } while (0)
#define PG8_LDB(dst, b, h) do { _Pragma("unroll") for (int n = 0; n < 2; ++n) _Pragma("unroll") for (int k = 0; k < 2; ++k) dst[n][k] = *(const PG8_LAS bf16x8*)(lds + PG8_SB(b, h) + boff + n * 2048 + k * 1024); } while (0)
#define PG8_MMA(ai, bj, At, Bt) do { __builtin_amdgcn_s_setprio(1); _Pragma("unroll") for (int m = 0; m < 4; ++m) _Pragma("unroll") for (int n = 0; n < 2; ++n) _Pragma("unroll") for (int k = 0; k < 2; ++k) \
        acc[ai][bj][m][n] = __builtin_amdgcn_mfma_f32_16x16x32_bf16(Bt[n][k], At[m][k], acc[ai][bj][m][n], 0, 0, 0); __builtin_amdgcn_s_setprio(0); } while (0)
#define PG8_WAIT_V(n) asm volatile("s_waitcnt vmcnt(" #n ")" ::: "memory")
#define PG8_WAIT_L(n) asm volatile("s_waitcnt lgkmcnt(" #n ")" ::: "memory")
#define PG8_BAR __builtin_amdgcn_s_barrier()
#define PG8_SCHED __builtin_amdgcn_sched_barrier(0)
    Unit cur, nxt; int ui = 0;
    if (!S.next(0, cur)) return;
    if constexpr (Epi::TABLE) E.fill(cur, 0, tab, tid);
    f32x4 acc[2][2][4][2];
#pragma unroll
    for (int a = 0; a < 2; ++a)
#pragma unroll
        for (int b = 0; b < 2; ++b)
#pragma unroll
            for (int m = 0; m < 4; ++m)
#pragma unroll
                for (int n = 0; n < 2; ++n) acc[a][b][m][n] = (f32x4){0.f, 0.f, 0.f, 0.f};
    bf16x8 At[4][2], B0[2][2], B1[2][2];
    const char* cA = (const char*)g.A + (size_t)cur.pm * tstep; const char* cB = (const char*)g.Bt + (size_t)cur.pn * tstep;
    S.a_ready(cur);
    if constexpr (SP2) {
        PG8_STAGE(PG8_SB(0, 0), cB, voffB); PG8_STAGE(PG8_SB(0, 1), cB + hstep, voffB); PG8_STAGE(PG8_SA(0, 0), cA, voffA); PG8_STAGE(PG8_SA(0, 1), cA + hstep, voffA);
        if (wr == 1) PG8_BAR;
        PG8_WAIT_V(2); PG8_BAR;
        PG8_STAGE(PG8_SB(1, 0), cB + kstep, voffB); PG8_STAGE(PG8_SA(1, 0), cA + kstep, voffA); PG8_STAGE(PG8_SB(1, 1), cB + hstep + kstep, voffB);
        PG8_WAIT_V(6); PG8_BAR;
    } else {
        PG8_STAGE(PG8_SB(0, 0), cB, voffB); PG8_STAGE(PG8_SA(0, 0), cA, voffA); PG8_STAGE(PG8_SB(0, 1), cB + hstep, voffB); PG8_STAGE(PG8_SA(0, 1), cA + hstep, voffA);
        if (wr == 1) PG8_BAR;
        PG8_WAIT_V(4); PG8_BAR;
        PG8_STAGE(PG8_SB(1, 0), cB + kstep, voffB); PG8_STAGE(PG8_SA(1, 0), cA + kstep, voffA); PG8_STAGE(PG8_SB(1, 1), cB + hstep + kstep, voffB);
        PG8_WAIT_V(6); PG8_BAR;
    }
    for (;;) {
        const bool has_next = S.next(ui + 1, nxt);
        const char* nA = has_next ? (const char*)g.A + (size_t)nxt.pm * tstep : cA; const char* nB = has_next ? (const char*)g.Bt + (size_t)nxt.pn * tstep : cB;
        for (int t = 0; t < nt; t += 2) {
            const bool last = (t == nt - 2);
            if constexpr (Epi::MID) { if (t == (nt >> 1)) E.mid(acc, wr, fr, tab, ui & 1); }
            const char* a1 = cA + (size_t)(t + 1) * kstep;
            const char* a2 = last ? nA : cA + (size_t)(t + 2) * kstep; const char* b2 = last ? nB : cB + (size_t)(t + 2) * kstep;
            const char* a3 = a2 + kstep; const char* b3 = b2 + kstep;
            if (last && has_next) S.a_ready(nxt);
            if constexpr (SP2) {
            PG8_LDB(B0, 0, 0); PG8_LDB(B1, 0, 1); PG8_SCHED; PG8_LDA(At, 0, 0); PG8_STAGE(PG8_SA(1, 1), a1 + hstep, voffA);
            PG8_WAIT_V(8); PG8_WAIT_L(0); PG8_BAR; PG8_MMA(0, 0, At, B0); PG8_MMA(0, 1, At, B1); PG8_BAR; PG8_SCHED;
            PG8_LDA(At, 0, 1); PG8_STAGE(PG8_SB(0, 0), b2, voffB); PG8_STAGE(PG8_SB(0, 1), b2 + hstep, voffB); PG8_STAGE(PG8_SA(0, 0), a2, voffA);
            PG8_WAIT_V(8); PG8_WAIT_L(0); PG8_BAR; PG8_MMA(1, 0, At, B0); PG8_MMA(1, 1, At, B1); PG8_BAR; PG8_SCHED;
            PG8_LDB(B0, 1, 0); PG8_LDB(B1, 1, 1); PG8_SCHED; PG8_LDA(At, 1, 0); PG8_STAGE(PG8_SA(0, 1), a2 + hstep, voffA);
            PG8_WAIT_V(8); PG8_WAIT_L(0); PG8_BAR; PG8_MMA(0, 0, At, B0); PG8_MMA(0, 1, At, B1); PG8_BAR; PG8_SCHED;
            PG8_LDA(At, 1, 1); PG8_STAGE(PG8_SB(1, 0), b3, voffB); PG8_STAGE(PG8_SB(1, 1), b3 + hstep, voffB); PG8_STAGE(PG8_SA(1, 0), a3, voffA);
            PG8_WAIT_V(8); PG8_WAIT_L(0); PG8_BAR; PG8_MMA(1, 0, At, B0); PG8_MMA(1, 1, At, B1); PG8_BAR; PG8_SCHED;
            } else {
            PG8_LDB(B0, 0, 0); PG8_SCHED; PG8_LDA(At, 0, 0); PG8_STAGE(PG8_SA(1, 1), a1 + hstep, voffA);
            PG8_WAIT_L(8); PG8_BAR; PG8_WAIT_L(0); PG8_MMA(0, 0, At, B0); PG8_BAR; PG8_SCHED;
            PG8_LDB(B1, 0, 1); PG8_STAGE(PG8_SB(0, 0), b2, voffB);
            PG8_BAR; PG8_WAIT_L(0); PG8_MMA(0, 1, At, B1); PG8_BAR;
            PG8_LDA(At, 0, 1); PG8_STAGE(PG8_SA(0, 0), a2, voffA);
            PG8_BAR; PG8_WAIT_L(0); PG8_MMA(1, 0, At, B0); PG8_BAR; PG8_SCHED;
            PG8_STAGE(PG8_SB(0, 1), b2 + hstep, voffB);
            PG8_WAIT_V(6); PG8_BAR; PG8_MMA(1, 1, At, B1); PG8_BAR;
            PG8_LDB(B0, 1, 0); PG8_SCHED; PG8_LDA(At, 1, 0); PG8_STAGE(PG8_SA(0, 1), a2 + hstep, voffA);
            PG8_WAIT_L(8); PG8_BAR; PG8_WAIT_L(0); PG8_MMA(0, 0, At, B0); PG8_BAR; PG8_SCHED;
            PG8_LDB(B1, 1, 1); PG8_STAGE(PG8_SB(1, 0), b3, voffB);
            PG8_BAR; PG8_WAIT_L(0); PG8_MMA(0, 1, At, B1); PG8_BAR;
            PG8_LDA(At, 1, 1); PG8_STAGE(PG8_SA(1, 0), a3, voffA);
            PG8_BAR; PG8_WAIT_L(0); PG8_MMA(1, 0, At, B0); PG8_BAR; PG8_SCHED;
            PG8_STAGE(PG8_SB(1, 1), b3 + hstep, voffB);
            PG8_WAIT_V(6); PG8_BAR; PG8_MMA(1, 1, At, B1); PG8_BAR;
            }
        }
        if constexpr (ALIGN_EPI) { if (wr == 0) PG8_BAR; }
        if constexpr (!Epi::AFTER_DRAIN) { E(acc, cur, wr, wc, fr, fq, tab, ui & 1); S.done(cur); }
        if (!has_next) break;
#pragma unroll
        for (int a = 0; a < 2; ++a)
#pragma unroll
            for (int b = 0; b < 2; ++b)
#pragma unroll
                for (int m = 0; m < 4; ++m)
#pragma unroll
                    for (int n = 0; n < 2; ++n) acc[a][b][m][n] = (f32x4){0.f, 0.f, 0.f, 0.f};
        cur = nxt; cA = nA; cB = nB; ++ui;
        if constexpr (Epi::TABLE) E.fill(cur, ui & 1, tab, tid);
        if constexpr (ALIGN_EPI) { if (wr == 1) PG8_BAR; }
    }
    PG8_WAIT_V(0);
    if constexpr (!ALIGN_EPI) { if (wr == 0) PG8_BAR; }
    PG8_BAR;
    if constexpr (Epi::AFTER_DRAIN) { E.fused(acc, cur, wr, wc, fr, fq, lds, wid, lane); S.done(cur); }
#undef PG8_SA
#undef PG8_SB
#undef PG8_STAGE
#undef PG8_LDA
#undef PG8_LDB
#undef PG8_MMA
#undef PG8_WAIT_V
#undef PG8_WAIT_L
#undef PG8_BAR
#undef PG8_SCHED
}
}
#define GAS __attribute__((address_space(1)))
#define LAS __attribute__((address_space(3)))
typedef unsigned short bf16;
typedef unsigned v4u __attribute__((ext_vector_type(4)));
typedef float f32x4 __attribute__((ext_vector_type(4)));
typedef short bf16x8 __attribute__((ext_vector_type(8)));
typedef GAS unsigned gu32;
typedef GAS unsigned long long gu64;
#define RLX_AGENT __ATOMIC_RELAXED, __HIP_MEMORY_SCOPE_AGENT
#define LDS_WAIT() asm volatile("s_waitcnt lgkmcnt(0)" ::: "memory")
#define VM_WAIT() asm volatile("s_waitcnt vmcnt(0)" ::: "memory")
__device__ __forceinline__ unsigned long long rt() { return __builtin_amdgcn_s_memrealtime(); }
__device__ __forceinline__ unsigned f2bf(float f) { unsigned u = __builtin_bit_cast(unsigned, f); return (u + 0x7fffu + ((u >> 16) & 1u)) >> 16; }
__device__ __forceinline__ unsigned pk2(float lo, float hi) { return f2bf(lo) | (f2bf(hi) << 16); }

#define XB_TMO      128
#define XB_XCNT(j)  (256  + 64 * (j))
#define XB_XSUB(j)  (1280 + 64 * (j))
#define XB_XGEN(j)  (2304 + 64 * (j))
#define XB_TOP      3328
#define XB_TOPGEN   3392
#define XCD_BAR_WORDS 3456
#define XB_SPIN_CAP (1u << 18)

__device__ __forceinline__ unsigned xb_ld(unsigned* p)              { return __hip_atomic_load(p, __ATOMIC_RELAXED, __HIP_MEMORY_SCOPE_AGENT); }
__device__ __forceinline__ unsigned xb_add(unsigned* p, unsigned v) { return __hip_atomic_fetch_add(p, v, __ATOMIC_RELAXED, __HIP_MEMORY_SCOPE_AGENT); }
__device__ __forceinline__ unsigned xb_xcc_id() { return (unsigned)__builtin_amdgcn_s_getreg((3 << 11) | 20) & 0xFu; }
#define XB_SPIN(cond, bar) do { unsigned _sp = 0; while (cond) { __builtin_amdgcn_s_sleep(1); \
    if ((++_sp & 255u) == 0u) { if (xb_ld(&(bar)[XB_TMO])) break; if (_sp > XB_SPIN_CAP) { atomicAdd(&(bar)[XB_TMO], 1u); break; } } } } while (0)

struct XcdBarrier {
    unsigned* bar; unsigned x;
    volatile LAS unsigned* st;
};

__device__ __forceinline__ XcdBarrier xcd_barrier_post(unsigned* bar, volatile LAS unsigned* st) {
    XcdBarrier b; b.bar = bar; b.x = xb_xcc_id(); b.st = st;
    if (threadIdx.x == 0) (void)xb_add(&bar[XB_XCNT(b.x)], 1u);
    return b;
}
__device__ __forceinline__ void xcd_barrier_complete(unsigned* bar, unsigned x, unsigned& nloc, unsigned& nx) {
    const unsigned G = gridDim.x * gridDim.y * gridDim.z;
    unsigned sum, cnt, mine, sp = 0u;
    for (;;) {
        sum = 0u; cnt = 0u; mine = 0u;
#pragma unroll
        for (unsigned j = 0; j < 16; ++j) { const unsigned c = xb_ld(&bar[XB_XCNT(j)]); sum += c; cnt += (c > 0u) ? 1u : 0u; mine = (j == x) ? c : mine; }
        if (sum == G) break;
        __builtin_amdgcn_s_sleep(1);
        if ((++sp & 255u) == 0u) { if (xb_ld(&bar[XB_TMO])) break; if (sp > XB_SPIN_CAP) { atomicAdd(&bar[XB_TMO], 1u); break; } }
    }
    nloc = mine > 0u ? mine : 1u; nx = cnt > 0u ? cnt : 1u;
}

__device__ __forceinline__ void xcd_barrier(const XcdBarrier& b) {
    asm volatile("s_waitcnt vmcnt(0)" ::: "memory");
    __syncthreads();
    if (threadIdx.x == 0) {
        unsigned* bar = b.bar;
        __builtin_amdgcn_s_waitcnt(0);
        unsigned nloc = b.st[0], nx = b.st[1];
        if (nloc == 0u) { xcd_barrier_complete(bar, b.x, nloc, nx); b.st[0] = nloc; b.st[1] = nx; }
        const unsigned old = xb_add(&bar[XB_XSUB(b.x)], 1u);
        const unsigned gen = old / nloc;
        if (old + 1u == (gen + 1u) * nloc) {
            __builtin_amdgcn_fence(__ATOMIC_RELEASE, "agent");
            asm volatile("s_waitcnt vmcnt(0)" ::: "memory");
            const unsigned og = xb_add(&bar[XB_TOP], 1u);
            const unsigned tg = og / nx;
            if (og + 1u == (tg + 1u) * nx) xb_add(&bar[XB_TOPGEN], 1u);
            else XB_SPIN(xb_ld(&bar[XB_TOPGEN]) == tg, bar);
            __builtin_amdgcn_fence(__ATOMIC_ACQUIRE, "agent");
            xb_add(&bar[XB_XGEN(b.x)], 1u);
            asm volatile("s_waitcnt vmcnt(0)" ::: "memory");
        } else {
            XB_SPIN(xb_ld(&bar[XB_XGEN(b.x)]) == gen, bar);
            __builtin_amdgcn_fence(__ATOMIC_ACQUIRE, "agent");
            asm volatile("s_waitcnt vmcnt(0)" ::: "memory");
        }
    }
    __syncthreads();
}

constexpr int NWAVES = 8;
#ifndef MK_N_LAUNCHES
#define MK_N_LAUNCHES 8
#endif
constexpr int N_LAUNCHES = MK_N_LAUNCHES;
constexpr int NPHASE = 8;
static_assert(N_LAUNCHES == 1 || N_LAUNCHES == NPHASE, "MK_N_LAUNCHES is 1 or NPHASE");

constexpr int BATCH = 8, SEQ = 4096, D = 1024, NH = 16, HD = 64, FF = 4096, PLE = 256;
constexpr int M = BATCH * SEQ;
constexpr int NQKV = 3 * D;
constexpr float EPS = 1e-6f;
constexpr float LOG2E = 1.4426950408889634f;
constexpr float C2 = 0.125f * LOG2E;

constexpr size_t MiB = 1u << 20;
constexpr size_t WS_CTL = 0, CTL_ZERO_BYTES = 64 * 1024;
constexpr size_t WS_WQKV = 1 * MiB, WS_WO = 7 * MiB, WS_WUP = 9 * MiB, WS_WDN = 17 * MiB, WS_WG = 25 * MiB, WS_WP = 27 * MiB;
constexpr size_t WS_SSQ0 = 28 * MiB, WS_SSQ1 = 30 * MiB, WS_SSQ2 = 32 * MiB, WS_SSQ3 = 34 * MiB;
constexpr size_t WS_KPART = 36 * MiB;
constexpr size_t WS_PB = 40 * MiB;
constexpr size_t WS_PP = 56 * MiB;
constexpr size_t WS_XN = 120 * MiB;
constexpr size_t WS_Q = 184 * MiB, WS_K = 248 * MiB, WS_V = 312 * MiB, WS_O = 376 * MiB;
constexpr size_t WS_U = 184 * MiB;
constexpr size_t WS_END = 440 * MiB;
constexpr int CW_BAR = 1024;

constexpr int RING_OFF = 0, RING_BYTES = 131072;
constexpr int LDSCTL_OFF = RING_BYTES, MISC_OFF = LDSCTL_OFF + 320;
constexpr int TAB_OFF = RING_BYTES + 1024;
constexpr int LDS_BYTES = 147456;
static_assert(TAB_OFF + 4096 <= LDS_BYTES, "LDS map");

struct Frame {
    LAS unsigned char* lds;
    volatile LAS unsigned* MISC;
    gu32* ctl;
    int tid, lane, wave;
    int vcu, G;
    const float *x, *p, *g_attn, *w_in, *g_out_a, *g_out_b, *w_out, *g_mlp, *w_up, *w_down, *g_ple, *w_gate, *b_gate, *w_proj, *g_final;
    float* out;
    bf16 *Wqkv_t, *Wo_t, *Wup_t, *Wdn_t, *Wg_t, *Wp_t;
    bf16 *XN, *QB, *KB, *VB, *OB, *UB, *PB, *PP;
    float *ssq0, *ssq1, *ssq2, *ssq3, *kpart;
};

__device__ __forceinline__ float wave_sum(float v) {
#pragma unroll
    for (int o = 1; o < 64; o <<= 1) v += __shfl_xor(v, o);
    return v;
}
__device__ __forceinline__ void p0_transpose_item(const float* W, int K, int N, bf16* dst, const float* g, LAS float* scr, int k0, int n0, int lane) {
#pragma unroll 8
    for (int i = 0; i < 32; ++i) { const int kk = 2 * i + (lane >> 5); float v = W[(size_t)(k0 + kk) * N + n0 + (lane & 31)]; if (g) v *= g[k0 + kk]; scr[kk * 33 + (lane & 31)] = v; }
    LDS_WAIT(); asm volatile("" ::: "memory");
    const int c = lane & 7;
#pragma unroll
    for (int j = 0; j < 4; ++j) { const int n = (lane >> 3) + 8 * j; const LAS float* s = scr + (8 * c) * 33 + n;
        v4u o; o.x = pk2(s[0 * 33], s[1 * 33]); o.y = pk2(s[2 * 33], s[3 * 33]); o.z = pk2(s[4 * 33], s[5 * 33]); o.w = pk2(s[6 * 33], s[7 * 33]);
        *(GAS v4u*)(dst + (size_t)n * K + k0 + 8 * c) = o; }
    LDS_WAIT(); asm volatile("" ::: "memory");
}
__device__ __forceinline__ int qkv_dst_row(int n0) {
    if (n0 < 1536) return (n0 / 512) * 1024 + (n0 % 512);
    const int n1 = n0 - 1536; return (n1 / 512) * 1024 + 512 + (n1 % 512);
}
__device__ __forceinline__ void p0_prologue(Frame& F) {
    LAS float* scr = (LAS float*)(F.lds + RING_OFF + F.wave * 16384);
    const int gw = F.vcu * NWAVES + F.wave, NGW = F.G * NWAVES;
    constexpr int I_IN = (D / 64) * (NQKV / 32), I_O = (D / 64) * (D / 32), I_UP = (D / 64) * (FF / 32), I_DN = (FF / 64) * (D / 32), I_G = I_O, I_P = (PLE / 64) * (D / 32);
    constexpr int NITEMS = I_IN + I_O + I_UP + I_DN + I_G + I_P;
    for (int it = gw; it < NITEMS; it += NGW) {
        int r = it;
        if (r < I_IN) { const int nb = r % (NQKV / 32), kb = r / (NQKV / 32); p0_transpose_item(F.w_in, D, NQKV, F.Wqkv_t + (size_t)qkv_dst_row(32 * nb) * D, F.g_attn, scr, 64 * kb, 32 * nb, F.lane); continue; } r -= I_IN;
        if (r < I_O) { const int nb = r % (D / 32), kb = r / (D / 32); const float* g = (64 * kb < 512) ? F.g_out_a : (F.g_out_b - 512);
            p0_transpose_item(F.w_out, D, D, F.Wo_t + (size_t)(32 * nb) * D, g, scr, 64 * kb, 32 * nb, F.lane); continue; } r -= I_O;
        if (r < I_UP) { const int nb = r % (FF / 32), kb = r / (FF / 32); p0_transpose_item(F.w_up, D, FF, F.Wup_t + (size_t)(32 * nb) * D, F.g_mlp, scr, 64 * kb, 32 * nb, F.lane); continue; } r -= I_UP;
        if (r < I_DN) { const int nb = r % (D / 32), kb = r / (D / 32); p0_transpose_item(F.w_down, FF, D, F.Wdn_t + (size_t)(32 * nb) * FF, nullptr, scr, 64 * kb, 32 * nb, F.lane); continue; } r -= I_DN;
        if (r < I_G) { const int nb = r % (D / 32), kb = r / (D / 32); p0_transpose_item(F.w_gate, D, D, F.Wg_t + (size_t)(32 * nb) * D, F.g_ple, scr, 64 * kb, 32 * nb, F.lane); continue; } r -= I_G;
        { const int nb = r % (D / 32), kb = r / (D / 32); p0_transpose_item(F.w_proj, PLE, D, F.Wp_t + (size_t)(32 * nb) * PLE, nullptr, scr, 64 * kb, 32 * nb, F.lane); }
    }
    for (int m = gw; m < M; m += NGW) {
        const GAS f32x4* xr = (const GAS f32x4*)(F.x + (size_t)m * D) + F.lane;
        f32x4 v[4]; float s = 0.f;
#pragma unroll
        for (int j = 0; j < 4; ++j) { v[j] = xr[64 * j]; s += (v[j].x * v[j].x + v[j].y * v[j].y) + (v[j].z * v[j].z + v[j].w * v[j].w); }
        const float rstd = 1.f / sqrtf(wave_sum(s) * (1.f / D) + EPS);
        GAS unsigned long long* o8 = (GAS unsigned long long*)(F.XN + (size_t)m * D) + F.lane;
#pragma unroll
        for (int j = 0; j < 4; ++j) o8[64 * j] = (unsigned long long)pk2(v[j].x * rstd, v[j].y * rstd) | ((unsigned long long)pk2(v[j].z * rstd, v[j].w * rstd) << 32);
        const f32x4 pv = ((const GAS f32x4*)(F.p + (size_t)m * PLE))[F.lane];
        ((GAS unsigned long long*)(F.PB + (size_t)m * PLE))[F.lane] = (unsigned long long)pk2(pv.x, pv.y) | ((unsigned long long)pk2(pv.z, pv.w) << 32);
    }
}

__device__ __forceinline__ float bf2f(unsigned short h) { return __uint_as_float((unsigned)h << 16); }
__device__ __forceinline__ void naive_key(const bf16* kp, const bf16* vp, const float (&q)[64], float bias, float& mx, float& l, float (&acc)[64]) {
    float s = 0.f;
#pragma unroll
    for (int c = 0; c < 8; ++c) { const v4u kw = *(const v4u*)(kp + 8 * c);
        s += q[8 * c + 0] * __uint_as_float(kw.x << 16) + q[8 * c + 1] * __uint_as_float(kw.x & 0xffff0000u) + q[8 * c + 2] * __uint_as_float(kw.y << 16) + q[8 * c + 3] * __uint_as_float(kw.y & 0xffff0000u)
           + q[8 * c + 4] * __uint_as_float(kw.z << 16) + q[8 * c + 5] * __uint_as_float(kw.z & 0xffff0000u) + q[8 * c + 6] * __uint_as_float(kw.w << 16) + q[8 * c + 7] * __uint_as_float(kw.w & 0xffff0000u); }
    s += bias;
    const float mn = fmaxf(mx, s), sc = __builtin_amdgcn_exp2f(mx - mn), pe = __builtin_amdgcn_exp2f(s - mn);
    mx = mn; l = l * sc + pe;
#pragma unroll
    for (int c = 0; c < 8; ++c) { const v4u vw = *(const v4u*)(vp + 8 * c);
        acc[8 * c + 0] = acc[8 * c + 0] * sc + pe * __uint_as_float(vw.x << 16); acc[8 * c + 1] = acc[8 * c + 1] * sc + pe * __uint_as_float(vw.x & 0xffff0000u);
        acc[8 * c + 2] = acc[8 * c + 2] * sc + pe * __uint_as_float(vw.y << 16); acc[8 * c + 3] = acc[8 * c + 3] * sc + pe * __uint_as_float(vw.y & 0xffff0000u);
        acc[8 * c + 4] = acc[8 * c + 4] * sc + pe * __uint_as_float(vw.z << 16); acc[8 * c + 5] = acc[8 * c + 5] * sc + pe * __uint_as_float(vw.z & 0xffff0000u);
        acc[8 * c + 6] = acc[8 * c + 6] * sc + pe * __uint_as_float(vw.w << 16); acc[8 * c + 7] = acc[8 * c + 7] * sc + pe * __uint_as_float(vw.w & 0xffff0000u); }
}
__device__ __forceinline__ void attn_naive(Frame& F) {
    const long NT = (long)F.G * NWAVES * 64;
    for (long idx = (long)blockIdx.x * (NWAVES * 64) + F.tid; idx < (long)M * NH; idx += NT) {
        const int tok = (int)(idx % M), hh = (int)(idx / M); const int b = tok / SEQ, t = tok % SEQ; const int grp = hh >> 3, h = hh & 7;
        float q[64], acc[64]; float mx = -1e30f, l = 0.f;
#pragma unroll
        for (int d = 0; d < 64; ++d) acc[d] = 0.f;
        if (grp == 0) {
            const float sl2 = exp2f(-0.5f * (float)(2 * h + 1)) * LOG2E;
            const size_t qrow = (size_t)b * SEQ + (size_t)(t & 3) * 1024 + (t >> 2);
            const bf16* qp = F.QB + qrow * D + h * 64;
#pragma unroll
            for (int d = 0; d < 64; ++d) q[d] = bf2f(qp[d]);
            for (int br = 0; br < 3; ++br) { const int dil = br == 0 ? 1 : (br == 1 ? 4 : 16);
                for (int mm = 0; mm <= 128; ++mm) { const int key = t - dil * mm; if (key < 0) break;
                    const size_t krow = (size_t)b * SEQ + (size_t)(key & 3) * 1024 + (key >> 2);
                    naive_key(F.KB + krow * D + h * 64, F.VB + krow * D + h * 64, q, -sl2 * (float)(dil * mm), mx, l, acc); } }
        } else {
            const float sl2 = exp2f(-(float)(h + 1)) * LOG2E;
            const bf16* qp = F.QB + (size_t)tok * D + 512 + h * 64;
#pragma unroll
            for (int d = 0; d < 64; ++d) q[d] = bf2f(qp[d]);
            const int own = t >> 8; int i0 = -1, i1 = -1, i2 = -1; float g0 = -INFINITY, g1 = -INFINITY, g2 = -INFINITY;
            for (int n = 0; n < own; ++n) { const float* k0 = F.kpart + (size_t)((b * 16 + n) * 2) * 512 + h * 64; const float* k1 = k0 + 512; float g = 0.f;
#pragma unroll
                for (int d = 0; d < 64; ++d) g += q[d] * (k0[d] + k1[d]);
                if (g > g0) { g2 = g1; i2 = i1; g1 = g0; i1 = i0; g0 = g; i0 = n; } else if (g > g1) { g2 = g1; i2 = i1; g1 = g; i1 = n; } else if (g > g2) { g2 = g; i2 = n; } }
            for (int j = 0; j < 4; ++j) { const int n = j == 0 ? i0 : (j == 1 ? i1 : (j == 2 ? i2 : own)); if (n < 0) continue;
                const int kend = (j == 3) ? t : 256 * n + 255;
                for (int key = 256 * n; key <= kend; ++key) { const size_t krow = (size_t)b * SEQ + key;
                    naive_key(F.KB + krow * D + 512 + h * 64, F.VB + krow * D + 512 + h * 64, q, -sl2 * (float)(t - key), mx, l, acc); } }
        }
        const float rl = 1.0f / l; float ss = 0.f; bf16* op = F.OB + (size_t)tok * D + grp * 512 + h * 64;
#pragma unroll
        for (int d = 0; d < 64; d += 2) { const float a = acc[d] * rl, c = acc[d + 1] * rl; ss += a * a + c * c; *(unsigned*)(op + d) = pk2(a, c); }
        F.ssq0[(size_t)tok * 16 + hh] = ss;
    }
}

__device__ __forceinline__ void final_norm(Frame& F) {
    const int gw = F.vcu * NWAVES + F.wave, NGW = F.G * NWAVES;
    f32x4 g[4];
#pragma unroll
    for (int j = 0; j < 4; ++j) g[j] = ((const GAS f32x4*)F.g_final)[F.lane + 64 * j];
    for (int m = gw; m < M; m += NGW) {
        const GAS f32x4* sp = (const GAS f32x4*)(F.ssq3 + (size_t)m * 16);
        const f32x4 a = sp[0], b = sp[1], c = sp[2], d = sp[3];
        const float s = ((a.x + a.y) + (a.z + a.w)) + ((b.x + b.y) + (b.z + b.w)) + ((c.x + c.y) + (c.z + c.w)) + ((d.x + d.y) + (d.z + d.w));
        const float rstd = 1.f / sqrtf(s * (1.f / D) + EPS);
        GAS f32x4* xr = (GAS f32x4*)(F.out + (size_t)m * D) + F.lane;
#pragma unroll
        for (int j = 0; j < 4; ++j) { const f32x4 v = xr[64 * j]; xr[64 * j] = v * rstd * g[j]; }
    }
}

struct Args { const float* in[15]; float* out; unsigned char* ws; int ph_lo, ph_hi, li, pad; };
__global__ void __launch_bounds__(NWAVES * 64, 2) mk_fwd(Args args) {
    extern __shared__ __attribute__((aligned(16))) unsigned char lds[];
    Frame F;
    F.lds = (LAS unsigned char*)lds;
    F.MISC = (volatile LAS unsigned*)(F.lds + MISC_OFF);
    F.tid = threadIdx.x; F.lane = F.tid & 63; F.wave = __builtin_amdgcn_readfirstlane(F.tid >> 6);
    F.G = gridDim.x; { const int bx = blockIdx.x; F.vcu = (F.G % 8 == 0) ? (bx % 8) * (F.G / 8) + bx / 8 : bx; }
    unsigned char* ws = args.ws;
    F.ctl = (gu32*)(ws + WS_CTL);
    F.x = args.in[0]; F.p = args.in[1]; F.g_attn = args.in[2]; F.w_in = args.in[3]; F.g_out_a = args.in[4]; F.g_out_b = args.in[5]; F.w_out = args.in[6]; F.g_mlp = args.in[7];
    F.w_up = args.in[8]; F.w_down = args.in[9]; F.g_ple = args.in[10]; F.w_gate = args.in[11]; F.b_gate = args.in[12]; F.w_proj = args.in[13]; F.g_final = args.in[14]; F.out = args.out;
    F.Wqkv_t = (bf16*)(ws + WS_WQKV); F.Wo_t = (bf16*)(ws + WS_WO); F.Wup_t = (bf16*)(ws + WS_WUP); F.Wdn_t = (bf16*)(ws + WS_WDN); F.Wg_t = (bf16*)(ws + WS_WG); F.Wp_t = (bf16*)(ws + WS_WP);
    F.XN = (bf16*)(ws + WS_XN); F.QB = (bf16*)(ws + WS_Q); F.KB = (bf16*)(ws + WS_K); F.VB = (bf16*)(ws + WS_V); F.OB = (bf16*)(ws + WS_O); F.UB = (bf16*)(ws + WS_U); F.PB = (bf16*)(ws + WS_PB); F.PP = (bf16*)(ws + WS_PP);
    F.ssq0 = (float*)(ws + WS_SSQ0); F.ssq1 = (float*)(ws + WS_SSQ1); F.ssq2 = (float*)(ws + WS_SSQ2); F.ssq3 = (float*)(ws + WS_SSQ3); F.kpart = (float*)(ws + WS_KPART);
    for (int u = F.tid; u < (LDS_BYTES - LDSCTL_OFF) / 4; u += NWAVES * 64) ((LAS unsigned*)(F.lds + LDSCTL_OFF))[u] = 0u;
    __syncthreads();
    XcdBarrier bar; bar.bar = (unsigned*)(F.ctl + CW_BAR); bar.x = 0; bar.st = nullptr;
    if (N_LAUNCHES == 1) bar = xcd_barrier_post((unsigned*)(F.ctl + CW_BAR), F.MISC + 8);
    PG8_LAS float* tab = (PG8_LAS float*)(F.lds + TAB_OFF);
    const int lo = args.ph_lo, hi = args.ph_hi;
#define IN(k) (lo <= (k) && (k) < hi)
#define SEAM(k) do { if (IN(k) && IN((k) + 1)) xcd_barrier(bar); } while (0)

    if (IN(0)) { p0_prologue(F); SEAM(0); }
    if (IN(1)) {
        { pg8::Gemm g{F.XN, F.Wqkv_t, M, NQKV, D}; pg8::StaticOrder S; S.init(M, NQKV, F.G, (int)blockIdx.x);
          pg8::EpiQKV E{F.QB, (size_t)(WS_K - WS_Q) / 2, F.kpart, C2};
          pg8::gemm_phase<pg8::EpiQKV, pg8::StaticOrder, true, true>(F.lds + RING_OFF, tab, g, S, E); }
        { pg8::Gemm g{F.PB, F.Wp_t, M, D, PLE}; pg8::StaticOrder S; S.init(M, D, F.G, (int)blockIdx.x);
          pg8::EpiBf16Plain E{F.PP, D};
          pg8::gemm_phase<pg8::EpiBf16Plain, pg8::StaticOrder, true, true>(F.lds + RING_OFF, tab, g, S, E); }
        SEAM(1);
    }
    if (IN(2)) { attn_naive(F); SEAM(2); }
    if (IN(3)) {
        pg8::Gemm g{F.OB, F.Wo_t, M, D, D}; pg8::StaticOrder S; S.init(M, D, F.G, (int)blockIdx.x);
        pg8::EpiRes<1> E{F.x, F.out, F.XN, F.ssq1, F.ssq0};
        pg8::gemm_phase<pg8::EpiRes<1>, pg8::StaticOrder, true, true>(F.lds + RING_OFF, tab, g, S, E);
        SEAM(3);
    }
    if (IN(4)) {
        pg8::Gemm g{F.XN, F.Wup_t, M, FF, D}; pg8::StaticOrder S; S.init(M, FF, F.G, (int)blockIdx.x);
        pg8::EpiUp E{F.UB, FF, F.ssq1};
        pg8::gemm_phase<pg8::EpiUp, pg8::StaticOrder, true, true>(F.lds + RING_OFF, tab, g, S, E);
        SEAM(4);
    }
    if (IN(5)) {
        pg8::Gemm g{F.UB, F.Wdn_t, M, D, FF}; pg8::StaticOrder S; S.init(M, D, F.G, (int)blockIdx.x);
        pg8::EpiRes<0> E{F.out, F.out, F.XN, F.ssq2, nullptr};
        pg8::gemm_phase<pg8::EpiRes<0>, pg8::StaticOrder, true, true>(F.lds + RING_OFF, tab, g, S, E);
        SEAM(5);
    }
    if (IN(6)) {
        pg8::Gemm g{F.XN, F.Wg_t, M, D, D}; pg8::StaticOrder S; S.init(M, D, F.G, (int)blockIdx.x);
        pg8::EpiGate E{F.out, F.out, F.PP, F.b_gate, F.ssq3, F.ssq2};
        pg8::gemm_phase<pg8::EpiGate, pg8::StaticOrder, true, true>(F.lds + RING_OFF, tab, g, S, E);
        SEAM(6);
    }
    if (IN(7)) { final_norm(F); }
#undef IN
#undef SEAM
}

extern "C" void kernel_launch(void* const* d_in, const int* in_sizes, int n_in, void* d_out, int out_size, void* d_ws, size_t ws_size, hipStream_t stream) {
    static int grid = 0;
    if (grid == 0) {
        if (n_in != 15 || in_sizes[0] != M * D || out_size != M * D || ws_size < WS_END) { fprintf(stderr, "kernel_launch: unexpected shapes (n_in %d, in0 %d, out %d, ws %zu); nothing launched\n", n_in, n_in > 0 ? in_sizes[0] : -1, out_size, ws_size); grid = -1; return; }
        int dev = 0, cus = 0, per_cu = 0;
        if (hipGetDevice(&dev) != hipSuccess || hipDeviceGetAttribute(&cus, hipDeviceAttributeMultiprocessorCount, dev) != hipSuccess) { grid = -1; return; }
        if (hipFuncSetAttribute((const void*)mk_fwd, hipFuncAttributeMaxDynamicSharedMemorySize, LDS_BYTES) != hipSuccess) { fprintf(stderr, "kernel_launch: hipFuncSetAttribute failed\n"); grid = -1; return; }
        if (hipOccupancyMaxActiveBlocksPerMultiprocessor(&per_cu, (const void*)mk_fwd, NWAVES * 64, LDS_BYTES) != hipSuccess || per_cu < 1) { fprintf(stderr, "kernel_launch: occupancy query reports %d blocks per CU\n", per_cu); }
        (void)hipGetLastError();
        grid = cus;
    }
    if (grid < 0) return;
    if (hipMemsetAsync((char*)d_ws + WS_CTL, 0, CTL_ZERO_BYTES, stream) != hipSuccess) { fprintf(stderr, "kernel_launch: hipMemsetAsync failed\n"); return; }
    Args a{};
    for (int i = 0; i < 15; ++i) a.in[i] = (const float*)d_in[i];
    a.out = (float*)d_out; a.ws = (unsigned char*)d_ws;
    for (int li = 0; li < N_LAUNCHES; ++li) {
        a.ph_lo = (N_LAUNCHES == 1) ? 0 : li; a.ph_hi = (N_LAUNCHES == 1) ? NPHASE : li + 1; a.li = li;
        hipLaunchKernelGGL(mk_fwd, dim3(grid), dim3(NWAVES * 64), LDS_BYTES, stream, a);
        const hipError_t le = hipPeekAtLastError();
        if (le != hipSuccess) { fprintf(stderr, "kernel_launch: launch %d failed: %s\n", li, hipGetErrorName(le)); break; }
    }
}
```

```cpp
#include <hip/hip_runtime.h>
#include <cstdio>
#include <cstdint>
namespace pg8 {
#define PG8_LAS __attribute__((address_space(3)))
typedef unsigned short bf16_t;
typedef short bf16x8 __attribute__((ext_vector_type(8)));
typedef float f32x4 __attribute__((ext_vector_type(4)));
typedef unsigned u32x4 __attribute__((ext_vector_type(4)));
constexpr int BM = 256, BK = 64, HALF = 128, HTB = HALF * BK * 2  , STAGE_BYTES = 8 * HTB, NXCD = 8, WGM = 8;

__host__ __device__ __forceinline__ int lds_byte(int r, int c) { const int st = (r >> 4) * 2 + (c >> 5), rr = r & 15, cc = c & 31, ob = rr * 64 + cc * 2; return st * 1024 + (ob ^ (((ob >> 9) & 1) << 5)); }
__host__ __device__ __forceinline__ void stage_rc(int b, int& R, int& C) { const int st = b / 1024, sb = b % 1024, swz = sb ^ (((sb >> 9) & 1) << 5); R = (st >> 1) * 16 + swz / 64; C = (st & 1) * 32 + (swz % 64) / 2; }
__host__ __device__ __forceinline__ int perm32(int rho) { const int n = rho >> 4, i = rho & 15; return 8 * (i >> 2) + 4 * n + (i & 3); }

struct Unit { int pm, pn; };
struct Gemm { const bf16_t* A; const bf16_t* Bt; int M, N, K; };

struct StaticOrder {
    int nM, nN, nwg, G, c;
    __host__ __device__ void init(int M, int N, int G_, int c_) { nM = M / BM; nN = N / BM; nwg = nM * nN; G = G_; c = c_; }
    __host__ __device__ bool next(int i, Unit& u) const {
        const long L = (long)i * G + c; if (L >= nwg) return false;
        int wgid = (int)L; { const int q = nwg / NXCD, r = nwg % NXCD, xcd = wgid % NXCD, off = wgid / NXCD; wgid = (xcd < r ? xcd * (q + 1) : r * (q + 1) + (xcd - r) * q) + off; }
        const int nig = WGM * nN, gid = wgid / nig, fm = gid * WGM, gsz = (nM - fm) < WGM ? (nM - fm) : WGM;
        u.pm = fm + ((wgid % nig) % gsz); u.pn = (wgid % nig) / gsz; return true;
    }
    __device__ __forceinline__ void a_ready(const Unit&) const {}
    __device__ __forceinline__ void done(const Unit&) const {}
};

__device__ __forceinline__ unsigned cvt_pk_bf16(float lo, float hi) { unsigned r; asm volatile("v_cvt_pk_bf16_f32 %0, %1, %2" : "=v"(r) : "v"(lo), "v"(hi)); return r; }
typedef unsigned u32x2 __attribute__((ext_vector_type(2)));
constexpr float RMS_EPS = 1e-6f;
__device__ __forceinline__ float sum4(f32x4 v) { return (v[0] + v[1]) + (v[2] + v[3]); }

struct EpiBf16Plain {
    static constexpr bool PERM = true, AFTER_DRAIN = false, MID = false, TABLE = false;
    bf16_t* O; int ldc;
    __device__ __forceinline__ void operator()(f32x4 (&acc)[2][2][4][2], const Unit& u, int wr, int wc, int fr, int fq, PG8_LAS float*, int) const {
        const int row0 = u.pm * BM + wr * 64 + fr, col0 = u.pn * BM + wc * 32 + 8 * fq;
#pragma unroll
        for (int ai = 0; ai < 2; ++ai)
#pragma unroll
            for (int m = 0; m < 4; ++m) { bf16_t* rowp = O + (size_t)(row0 + ai * HALF + m * 16) * ldc + col0;
#pragma unroll
                for (int bj = 0; bj < 2; ++bj) { const f32x4 v0 = acc[ai][bj][m][0], v1 = acc[ai][bj][m][1];
                    u32x4 w; w.x = cvt_pk_bf16(v0[0], v0[1]); w.y = cvt_pk_bf16(v0[2], v0[3]); w.z = cvt_pk_bf16(v1[0], v1[1]); w.w = cvt_pk_bf16(v1[2], v1[3]);
                    *(u32x4*)(rowp + bj * HALF) = w; } }
    }
};

struct EpiQKV {
    static constexpr bool PERM = true, AFTER_DRAIN = false, MID = false, TABLE = false;
    bf16_t* Q; size_t part_stride; float* kpart; float qscale;
    __device__ __forceinline__ void operator()(f32x4 (&acc)[2][2][4][2], const Unit& u, int wr, int wc, int fr, int fq, PG8_LAS float*, int) const {
        const int part = u.pn >> 2, pc = u.pn & 3; const bool ga = pc < 2;
        bf16_t* base = Q + (size_t)part * part_stride; const float sc = part == 0 ? qscale : 1.0f;
        const int row0 = u.pm * BM + wr * 64 + fr, col0 = pc * BM + wc * 32 + 8 * fq;
#pragma unroll
        for (int ai = 0; ai < 2; ++ai)
#pragma unroll
            for (int m = 0; m < 4; ++m) { const int row = row0 + ai * HALF + m * 16;
                const int rowd = ga ? ((row & ~4095) | ((row & 3) << 10) | ((row & 4095) >> 2)) : row;
                bf16_t* rowp = base + (size_t)rowd * 1024 + col0;
#pragma unroll
                for (int bj = 0; bj < 2; ++bj) { const f32x4 v0 = acc[ai][bj][m][0] * sc, v1 = acc[ai][bj][m][1] * sc;
                    u32x4 w; w.x = cvt_pk_bf16(v0[0], v0[1]); w.y = cvt_pk_bf16(v0[2], v0[3]); w.z = cvt_pk_bf16(v1[0], v1[1]); w.w = cvt_pk_bf16(v1[2], v1[3]);
                    *(u32x4*)(rowp + bj * HALF) = w; } }
        if (part == 1 && !ga) {
#pragma unroll
            for (int bj = 0; bj < 2; ++bj) {
                f32x4 s0 = acc[0][bj][0][0], s1 = acc[0][bj][0][1];
#pragma unroll
                for (int ai = 0; ai < 2; ++ai)
#pragma unroll
                    for (int m = 0; m < 4; ++m) if (ai + m) { s0 += acc[ai][bj][m][0]; s1 += acc[ai][bj][m][1]; }
#pragma unroll
                for (int e = 0; e < 4; ++e) {
#pragma unroll
                    for (int o = 1; o < 16; o <<= 1) { s0[e] += __shfl_xor(s0[e], o); s1[e] += __shfl_xor(s1[e], o); } }
                if (fr == 0) { float* kp = kpart + (size_t)(u.pm * 2 + wr) * 512 + (pc - 2) * BM + bj * HALF + wc * 32 + 8 * fq;
                    *(f32x4*)kp = s0; *(f32x4*)(kp + 4) = s1; }
            }
        }
    }
};

template <int KIND> __device__ __forceinline__ void fill_rowscale(const float* ssq, const Unit& u, int par, PG8_LAS float* tab, int tid) {
    if (tid < 256) {
        const f32x4* p = (const f32x4*)(ssq + (size_t)(u.pm * BM + tid) * 16);
        const f32x4 a0 = p[0], a1 = p[1], b0 = p[2], b1 = p[3];
        const float sa = sum4(a0) + sum4(a1), sb = sum4(b0) + sum4(b1);
        if (KIND == 1) { tab[par * 512 + 2 * tid] = 1.0f / sqrtf((sa + sb) * (1.0f / 1024.0f) + RMS_EPS); }
        else { const float ra = 1.0f / sqrtf(sa * (1.0f / 512.0f) + RMS_EPS), rb = 1.0f / sqrtf(sb * (1.0f / 512.0f) + RMS_EPS);
            tab[par * 512 + 2 * tid] = ra / rb; tab[par * 512 + 2 * tid + 1] = rb; }
    }
}

struct EpiUp {
    static constexpr bool PERM = true, AFTER_DRAIN = false, MID = false, TABLE = true;
    bf16_t* O; int ldc; const float* ssq;
    __device__ __forceinline__ void fill(const Unit& u, int par, PG8_LAS float* tab, int tid) const { fill_rowscale<1>(ssq, u, par, tab, tid); }
    __device__ __forceinline__ void operator()(f32x4 (&acc)[2][2][4][2], const Unit& u, int wr, int wc, int fr, int fq, PG8_LAS float* tab, int par) const {
        const int row0 = u.pm * BM + wr * 64 + fr, col0 = u.pn * BM + wc * 32 + 8 * fq;
#pragma unroll
        for (int ai = 0; ai < 2; ++ai)
#pragma unroll
            for (int m = 0; m < 4; ++m) { const int r = ai * HALF + wr * 64 + m * 16 + fr; const float rs = tab[par * 512 + 2 * r];
                bf16_t* rowp = O + (size_t)(row0 + ai * HALF + m * 16) * ldc + col0;
#pragma unroll
                for (int bj = 0; bj < 2; ++bj) { f32x4 v0 = acc[ai][bj][m][0] * rs, v1 = acc[ai][bj][m][1] * rs;
#pragma unroll
                    for (int e = 0; e < 4; ++e) { const float a = fmaxf(v0[e], 0.f), b = fmaxf(v1[e], 0.f); v0[e] = a * a; v1[e] = b * b; }
                    u32x4 w; w.x = cvt_pk_bf16(v0[0], v0[1]); w.y = cvt_pk_bf16(v0[2], v0[3]); w.z = cvt_pk_bf16(v1[0], v1[1]); w.w = cvt_pk_bf16(v1[2], v1[3]);
                    *(u32x4*)(rowp + bj * HALF) = w; } }
    }
};

template <int KIND> struct EpiRes {
    static constexpr bool PERM = true, AFTER_DRAIN = false, MID = (KIND == 1), TABLE = (KIND == 1);
    const float* res32; bf16_t* hb; float* ssq_out; const float* ssq_in;
    __device__ __forceinline__ void fill(const Unit& u, int par, PG8_LAS float* tab, int tid) const { fill_rowscale<2>(ssq_in, u, par, tab, tid); }
    __device__ __forceinline__ void mid(f32x4 (&acc)[2][2][4][2], int wr, int fr, PG8_LAS float* tab, int par) const {
#pragma unroll
        for (int ai = 0; ai < 2; ++ai)
#pragma unroll
            for (int m = 0; m < 4; ++m) { const float f = tab[par * 512 + 2 * (ai * HALF + wr * 64 + m * 16 + fr)];
#pragma unroll
                for (int bj = 0; bj < 2; ++bj)
#pragma unroll
                    for (int n = 0; n < 2; ++n) acc[ai][bj][m][n] *= f; }
    }
    __device__ __forceinline__ void operator()(f32x4 (&acc)[2][2][4][2], const Unit& u, int wr, int wc, int fr, int fq, PG8_LAS float* tab, int par) const {
        const int col0 = u.pn * BM + wc * 32 + 8 * fq;
#pragma unroll
        for (int ai = 0; ai < 2; ++ai) {
            f32x4 rv[4][2][2];
#pragma unroll
            for (int m = 0; m < 4; ++m) { const size_t off = (size_t)(u.pm * BM + ai * HALF + wr * 64 + m * 16 + fr) * 1024 + col0;
#pragma unroll
                for (int bj = 0; bj < 2; ++bj) {
                    if (KIND == 1) { rv[m][bj][0] = *(const f32x4*)(res32 + off + bj * HALF); rv[m][bj][1] = *(const f32x4*)(res32 + off + bj * HALF + 4); }
                    else { const u32x4 w = *(const u32x4*)(hb + off + bj * HALF);
                        rv[m][bj][0] = (f32x4){__uint_as_float(w.x << 16), __uint_as_float(w.x & 0xffff0000u), __uint_as_float(w.y << 16), __uint_as_float(w.y & 0xffff0000u)};
                        rv[m][bj][1] = (f32x4){__uint_as_float(w.z << 16), __uint_as_float(w.z & 0xffff0000u), __uint_as_float(w.w << 16), __uint_as_float(w.w & 0xffff0000u)}; } } }
#pragma unroll
            for (int m = 0; m < 4; ++m) { const int r = ai * HALF + wr * 64 + m * 16 + fr; const int rowg = u.pm * BM + r;
                const float rb = (KIND == 1) ? tab[par * 512 + 2 * r + 1] : 1.0f;
                const size_t off = (size_t)rowg * 1024 + col0; float ss = 0.f;
#pragma unroll
                for (int bj = 0; bj < 2; ++bj) { const f32x4 v0 = rv[m][bj][0] + acc[ai][bj][m][0] * rb, v1 = rv[m][bj][1] + acc[ai][bj][m][1] * rb;
                    u32x4 w; w.x = cvt_pk_bf16(v0[0], v0[1]); w.y = cvt_pk_bf16(v0[2], v0[3]); w.z = cvt_pk_bf16(v1[0], v1[1]); w.w = cvt_pk_bf16(v1[2], v1[3]);
                    *(u32x4*)(hb + off + bj * HALF) = w;
                    ss += ((v0[0] * v0[0] + v0[1] * v0[1]) + (v0[2] * v0[2] + v0[3] * v0[3])) + ((v1[0] * v1[0] + v1[1] * v1[1]) + (v1[2] * v1[2] + v1[3] * v1[3])); }
                ss += __shfl_xor(ss, 16); ss += __shfl_xor(ss, 32);
                if (fq == 0) ssq_out[(size_t)rowg * 16 + u.pn * 4 + wc] = ss; }
            asm volatile("" ::: "memory");
        }
    }
};

struct EpiGate {
    static constexpr bool PERM = true, AFTER_DRAIN = false, MID = false, TABLE = true;
    bf16_t* hb; const bf16_t* pp; const float* bias; float* ssq_out; const float* ssq_in;
    __device__ __forceinline__ void fill(const Unit& u, int par, PG8_LAS float* tab, int tid) const { fill_rowscale<1>(ssq_in, u, par, tab, tid); }
    __device__ __forceinline__ void operator()(f32x4 (&acc)[2][2][4][2], const Unit& u, int wr, int wc, int fr, int fq, PG8_LAS float* tab, int par) const {
        const int col0 = u.pn * BM + wc * 32 + 8 * fq;
        f32x4 bv[2][2];
#pragma unroll
        for (int bj = 0; bj < 2; ++bj)
#pragma unroll
            for (int n = 0; n < 2; ++n) bv[bj][n] = *(const f32x4*)(bias + col0 + bj * HALF + 4 * n);
#pragma unroll
        for (int ai = 0; ai < 2; ++ai) {
            u32x4 hv[4][2], pv[4][2];
#pragma unroll
            for (int m = 0; m < 4; ++m) { const size_t off = (size_t)(u.pm * BM + ai * HALF + wr * 64 + m * 16 + fr) * 1024 + col0;
#pragma unroll
                for (int bj = 0; bj < 2; ++bj) { hv[m][bj] = *(const u32x4*)(hb + off + bj * HALF); pv[m][bj] = *(const u32x4*)(pp + off + bj * HALF); } }
#pragma unroll
            for (int m = 0; m < 4; ++m) { const int r = ai * HALF + wr * 64 + m * 16 + fr; const int rowg = u.pm * BM + r;
                const float rs = tab[par * 512 + 2 * r];
                const size_t off = (size_t)rowg * 1024 + col0; float ss = 0.f;
#pragma unroll
                for (int bj = 0; bj < 2; ++bj) { float v[8];
#pragma unroll
                    for (int e = 0; e < 8; ++e) { const unsigned hw = hv[m][bj][e >> 1], pw = pv[m][bj][e >> 1];
                        const float h = __uint_as_float((e & 1) ? (hw & 0xffff0000u) : (hw << 16)), p = __uint_as_float((e & 1) ? (pw & 0xffff0000u) : (pw << 16));
                        const float z = acc[ai][bj][m][e >> 2][e & 3] * rs + bv[bj][e >> 2][e & 3];
                        v[e] = h + __builtin_amdgcn_rcpf(1.0f + __builtin_amdgcn_exp2f(-1.4426950408889634f * z)) * p; ss += v[e] * v[e]; }
                    u32x4 w; w.x = cvt_pk_bf16(v[0], v[1]); w.y = cvt_pk_bf16(v[2], v[3]); w.z = cvt_pk_bf16(v[4], v[5]); w.w = cvt_pk_bf16(v[6], v[7]);
                    *(u32x4*)(hb + off + bj * HALF) = w; }
                ss += __shfl_xor(ss, 16); ss += __shfl_xor(ss, 32);
                if (fq == 0) ssq_out[(size_t)rowg * 16 + u.pn * 4 + wc] = ss; }
            asm volatile("" ::: "memory");
        }
    }
};

template <class Epi, class Sched, bool ALIGN_EPI = false, bool SP2 = false>
__device__ __forceinline__ void gemm_phase(PG8_LAS unsigned char* lds, PG8_LAS float* tab, const Gemm g, const Sched& S, const Epi& E) {
    const int tid = threadIdx.x, wid = __builtin_amdgcn_readfirstlane(tid >> 6), lane = tid & 63, wr = wid >> 2, wc = wid & 3, fr = lane & 15, fq = lane >> 4;
    const int K = g.K, nt = K / BK;
    unsigned voffA[2], voffB[2];
#pragma unroll
    for (int i = 0; i < 2; ++i) { int R, C; stage_rc(tid * 16 + i * 8192, R, C); const int Rb = Epi::PERM ? ((R & ~31) + perm32(R & 31)) : R;
        voffA[i] = (unsigned)(R * K + C) * 2u; voffB[i] = (unsigned)(Rb * K + C) * 2u; }
    const size_t kstep = (size_t)(BK * 2);
    const size_t hstep = (size_t)HALF * K * 2;
    const size_t tstep = 2 * hstep;
    const unsigned ldsw = (unsigned)wid * 1024u;
    const int aoff = lds_byte(wr * 64 + fr, fq * 8), boff = lds_byte(wc * 32 + fr, fq * 8);
#define PG8_SA(b, h) (((b) * 2 + (h)) * HTB)
#define PG8_SB(b, h) ((4 + (b) * 2 + (h)) * HTB)
#define PG8_STAGE(bufoff, gbase, voff) do { _Pragma("unroll") for (int _i = 0; _i < 2; ++_i) \
        __builtin_amdgcn_global_load_lds((const unsigned*)((const char*)(gbase) + (voff)[_i]), (PG8_LAS unsigned*)(lds + (bufoff) + ldsw + _i * 8192), 16, 0, 0); } while (0)
#define PG8_LDA(dst, b, h) do { _Pragma("unroll") for (int m = 0; m < 4; ++m) _Pragma("unroll") for (int k = 0; k < 2; ++k) dst[m][k] = *(const PG8_LAS bf16x8*)(lds + PG8_SA(b, h) + aoff + m * 2048 + k * 1024); } while (0)
#define PG8_LDB(dst, b, h) do { _Pragma("unroll") for (int n = 0; n < 2; ++n) _Pragma("unroll") for (int k = 0; k < 2; ++k) dst[n][k] = *(const PG8_LAS bf16x8*)(lds + PG8_SB(b, h) + boff + n * 2048 + k * 1024); } while (0)
#define PG8_MMA(ai, bj, At, Bt) do { __builtin_amdgcn_s_setprio(1); _Pragma("unroll") for (int m = 0; m < 4; ++m) _Pragma("unroll") for (int n = 0; n < 2; ++n) _Pragma("unroll") for (int k = 0; k < 2; ++k) \
        acc[ai][bj][m][n] = __builtin_amdgcn_mfma_f32_16x16x32_bf16(Bt[n][k], At[m][k], acc[ai][bj][m][n], 0, 0, 0); __builtin_amdgcn_s_setprio(0); } while (0)
#define PG8_WAIT_V(n) asm volatile("s_waitcnt vmcnt(" #n ")" ::: "memory")
#define PG8_WAIT_L(n) asm volatile("s_waitcnt lgkmcnt(" #n ")" ::: "memory")
#define PG8_BAR __builtin_amdgcn_s_barrier()
#define PG8_SCHED __builtin_amdgcn_sched_barrier(0)
    Unit cur, nxt; int ui = 0;
    if (!S.next(0, cur)) return;
    if constexpr (Epi::TABLE) E.fill(cur, 0, tab, tid);
    f32x4 acc[2][2][4][2];
#pragma unroll
    for (int a = 0; a < 2; ++a)
#pragma unroll
        for (int b = 0; b < 2; ++b)
#pragma unroll
            for (int m = 0; m < 4; ++m)
#pragma unroll
                for (int n = 0; n < 2; ++n) acc[a][b][m][n] = (f32x4){0.f, 0.f, 0.f, 0.f};
    bf16x8 At[4][2], B0[2][2], B1[2][2];
    const char* cA = (const char*)g.A + (size_t)cur.pm * tstep; const char* cB = (const char*)g.Bt + (size_t)cur.pn * tstep;
    S.a_ready(cur);
    if constexpr (SP2) {
        PG8_STAGE(PG8_SB(0, 0), cB, voffB); PG8_STAGE(PG8_SB(0, 1), cB + hstep, voffB); PG8_STAGE(PG8_SA(0, 0), cA, voffA); PG8_STAGE(PG8_SA(0, 1), cA + hstep, voffA);
        if (wr == 1) PG8_BAR;
        PG8_WAIT_V(2); PG8_BAR;
        PG8_STAGE(PG8_SB(1, 0), cB + kstep, voffB); PG8_STAGE(PG8_SA(1, 0), cA + kstep, voffA); PG8_STAGE(PG8_SB(1, 1), cB + hstep + kstep, voffB);
        PG8_WAIT_V(6); PG8_BAR;
    } else {
        PG8_STAGE(PG8_SB(0, 0), cB, voffB); PG8_STAGE(PG8_SA(0, 0), cA, voffA); PG8_STAGE(PG8_SB(0, 1), cB + hstep, voffB); PG8_STAGE(PG8_SA(0, 1), cA + hstep, voffA);
        if (wr == 1) PG8_BAR;
        PG8_WAIT_V(4); PG8_BAR;
        PG8_STAGE(PG8_SB(1, 0), cB + kstep, voffB); PG8_STAGE(PG8_SA(1, 0), cA + kstep, voffA); PG8_STAGE(PG8_SB(1, 1), cB + hstep + kstep, voffB);
        PG8_WAIT_V(6); PG8_BAR;
    }
    for (;;) {
        const bool has_next = S.next(ui + 1, nxt);
        const char* nA = has_next ? (const char*)g.A + (size_t)nxt.pm * tstep : cA; const char* nB = has_next ? (const char*)g.Bt + (size_t)nxt.pn * tstep : cB;
        for (int t = 0; t < nt; t += 2) {
            const bool last = (t == nt - 2);
            if constexpr (Epi::MID) { if (t == (nt >> 1)) E.mid(acc, wr, fr, tab, ui & 1); }
            const char* a1 = cA + (size_t)(t + 1) * kstep;
            const char* a2 = last ? nA : cA + (size_t)(t + 2) * kstep; const char* b2 = last ? nB : cB + (size_t)(t + 2) * kstep;
            const char* a3 = a2 + kstep; const char* b3 = b2 + kstep;
            if (last && has_next) S.a_ready(nxt);
            if constexpr (SP2) {
            PG8_LDB(B0, 0, 0); PG8_LDB(B1, 0, 1); PG8_SCHED; PG8_LDA(At, 0, 0); PG8_STAGE(PG8_SA(1, 1), a1 + hstep, voffA);
            PG8_WAIT_V(8); PG8_WAIT_L(0); PG8_BAR; PG8_MMA(0, 0, At, B0); PG8_MMA(0, 1, At, B1); PG8_BAR; PG8_SCHED;
            PG8_LDA(At, 0, 1); PG8_STAGE(PG8_SB(0, 0), b2, voffB); PG8_STAGE(PG8_SB(0, 1), b2 + hstep, voffB); PG8_STAGE(PG8_SA(0, 0), a2, voffA);
            PG8_WAIT_V(8); PG8_WAIT_L(0); PG8_BAR; PG8_MMA(1, 0, At, B0); PG8_MMA(1, 1, At, B1); PG8_BAR; PG8_SCHED;
            PG8_LDB(B0, 1, 0); PG8_LDB(B1, 1, 1); PG8_SCHED; PG8_LDA(At, 1, 0); PG8_STAGE(PG8_SA(0, 1), a2 + hstep, voffA);
            PG8_WAIT_V(8); PG8_WAIT_L(0); PG8_BAR; PG8_MMA(0, 0, At, B0); PG8_MMA(0, 1, At, B1); PG8_BAR; PG8_SCHED;
            PG8_LDA(At, 1, 1); PG8_STAGE(PG8_SB(1, 0), b3, voffB); PG8_STAGE(PG8_SB(1, 1), b3 + hstep, voffB); PG8_STAGE(PG8_SA(1, 0), a3, voffA);
            PG8_WAIT_V(8); PG8_WAIT_L(0); PG8_BAR; PG8_MMA(1, 0, At, B0); PG8_MMA(1, 1, At, B1); PG8_BAR; PG8_SCHED;
            } else {
            PG8_LDB(B0, 0, 0); PG8_SCHED; PG8_LDA(At, 0, 0); PG8_STAGE(PG8_SA(1, 1), a1 + hstep, voffA);
            PG8_WAIT_L(8); PG8_BAR; PG8_WAIT_L(0); PG8_MMA(0, 0, At, B0); PG8_BAR; PG8_SCHED;
            PG8_LDB(B1, 0, 1); PG8_STAGE(PG8_SB(0, 0), b2, voffB);
            PG8_BAR; PG8_WAIT_L(0); PG8_MMA(0, 1, At, B1); PG8_BAR;
            PG8_LDA(At, 0, 1); PG8_STAGE(PG8_SA(0, 0), a2, voffA);
            PG8_BAR; PG8_WAIT_L(0); PG8_MMA(1, 0, At, B0); PG8_BAR; PG8_SCHED;
            PG8_STAGE(PG8_SB(0, 1), b2 + hstep, voffB);
            PG8_WAIT_V(6); PG8_BAR; PG8_MMA(1, 1, At, B1); PG8_BAR;
            PG8_LDB(B0, 1, 0); PG8_SCHED; PG8_LDA(At, 1, 0); PG8_STAGE(PG8_SA(0, 1), a2 + hstep, voffA);
            PG8_WAIT_L(8); PG8_BAR; PG8_WAIT_L(0); PG8_MMA(0, 0, At, B0); PG8_BAR; PG8_SCHED;
            PG8_LDB(B1, 1, 1); PG8_STAGE(PG8_SB(1, 0), b3, voffB);
            PG8_BAR; PG8_WAIT_L(0); PG8_MMA(0, 1, At, B1); PG8_BAR;
            PG8_LDA(At, 1, 1); PG8_STAGE(PG8_SA(1, 0), a3, voffA);
            PG8_BAR; PG8_WAIT_L(0); PG8_MMA(1, 0, At, B0); PG8_BAR; PG8_SCHED;
            PG8_STAGE(PG8_SB(1, 1), b3 + hstep, voffB);
            PG8_WAIT_V(6); PG8_BAR; PG8_MMA(1, 1, At, B1); PG8_BAR;
            }
        }
        if constexpr (ALIGN_EPI) { if (wr == 0) PG8_BAR; }
        if constexpr (!Epi::AFTER_DRAIN) { int tid_e = threadIdx.x; asm volatile("" : "+v"(tid_e)); const int lane_e = tid_e & 63;
            E(acc, cur, wr, wc, lane_e & 15, lane_e >> 4, tab, ui & 1); S.done(cur); }
        if (!has_next) break;
#pragma unroll
        for (int a = 0; a < 2; ++a)
#pragma unroll
            for (int b = 0; b < 2; ++b)
#pragma unroll
                for (int m = 0; m < 4; ++m)
#pragma unroll
                    for (int n = 0; n < 2; ++n) acc[a][b][m][n] = (f32x4){0.f, 0.f, 0.f, 0.f};
        cur = nxt; cA = nA; cB = nB; ++ui;
        if constexpr (Epi::TABLE) E.fill(cur, ui & 1, tab, tid);
        if constexpr (ALIGN_EPI) { if (wr == 1) PG8_BAR; }
    }
    PG8_WAIT_V(0);
    if constexpr (!ALIGN_EPI) { if (wr == 0) PG8_BAR; }
    PG8_BAR;
    if constexpr (Epi::AFTER_DRAIN) { E.fused(acc, cur, wr, wc, fr, fq, lds, wid, lane); S.done(cur); }
#undef PG8_SA
#undef PG8_SB
#undef PG8_STAGE
#undef PG8_LDA
#undef PG8_LDB
#undef PG8_MMA
#undef PG8_WAIT_V
#undef PG8_WAIT_L
#undef PG8_BAR
#undef PG8_SCHED
}
}
#define GAS __attribute__((address_space(1)))
#define LAS __attribute__((address_space(3)))
typedef unsigned short bf16;
typedef unsigned v4u __attribute__((ext_vector_type(4)));
typedef float f32x4 __attribute__((ext_vector_type(4)));
typedef short bf16x8 __attribute__((ext_vector_type(8)));
typedef GAS unsigned gu32;
typedef GAS unsigned long long gu64;
#define RLX_AGENT __ATOMIC_RELAXED, __HIP_MEMORY_SCOPE_AGENT
#define LDS_WAIT() asm volatile("s_waitcnt lgkmcnt(0)" ::: "memory")
#define VM_WAIT() asm volatile("s_waitcnt vmcnt(0)" ::: "memory")
__device__ __forceinline__ unsigned long long rt() { return __builtin_amdgcn_s_memrealtime(); }
__device__ __forceinline__ unsigned f2bf(float f) { unsigned u = __builtin_bit_cast(unsigned, f); return (u + 0x7fffu + ((u >> 16) & 1u)) >> 16; }
__device__ __forceinline__ unsigned pk2(float lo, float hi) { return f2bf(lo) | (f2bf(hi) << 16); }

#define XB_TMO      128
#define XB_XCNT(j)  (256  + 64 * (j))
#define XB_XSUB(j)  (1280 + 64 * (j))
#define XB_XGEN(j)  (2304 + 64 * (j))
#define XB_TOP      3328
#define XB_TOPGEN   3392
#define XCD_BAR_WORDS 3456
#define XB_SPIN_CAP (1u << 18)

__device__ __forceinline__ unsigned xb_ld(unsigned* p)              { return __hip_atomic_load(p, __ATOMIC_RELAXED, __HIP_MEMORY_SCOPE_AGENT); }
__device__ __forceinline__ unsigned xb_add(unsigned* p, unsigned v) { return __hip_atomic_fetch_add(p, v, __ATOMIC_RELAXED, __HIP_MEMORY_SCOPE_AGENT); }
__device__ __forceinline__ unsigned xb_xcc_id() { return (unsigned)__builtin_amdgcn_s_getreg((3 << 11) | 20) & 0xFu; }
#define XB_SPIN(cond, bar) do { unsigned _sp = 0; while (cond) { __builtin_amdgcn_s_sleep(1); \
    if ((++_sp & 255u) == 0u) { if (xb_ld(&(bar)[XB_TMO])) break; if (_sp > XB_SPIN_CAP) { atomicAdd(&(bar)[XB_TMO], 1u); break; } } } } while (0)

struct XcdBarrier {
    unsigned* bar; unsigned x;
    volatile LAS unsigned* st;
};

__device__ __forceinline__ XcdBarrier xcd_barrier_post(unsigned* bar, volatile LAS unsigned* st) {
    XcdBarrier b; b.bar = bar; b.x = xb_xcc_id(); b.st = st;
    if (threadIdx.x == 0) (void)xb_add(&bar[XB_XCNT(b.x)], 1u);
    return b;
}
__device__ __forceinline__ void xcd_barrier_complete(unsigned* bar, unsigned x, unsigned& nloc, unsigned& nx) {
    const unsigned G = gridDim.x * gridDim.y * gridDim.z;
    unsigned sum, cnt, mine, sp = 0u;
    for (;;) {
        sum = 0u; cnt = 0u; mine = 0u;
#pragma unroll
        for (unsigned j = 0; j < 16; ++j) { const unsigned c = xb_ld(&bar[XB_XCNT(j)]); sum += c; cnt += (c > 0u) ? 1u : 0u; mine = (j == x) ? c : mine; }
        if (sum == G) break;
        __builtin_amdgcn_s_sleep(1);
        if ((++sp & 255u) == 0u) { if (xb_ld(&bar[XB_TMO])) break; if (sp > XB_SPIN_CAP) { atomicAdd(&bar[XB_TMO], 1u); break; } }
    }
    nloc = mine > 0u ? mine : 1u; nx = cnt > 0u ? cnt : 1u;
}

__device__ __forceinline__ void xcd_barrier(const XcdBarrier& b) {
    asm volatile("s_waitcnt vmcnt(0)" ::: "memory");
    __syncthreads();
    if (threadIdx.x == 0) {
        unsigned* bar = b.bar;
        __builtin_amdgcn_s_waitcnt(0);
        unsigned nloc = b.st[0], nx = b.st[1];
        if (nloc == 0u) { xcd_barrier_complete(bar, b.x, nloc, nx); b.st[0] = nloc; b.st[1] = nx; }
        const unsigned old = xb_add(&bar[XB_XSUB(b.x)], 1u);
        const unsigned gen = old / nloc;
        if (old + 1u == (gen + 1u) * nloc) {
            __builtin_amdgcn_fence(__ATOMIC_RELEASE, "agent");
            asm volatile("s_waitcnt vmcnt(0)" ::: "memory");
            const unsigned og = xb_add(&bar[XB_TOP], 1u);
            const unsigned tg = og / nx;
            if (og + 1u == (tg + 1u) * nx) xb_add(&bar[XB_TOPGEN], 1u);
            else XB_SPIN(xb_ld(&bar[XB_TOPGEN]) == tg, bar);
            __builtin_amdgcn_fence(__ATOMIC_ACQUIRE, "agent");
            xb_add(&bar[XB_XGEN(b.x)], 1u);
            asm volatile("s_waitcnt vmcnt(0)" ::: "memory");
        } else {
            XB_SPIN(xb_ld(&bar[XB_XGEN(b.x)]) == gen, bar);
            __builtin_amdgcn_fence(__ATOMIC_ACQUIRE, "agent");
            asm volatile("s_waitcnt vmcnt(0)" ::: "memory");
        }
    }
    __syncthreads();
}

constexpr int NWAVES = 8;
#ifndef MK_N_LAUNCHES
#define MK_N_LAUNCHES 1
#endif
constexpr int N_LAUNCHES = MK_N_LAUNCHES;
constexpr int NPHASE = 8;
static_assert(N_LAUNCHES == 1 || N_LAUNCHES == NPHASE, "MK_N_LAUNCHES is 1 or NPHASE");

constexpr int BATCH = 8, SEQ = 4096, D = 1024, NH = 16, HD = 64, FF = 4096, PLE = 256;
constexpr int M = BATCH * SEQ;
constexpr int NQKV = 3 * D;
constexpr float EPS = 1e-6f;
constexpr float LOG2E = 1.4426950408889634f;
constexpr float C2 = 0.125f * LOG2E;

constexpr size_t MiB = 1u << 20;
constexpr size_t WS_CTL = 0, CTL_ZERO_BYTES = 64 * 1024;
constexpr size_t WS_WQKV = 1 * MiB, WS_WO = 7 * MiB, WS_WUP = 9 * MiB, WS_WDN = 17 * MiB, WS_WG = 25 * MiB, WS_WP = 27 * MiB;
constexpr size_t WS_SSQ0 = 28 * MiB, WS_SSQ1 = 30 * MiB, WS_SSQ2 = 32 * MiB, WS_SSQ3 = 34 * MiB;
constexpr size_t WS_KPART = 36 * MiB;
constexpr size_t WS_PB = 40 * MiB;
constexpr size_t WS_PP = 56 * MiB;
constexpr size_t WS_XN = 120 * MiB;
constexpr size_t WS_Q = 184 * MiB, WS_K = 248 * MiB, WS_V = 312 * MiB, WS_O = 376 * MiB;
constexpr size_t WS_U = 184 * MiB;
constexpr size_t WS_END = 440 * MiB;
constexpr int CW_BAR = 1024;

constexpr int RING_OFF = 0, RING_BYTES = 131072;
constexpr int LDSCTL_OFF = RING_BYTES, MISC_OFF = LDSCTL_OFF + 320;
constexpr int TAB_OFF = RING_BYTES + 1024;
constexpr int LDS_BYTES = 147456;
static_assert(TAB_OFF + 4096 <= LDS_BYTES, "LDS map");

struct Frame {
    LAS unsigned char* lds;
    volatile LAS unsigned* MISC;
    gu32* ctl;
    int tid, lane, wave;
    int vcu, G;
    const float *x, *p, *g_attn, *w_in, *g_out_a, *g_out_b, *w_out, *g_mlp, *w_up, *w_down, *g_ple, *w_gate, *b_gate, *w_proj, *g_final;
    float* out;
    bf16 *Wqkv_t, *Wo_t, *Wup_t, *Wdn_t, *Wg_t, *Wp_t;
    bf16 *XN, *QB, *KB, *VB, *OB, *UB, *PB, *PP;
    float *ssq0, *ssq1, *ssq2, *ssq3, *kpart;
};

__device__ __forceinline__ float wave_sum(float v) {
#pragma unroll
    for (int o = 1; o < 64; o <<= 1) v += __shfl_xor(v, o);
    return v;
}
__device__ __forceinline__ void p0_transpose_item(const float* W, int K, int N, bf16* dst, const float* g, LAS float* scr, int k0, int n0, int lane) {
#pragma unroll 8
    for (int i = 0; i < 32; ++i) { const int kk = 2 * i + (lane >> 5); float v = W[(size_t)(k0 + kk) * N + n0 + (lane & 31)]; if (g) v *= g[k0 + kk]; scr[kk * 33 + (lane & 31)] = v; }
    LDS_WAIT(); asm volatile("" ::: "memory");
    const int c = lane & 7;
#pragma unroll
    for (int j = 0; j < 4; ++j) { const int n = (lane >> 3) + 8 * j; const LAS float* s = scr + (8 * c) * 33 + n;
        v4u o; o.x = pk2(s[0 * 33], s[1 * 33]); o.y = pk2(s[2 * 33], s[3 * 33]); o.z = pk2(s[4 * 33], s[5 * 33]); o.w = pk2(s[6 * 33], s[7 * 33]);
        *(GAS v4u*)(dst + (size_t)n * K + k0 + 8 * c) = o; }
    LDS_WAIT(); asm volatile("" ::: "memory");
}
__device__ __forceinline__ int qkv_dst_row(int n0) {
    if (n0 < 1536) return (n0 / 512) * 1024 + (n0 % 512);
    const int n1 = n0 - 1536; return (n1 / 512) * 1024 + 512 + (n1 % 512);
}
__device__ __forceinline__ void p0_prologue(Frame& F) {
    LAS float* scr = (LAS float*)(F.lds + RING_OFF + F.wave * 16384);
    const int gw = F.vcu * NWAVES + F.wave, NGW = F.G * NWAVES;
    constexpr int I_IN = (D / 64) * (NQKV / 32), I_O = (D / 64) * (D / 32), I_UP = (D / 64) * (FF / 32), I_DN = (FF / 64) * (D / 32), I_G = I_O, I_P = (PLE / 64) * (D / 32);
    constexpr int NITEMS = I_IN + I_O + I_UP + I_DN + I_G + I_P;
    for (int it = gw; it < NITEMS; it += NGW) {
        int r = it;
        if (r < I_IN) { const int nb = r % (NQKV / 32), kb = r / (NQKV / 32); p0_transpose_item(F.w_in, D, NQKV, F.Wqkv_t + (size_t)qkv_dst_row(32 * nb) * D, F.g_attn, scr, 64 * kb, 32 * nb, F.lane); continue; } r -= I_IN;
        if (r < I_O) { const int nb = r % (D / 32), kb = r / (D / 32); const float* g = (64 * kb < 512) ? F.g_out_a : (F.g_out_b - 512);
            p0_transpose_item(F.w_out, D, D, F.Wo_t + (size_t)(32 * nb) * D, g, scr, 64 * kb, 32 * nb, F.lane); continue; } r -= I_O;
        if (r < I_UP) { const int nb = r % (FF / 32), kb = r / (FF / 32); p0_transpose_item(F.w_up, D, FF, F.Wup_t + (size_t)(32 * nb) * D, F.g_mlp, scr, 64 * kb, 32 * nb, F.lane); continue; } r -= I_UP;
        if (r < I_DN) { const int nb = r % (D / 32), kb = r / (D / 32); p0_transpose_item(F.w_down, FF, D, F.Wdn_t + (size_t)(32 * nb) * FF, nullptr, scr, 64 * kb, 32 * nb, F.lane); continue; } r -= I_DN;
        if (r < I_G) { const int nb = r % (D / 32), kb = r / (D / 32); p0_transpose_item(F.w_gate, D, D, F.Wg_t + (size_t)(32 * nb) * D, F.g_ple, scr, 64 * kb, 32 * nb, F.lane); continue; } r -= I_G;
        { const int nb = r % (D / 32), kb = r / (D / 32); p0_transpose_item(F.w_proj, PLE, D, F.Wp_t + (size_t)(32 * nb) * PLE, nullptr, scr, 64 * kb, 32 * nb, F.lane); }
    }
    for (int m = gw; m < M; m += NGW) {
        const GAS f32x4* xr = (const GAS f32x4*)(F.x + (size_t)m * D) + F.lane;
        f32x4 v[4]; float s = 0.f;
#pragma unroll
        for (int j = 0; j < 4; ++j) { v[j] = xr[64 * j]; s += (v[j].x * v[j].x + v[j].y * v[j].y) + (v[j].z * v[j].z + v[j].w * v[j].w); }
        const float rstd = 1.f / sqrtf(wave_sum(s) * (1.f / D) + EPS);
        GAS unsigned long long* o8 = (GAS unsigned long long*)(F.XN + (size_t)m * D) + F.lane;
#pragma unroll
        for (int j = 0; j < 4; ++j) o8[64 * j] = (unsigned long long)pk2(v[j].x * rstd, v[j].y * rstd) | ((unsigned long long)pk2(v[j].z * rstd, v[j].w * rstd) << 32);
        const f32x4 pv = ((const GAS f32x4*)(F.p + (size_t)m * PLE))[F.lane];
        ((GAS unsigned long long*)(F.PB + (size_t)m * PLE))[F.lane] = (unsigned long long)pk2(pv.x, pv.y) | ((unsigned long long)pk2(pv.z, pv.w) << 32);
    }
}

__device__ __forceinline__ float bf2f(unsigned short h) { return __uint_as_float((unsigned)h << 16); }
__device__ __forceinline__ void naive_key(const bf16* kp, const bf16* vp, const float (&q)[64], float bias, float& mx, float& l, float (&acc)[64]) {
    float s = 0.f;
#pragma unroll
    for (int c = 0; c < 8; ++c) { const v4u kw = *(const v4u*)(kp + 8 * c);
        s += q[8 * c + 0] * __uint_as_float(kw.x << 16) + q[8 * c + 1] * __uint_as_float(kw.x & 0xffff0000u) + q[8 * c + 2] * __uint_as_float(kw.y << 16) + q[8 * c + 3] * __uint_as_float(kw.y & 0xffff0000u)
           + q[8 * c + 4] * __uint_as_float(kw.z << 16) + q[8 * c + 5] * __uint_as_float(kw.z & 0xffff0000u) + q[8 * c + 6] * __uint_as_float(kw.w << 16) + q[8 * c + 7] * __uint_as_float(kw.w & 0xffff0000u); }
    s += bias;
    const float mn = fmaxf(mx, s), sc = __builtin_amdgcn_exp2f(mx - mn), pe = __builtin_amdgcn_exp2f(s - mn);
    mx = mn; l = l * sc + pe;
#pragma unroll
    for (int c = 0; c < 8; ++c) { const v4u vw = *(const v4u*)(vp + 8 * c);
        acc[8 * c + 0] = acc[8 * c + 0] * sc + pe * __uint_as_float(vw.x << 16); acc[8 * c + 1] = acc[8 * c + 1] * sc + pe * __uint_as_float(vw.x & 0xffff0000u);
        acc[8 * c + 2] = acc[8 * c + 2] * sc + pe * __uint_as_float(vw.y << 16); acc[8 * c + 3] = acc[8 * c + 3] * sc + pe * __uint_as_float(vw.y & 0xffff0000u);
        acc[8 * c + 4] = acc[8 * c + 4] * sc + pe * __uint_as_float(vw.z << 16); acc[8 * c + 5] = acc[8 * c + 5] * sc + pe * __uint_as_float(vw.z & 0xffff0000u);
        acc[8 * c + 6] = acc[8 * c + 6] * sc + pe * __uint_as_float(vw.w << 16); acc[8 * c + 7] = acc[8 * c + 7] * sc + pe * __uint_as_float(vw.w & 0xffff0000u); }
}
__device__ __forceinline__ void attn_naive(Frame& F) {
    const long NT = (long)F.G * NWAVES * 64;
    for (long idx = (long)blockIdx.x * (NWAVES * 64) + F.tid; idx < (long)M * NH; idx += NT) {
        const int tok = (int)(idx % M), hh = (int)(idx / M); const int b = tok / SEQ, t = tok % SEQ; const int grp = hh >> 3, h = hh & 7;
        float q[64], acc[64]; float mx = -1e30f, l = 0.f;
#pragma unroll
        for (int d = 0; d < 64; ++d) acc[d] = 0.f;
        if (grp == 0) {
            const float sl2 = exp2f(-0.5f * (float)(2 * h + 1)) * LOG2E;
            const size_t qrow = (size_t)b * SEQ + (size_t)(t & 3) * 1024 + (t >> 2);
            const bf16* qp = F.QB + qrow * D + h * 64;
#pragma unroll
            for (int d = 0; d < 64; ++d) q[d] = bf2f(qp[d]);
            for (int br = 0; br < 3; ++br) { const int dil = br == 0 ? 1 : (br == 1 ? 4 : 16);
                for (int mm = 0; mm <= 128; ++mm) { const int key = t - dil * mm; if (key < 0) break;
                    const size_t krow = (size_t)b * SEQ + (size_t)(key & 3) * 1024 + (key >> 2);
                    naive_key(F.KB + krow * D + h * 64, F.VB + krow * D + h * 64, q, -sl2 * (float)(dil * mm), mx, l, acc); } }
        } else {
            const float sl2 = exp2f(-(float)(h + 1)) * LOG2E;
            const bf16* qp = F.QB + (size_t)tok * D + 512 + h * 64;
#pragma unroll
            for (int d = 0; d < 64; ++d) q[d] = bf2f(qp[d]);
            const int own = t >> 8; int i0 = -1, i1 = -1, i2 = -1; float g0 = -INFINITY, g1 = -INFINITY, g2 = -INFINITY;
            for (int n = 0; n < own; ++n) { const float* k0 = F.kpart + (size_t)((b * 16 + n) * 2) * 512 + h * 64; const float* k1 = k0 + 512; float g = 0.f;
#pragma unroll
                for (int d = 0; d < 64; ++d) g += q[d] * (k0[d] + k1[d]);
                if (g > g0) { g2 = g1; i2 = i1; g1 = g0; i1 = i0; g0 = g; i0 = n; } else if (g > g1) { g2 = g1; i2 = i1; g1 = g; i1 = n; } else if (g > g2) { g2 = g; i2 = n; } }
            for (int j = 0; j < 4; ++j) { const int n = j == 0 ? i0 : (j == 1 ? i1 : (j == 2 ? i2 : own)); if (n < 0) continue;
                const int kend = (j == 3) ? t : 256 * n + 255;
                for (int key = 256 * n; key <= kend; ++key) { const size_t krow = (size_t)b * SEQ + key;
                    naive_key(F.KB + krow * D + 512 + h * 64, F.VB + krow * D + 512 + h * 64, q, -sl2 * (float)(t - key), mx, l, acc); } }
        }
        const float rl = 1.0f / l; float ss = 0.f; bf16* op = F.OB + (size_t)tok * D + grp * 512 + h * 64;
#pragma unroll
        for (int d = 0; d < 64; d += 2) { const float a = acc[d] * rl, c = acc[d + 1] * rl; ss += a * a + c * c; *(unsigned*)(op + d) = pk2(a, c); }
        F.ssq0[(size_t)tok * 16 + hh] = ss;
    }
}


namespace att {
typedef short bf16x8 __attribute__((ext_vector_type(8)));
typedef short s16x4 __attribute__((ext_vector_type(4)));
typedef float f32x16 __attribute__((ext_vector_type(16)));
typedef unsigned u32x4 __attribute__((ext_vector_type(4)));
typedef LAS const char* lds_cptr;
constexpr int NSLOT = 4, SLOTB = 8192;
constexpr int L_K = 0, L_V = NSLOT * SLOTB, L_WS = 2 * NSLOT * SLOTB, L_OST = L_WS + 8 * 256, L_TAB = L_OST + 8 * 4096, L_END = L_TAB + 16384;
static_assert(L_END <= RING_BYTES, "attention LDS map");
typedef short v4i16_t __attribute__((ext_vector_type(4)));
#define ATT_NEG (-INFINITY)
__device__ __forceinline__ int crow(int r, int hi) { return (r & 3) + 8 * (r >> 2) + 4 * hi; }
__device__ __forceinline__ void glds16(const void* gsrc, unsigned lds_dst) { unsigned keep;
    asm volatile("s_mov_b32 %0, m0\n\ts_mov_b32 m0, %2\n\ts_nop 0\n\tglobal_load_lds_dwordx4 %1, off\n\ts_mov_b32 m0, %0" : "=&s"(keep) : "v"(gsrc), "s"(lds_dst) : "memory"); }
typedef float f32x2_t __attribute__((ext_vector_type(2))); typedef __bf16 bf16x2_t __attribute__((ext_vector_type(2)));
__device__ __forceinline__ unsigned cvtpk_s(float lo, float hi) { f32x2_t v = {lo, hi}; bf16x2_t b = __builtin_convertvector(v, bf16x2_t); return __builtin_bit_cast(unsigned, b); }
#define ATT_WAIT_BAR(N) asm volatile("s_waitcnt vmcnt(" #N ") lgkmcnt(0)\n\ts_barrier" ::: "memory")
#define ATT_SBAR() __builtin_amdgcn_sched_barrier(0)

__device__ __forceinline__ void qkt(f32x16& p0, f32x16& p1, lds_cptr kb, const bf16x8 (&qr)[4]) {
#pragma unroll
    for (int d0 = 0; d0 < 4; ++d0) {
        const bf16x8 b0 = *(LAS const bf16x8*)(kb + d0 * 2048);
        const bf16x8 b1 = *(LAS const bf16x8*)(kb + d0 * 2048 + 512);
        p0 = __builtin_amdgcn_mfma_f32_32x32x16_bf16(b0, qr[d0], p0, 0, 0, 0);
        p1 = __builtin_amdgcn_mfma_f32_32x32x16_bf16(b1, qr[d0], p1, 0, 0, 0); }
}
__device__ __forceinline__ void pv(f32x16 (&o)[2], int vb, bf16x8 pa0, bf16x8 pa1, bf16x8 pa2, bf16x8 pa3) {
#pragma unroll
    for (int d0 = 0; d0 < 2; ++d0) { s16x4 lo[4], hi[4];
#pragma unroll
        for (int ks = 0; ks < 4; ++ks) {
            asm volatile("ds_read_b64_tr_b16 %0,%1 offset:%c2" : "=&v"(lo[ks]) : "v"(vb), "i"(d0 * 4096 + ks * 1024) : "memory");
            asm volatile("ds_read_b64_tr_b16 %0,%1 offset:%c2" : "=&v"(hi[ks]) : "v"(vb), "i"(d0 * 4096 + ks * 1024 + 512) : "memory"); }
        asm volatile("s_waitcnt lgkmcnt(0)" ::: "memory"); ATT_SBAR();
#define ATT_PK(k) (bf16x8){lo[k][0], lo[k][1], lo[k][2], lo[k][3], hi[k][0], hi[k][1], hi[k][2], hi[k][3]}
        o[d0] = __builtin_amdgcn_mfma_f32_32x32x16_bf16(pa0, ATT_PK(0), o[d0], 0, 0, 0);
        o[d0] = __builtin_amdgcn_mfma_f32_32x32x16_bf16(pa1, ATT_PK(1), o[d0], 0, 0, 0);
        o[d0] = __builtin_amdgcn_mfma_f32_32x32x16_bf16(pa2, ATT_PK(2), o[d0], 0, 0, 0);
        o[d0] = __builtin_amdgcn_mfma_f32_32x32x16_bf16(pa3, ATT_PK(3), o[d0], 0, 0, 0);
#undef ATT_PK
    }
}

struct PolA {
    int b, r, T0, NT, NT_own, jmin, jpmin, per, iq;
    LAS const float* tab; int hi;
    __device__ __forceinline__ void init(int b_, int r_, int Tblk, int wid, int r32, int hi_, LAS const float* tab_) {
        b = b_; r = r_; T0 = 256 * Tblk; jmin = T0 >= 512 ? 0 : (512 - T0) / 64; NT_own = 12 - jmin; jpmin = T0 == 0 ? 1 : 0; per = 5 - jpmin; NT = NT_own + 3 * per;
        iq = T0 + 32 * wid + r32; tab = tab_; hi = hi_; }
    __device__ __forceinline__ void tile(int t, int& rho, int& ik0, int& k) const {
        if (t < NT_own) { k = 0; rho = r; ik0 = T0 - 512 + 64 * (jmin + t); }
        else { const int tp = t - NT_own; k = 1 + tp / per; rho = (r + k) & 3; ik0 = T0 - 64 + 64 * (jpmin + tp % per); } }
    __device__ __forceinline__ long row0(int t) const { int rho, ik0, k; tile(t, rho, ik0, k); return (long)b * SEQ + rho * 1024 + ik0; }
    __device__ __forceinline__ long qrow(int wid, int r32) const { return (long)b * SEQ + r * 1024 + T0 + 32 * wid + r32; }
    __device__ __forceinline__ long orow(int wid, int row) const { return (long)b * SEQ + 4 * (T0 + 32 * wid + row) + r; }
    __device__ __forceinline__ bool active(int t, int wid) const {
        int rho, ik0, k; tile(t, rho, ik0, k); const int dmax = T0 + 32 * wid + 31 - ik0, dmin = T0 + 32 * wid - ik0 - 63; return dmax >= 0 && dmin <= (k == 0 ? 512 : 32); }
    __device__ __forceinline__ void cinit(int t, f32x16& p0, f32x16& p1) const {
        int rho, ik0, k; tile(t, rho, ik0, k);
        LAS const float* tb = tab + (k == 0 ? 0 : 1024 + (k - 1) * 576) + (iq - ik0 - 4 * hi + 256 - 63);
#pragma unroll
        for (int rr = 0; rr < 16; ++rr) { const int c = (rr & 3) + 8 * (rr >> 2); p0[rr] = tb[63 - c]; p1[rr] = tb[31 - c]; }
    }
};
__device__ __forceinline__ void fill_tab_A(LAS float* tab, int h, int r, int tid) {
    const float sl2 = exp2f(-0.5f * (float)(2 * h + 1)) * LOG2E;
    for (int idx = tid; idx < 1024; idx += NWAVES * 64) { const int dl = idx - 256; float v = ATT_NEG;
        if (dl >= 0 && dl <= 512) { const int w = (dl <= 32 ? 1 : 0) + (dl <= 128 ? 1 : 0) + ((dl & 3) == 0 ? 1 : 0);
            if (w > 0) v = (w == 1 ? 0.f : (w == 2 ? 1.f : 1.5849625007211562f)) - sl2 * (float)(4 * dl); }
        tab[idx] = v; }
    for (int idx = tid; idx < 3 * 576; idx += NWAVES * 64) { const int k = 1 + idx / 576, dl = idx % 576 - 256; const int rho = (r + k) & 3; const int dist = 4 * dl + (r - rho);
        tab[1024 + idx] = (dist >= 0 && dist <= 128) ? -sl2 * (float)dist : ATT_NEG; }
}

struct PolB {
    int b, i, NT, dq0, hi; unsigned sel; float sl2;
    __device__ __forceinline__ long row0(int t) const { return (long)b * SEQ + 64 * t; }
    __device__ __forceinline__ long qrow(int wid, int r32) const { return (long)b * SEQ + 256 * i + 32 * wid + r32; }
    __device__ __forceinline__ long orow(int wid, int row) const { return (long)b * SEQ + 256 * i + 32 * wid + row; }
    __device__ __forceinline__ bool active(int t, int) const { return __any((int)((sel >> (t >> 2)) & 1u)) != 0; }
    __device__ __forceinline__ void cinit(int t, f32x16& p0, f32x16& p1) const {
        const int dqi = 64 * t + dq0;
        float base = sl2 * (float)dqi; if (!((sel >> (t >> 2)) & 1u)) base = ATT_NEG;
        const float base1 = base + 32.0f * sl2;
#pragma unroll
        for (int rr = 0; rr < 16; ++rr) { const int c = (rr & 3) + 8 * (rr >> 2); p0[rr] = base + sl2 * (float)c; p1[rr] = base1 + sl2 * (float)c; }
        if (t >= 4 * i) {
            asm volatile("; causal band tile" ::: "memory");
#pragma unroll
            for (int rr = 0; rr < 16; ++rr) { const int c = (rr & 3) + 8 * (rr >> 2); if (dqi + c > 0) p0[rr] = ATT_NEG; if (dqi + c + 32 > 0) p1[rr] = ATT_NEG; }
        }
    }
    __device__ __forceinline__ void select(const bf16x8 (&qr)[4], LAS const float* km) {
        float qf[32];
#pragma unroll
        for (int d0 = 0; d0 < 4; ++d0)
#pragma unroll
            for (int j = 0; j < 8; ++j) qf[8 * d0 + j] = __uint_as_float((unsigned)(unsigned short)qr[d0][j] << 16);
        int i0 = -1, i1 = -1, i2 = -1; float g0 = ATT_NEG, g1 = ATT_NEG, g2 = ATT_NEG;
        for (int n = 0; n < i; ++n) { float g = 0.f;
#pragma unroll
            for (int d0 = 0; d0 < 4; ++d0) { const f32x4 ka = *(LAS const f32x4*)(km + n * 64 + 16 * d0 + 8 * hi), kb = *(LAS const f32x4*)(km + n * 64 + 16 * d0 + 8 * hi + 4);
                g += (qf[8 * d0 + 0] * ka.x + qf[8 * d0 + 1] * ka.y) + (qf[8 * d0 + 2] * ka.z + qf[8 * d0 + 3] * ka.w) + (qf[8 * d0 + 4] * kb.x + qf[8 * d0 + 5] * kb.y) + (qf[8 * d0 + 6] * kb.z + qf[8 * d0 + 7] * kb.w); }
            g += __shfl_xor(g, 32);
            if (g > g0) { g2 = g1; i2 = i1; g1 = g0; i1 = i0; g0 = g; i0 = n; } else if (g > g1) { g2 = g1; i2 = i1; g1 = g; i1 = n; } else if (g > g2) { g2 = g; i2 = n; } }
        sel = 1u << i; if (i0 >= 0) sel |= 1u << i0; if (i1 >= 0) sel |= 1u << i1; if (i2 >= 0) sel |= 1u << i2;
    }
};

template <class P, bool SELECT>
__device__ __forceinline__ void attn_unit(P& pol, const bf16* Qc, const bf16* Kc, const bf16* Vc, bf16* Oc, float* ssq, int hh, LAS unsigned char* shm, LAS const float* km) {
    int tid = threadIdx.x; asm volatile("" : "+v"(tid)); const int lane = tid & 63, r32 = lane & 31, hi = lane >> 5; const int wid = __builtin_amdgcn_readfirstlane(tid >> 6);
    const unsigned lds0 = (unsigned)(uintptr_t)shm;
    LAS float* wsf = (LAS float*)(shm + L_WS) + wid * 64;
    const int NT = pol.NT;
    const bf16* ksrc = Kc + (long)lane * D + wid * 8;
    const bf16* vsrc = Vc + (long)(16 * (wid & 3) + (lane >> 2)) * D + (wid >> 2) * 32 + (lane & 3) * 8;
    const unsigned kdst = lds0 + L_K + wid * 1024, vdst = lds0 + L_V + wid * 1024;
#define ATT_DMA(t, slot) do { const long r0_ = pol.row0(t); glds16(ksrc + r0_ * D, (unsigned)__builtin_amdgcn_readfirstlane(kdst + (slot))); glds16(vsrc + r0_ * D, (unsigned)__builtin_amdgcn_readfirstlane(vdst + (slot))); } while (0)
    bf16x8 qr[4];
    { const bf16* qp = Qc + pol.qrow(wid, r32) * D + hi * 8;
#pragma unroll
      for (int d0 = 0; d0 < 4; ++d0) qr[d0] = *(const bf16x8*)(qp + d0 * 16); }
    ATT_DMA(0, 0); ATT_DMA(1, SLOTB); ATT_DMA(2, 2 * SLOTB);
    if constexpr (SELECT) pol.select(qr, km);
    f32x16 o[2]; o[0] = f32x16{}; o[1] = f32x16{}; float l_reg = 0.f;
    const lds_cptr kp0 = (lds_cptr)shm + L_K + hi * 1024 + r32 * 16;
    const int vb0 = (int)(lds0 + L_V) + ((lane >> 4) & 1) * 32 + (lane & 3) * 8 + (4 * hi + ((lane & 15) >> 2)) * 64;
#define ATT_EXP(P0, P1) do { _Pragma("unroll") for (int rr = 0; rr < 16; ++rr) { P0[rr] = __builtin_amdgcn_exp2f(P0[rr]); P1[rr] = __builtin_amdgcn_exp2f(P1[rr]); } } while (0)
#define ATT_SOFTMAX_PV(P0, P1, slotoff) do { float sacc = 0.f; \
        _Pragma("unroll") for (int rr = 0; rr < 16; ++rr) { sacc += P0[rr] + P1[rr]; } \
        l_reg += sacc; \
        const u32x4 pw0 = (u32x4){cvtpk_s(P0[0], P0[1]), cvtpk_s(P0[2], P0[3]), cvtpk_s(P0[4], P0[5]), cvtpk_s(P0[6], P0[7])}; \
        const u32x4 pw1 = (u32x4){cvtpk_s(P0[8], P0[9]), cvtpk_s(P0[10], P0[11]), cvtpk_s(P0[12], P0[13]), cvtpk_s(P0[14], P0[15])}; \
        const u32x4 pw2 = (u32x4){cvtpk_s(P1[0], P1[1]), cvtpk_s(P1[2], P1[3]), cvtpk_s(P1[4], P1[5]), cvtpk_s(P1[6], P1[7])}; \
        const u32x4 pw3 = (u32x4){cvtpk_s(P1[8], P1[9]), cvtpk_s(P1[10], P1[11]), cvtpk_s(P1[12], P1[13]), cvtpk_s(P1[14], P1[15])}; \
        ATT_SBAR(); pv(o, vb0 + (slotoff), __builtin_bit_cast(bf16x8, pw0), __builtin_bit_cast(bf16x8, pw1), __builtin_bit_cast(bf16x8, pw2), __builtin_bit_cast(bf16x8, pw3)); ATT_SBAR(); } while (0)
#define ATT_BODY(PC0, PC1, PN0, PN1, t) do { \
        if ((t) + 2 < NT) { ATT_WAIT_BAR(2); } else { ATT_WAIT_BAR(0); } \
        if ((t) + 3 < NT) ATT_DMA((t) + 3, (((t) + 3) & 3) * SLOTB); \
        const bool an_ = ((t) + 1 < NT) && pol.active((t) + 1, wid); const int tn_ = ((t) + 1 < NT) ? (t) + 1 : (t); \
        if (acur || an_) { pol.cinit(tn_, PN0, PN1); ATT_SBAR(); qkt(PN0, PN1, kp0 + (tn_ & 3) * SLOTB, qr); ATT_EXP(PC0, PC1); ATT_SBAR(); ATT_SOFTMAX_PV(PC0, PC1, ((t) & 3) * SLOTB); } \
        else { _Pragma("unroll") for (int rr = 0; rr < 16; ++rr) { PN0[rr] = ATT_NEG; PN1[rr] = ATT_NEG; } } \
        acur = an_; } while (0)
    f32x16 pA0, pA1, pB0, pB1;
    asm volatile("s_waitcnt vmcnt(4) lgkmcnt(0)\n\ts_barrier" ::: "memory");
    bool acur = pol.active(0, wid);
    { pol.cinit(0, pA0, pA1); qkt(pA0, pA1, kp0, qr); }
    for (int t = 0; t < NT; t += 2) {
        ATT_BODY(pA0, pA1, pB0, pB1, t);
        if (t + 1 < NT) ATT_BODY(pB0, pB1, pA0, pA1, t + 1);
    }
#undef ATT_BODY
#undef ATT_SOFTMAX_PV
#undef ATT_EXP
#undef ATT_DMA
    l_reg += __shfl_xor(l_reg, 32);
    if (hi == 0) wsf[32 + r32] = l_reg;
    asm volatile("s_waitcnt lgkmcnt(0)" ::: "memory");
    float rli[16];
#pragma unroll
    for (int rr = 0; rr < 16; ++rr) rli[rr] = 1.0f / wsf[32 + crow(rr, hi)];
    { LAS unsigned short* stg = (LAS unsigned short*)(shm + L_OST) + wid * 2048;
#pragma unroll
      for (int rr = 0; rr < 16; ++rr) { const int orow = crow(rr, hi);
#pragma unroll
          for (int d0 = 0; d0 < 2; ++d0) stg[orow * 64 + d0 * 32 + r32] = (unsigned short)f2bf(o[d0][rr] * rli[rr]); }
      asm volatile("s_waitcnt lgkmcnt(0)" ::: "memory");
#pragma unroll
      for (int i4 = 0; i4 < 4; ++i4) { const int row = i4 * 8 + (lane >> 3), ch = lane & 7; const u32x4 v = *(LAS const u32x4*)(stg + row * 64 + ch * 8);
          const long grow = pol.orow(wid, row);
          *(u32x4*)(Oc + grow * D + ch * 8) = v;
          float ss = 0.f;
#pragma unroll
          for (int e = 0; e < 4; ++e) { const float a = __uint_as_float(v[e] << 16), c = __uint_as_float(v[e] & 0xffff0000u); ss += a * a + c * c; }
          ss += __shfl_xor(ss, 1); ss += __shfl_xor(ss, 2); ss += __shfl_xor(ss, 4);
          if (ch == 0) ssq[grow * 16 + hh] = ss; } }
    asm volatile("s_waitcnt vmcnt(0) lgkmcnt(0)\n\ts_barrier" ::: "memory");
}

__device__ __forceinline__ void attn_phase(Frame& F) {
    LAS unsigned char* shm = F.lds + RING_OFF;
    LAS float* tab = (LAS float*)(shm + L_TAB);
    int tid_a = threadIdx.x; asm volatile("" : "+v"(tid_a)); const int r32 = tid_a & 31, hi = (tid_a >> 5) & 1;
    for (int su = F.vcu; su < 256; su += F.G) {
        const int b = su >> 5, h = (su >> 2) & 7, r = su & 3;
        fill_tab_A(tab, h, r, F.tid);
        asm volatile("s_waitcnt lgkmcnt(0)\n\ts_barrier" ::: "memory");
        for (int Tb = 0; Tb < 4; ++Tb) { PolA pol; pol.init(b, r, Tb, F.wave, r32, hi, tab);
            attn_unit<PolA, false>(pol, F.QB + h * 64, F.KB + h * 64, F.VB + h * 64, F.OB + h * 64, F.ssq0, h, shm, nullptr); }
    }
    for (int su = F.vcu; su < 256; su += F.G) {
        const int b = su >> 5, h = (su >> 2) & 7, qt = su & 3;
        for (int idx = F.tid; idx < 1024; idx += NWAVES * 64) { const int n = idx >> 6, d = idx & 63; const float* kp = F.kpart + (size_t)((b * 16 + n) * 2) * 512 + h * 64 + d; tab[idx] = kp[0] + kp[512]; }
        asm volatile("s_waitcnt vmcnt(0) lgkmcnt(0)\n\ts_barrier" ::: "memory");
        for (int u4 = 0; u4 < 4; ++u4) { const int s = 2 * qt + (u4 >> 1); const int i = (u4 & 1) ? 15 - s : s;
            PolB pol; pol.b = b; pol.i = i; pol.NT = 4 * (i + 1); pol.hi = hi; pol.dq0 = 4 * hi - (256 * i + 32 * F.wave + r32); pol.sl2 = exp2f(-(float)(h + 1)) * LOG2E; pol.sel = 0u;
            attn_unit<PolB, true>(pol, F.QB + 512 + h * 64, F.KB + 512 + h * 64, F.VB + 512 + h * 64, F.OB + 512 + h * 64, F.ssq0, 8 + h, shm, tab); }
    }
}
#undef ATT_WAIT_BAR
#undef ATT_SBAR
}

__device__ __forceinline__ void final_norm(Frame& F) {
    int tid_f = threadIdx.x; asm volatile("" : "+v"(tid_f)); const int lane_f = tid_f & 63;
    const int gw = F.vcu * NWAVES + F.wave, NGW = F.G * NWAVES;
    f32x4 g[2][2];
#pragma unroll
    for (int j = 0; j < 2; ++j) { g[j][0] = *(const GAS f32x4*)(F.g_final + 512 * j + 8 * lane_f); g[j][1] = *(const GAS f32x4*)(F.g_final + 512 * j + 8 * lane_f + 4); }
    for (int m = gw; m < M; m += NGW) {
        const GAS f32x4* sp = (const GAS f32x4*)(F.ssq3 + (size_t)m * 16);
        const f32x4 a = sp[0], b = sp[1], c = sp[2], d = sp[3];
        const float s = ((a.x + a.y) + (a.z + a.w)) + ((b.x + b.y) + (b.z + b.w)) + ((c.x + c.y) + (c.z + c.w)) + ((d.x + d.y) + (d.z + d.w));
        const float rstd = 1.f / sqrtf(s * (1.f / D) + EPS);
#pragma unroll
        for (int j = 0; j < 2; ++j) { const v4u w = *(const GAS v4u*)(F.XN + (size_t)m * D + 512 * j + 8 * lane_f);
            f32x4 o0 = (f32x4){__uint_as_float(w.x << 16), __uint_as_float(w.x & 0xffff0000u), __uint_as_float(w.y << 16), __uint_as_float(w.y & 0xffff0000u)};
            f32x4 o1 = (f32x4){__uint_as_float(w.z << 16), __uint_as_float(w.z & 0xffff0000u), __uint_as_float(w.w << 16), __uint_as_float(w.w & 0xffff0000u)};
            GAS f32x4* op = (GAS f32x4*)(F.out + (size_t)m * D + 512 * j + 8 * lane_f);
            op[0] = o0 * rstd * g[j][0]; op[1] = o1 * rstd * g[j][1]; }
    }
}

struct Args { const float* in[15]; float* out; unsigned char* ws; int ph_lo, ph_hi, li, pad; };
__global__ void __launch_bounds__(NWAVES * 64, 2) mk_fwd(Args args) {
    extern __shared__ __attribute__((aligned(16))) unsigned char lds[];
    Frame F;
    F.lds = (LAS unsigned char*)lds;
    F.MISC = (volatile LAS unsigned*)(F.lds + MISC_OFF);
    F.tid = threadIdx.x; F.lane = F.tid & 63; F.wave = __builtin_amdgcn_readfirstlane(F.tid >> 6);
    F.G = gridDim.x; { const int bx = blockIdx.x; F.vcu = (F.G % 8 == 0) ? (bx % 8) * (F.G / 8) + bx / 8 : bx; }
    unsigned char* ws = args.ws;
    F.ctl = (gu32*)(ws + WS_CTL);
    F.x = args.in[0]; F.p = args.in[1]; F.g_attn = args.in[2]; F.w_in = args.in[3]; F.g_out_a = args.in[4]; F.g_out_b = args.in[5]; F.w_out = args.in[6]; F.g_mlp = args.in[7];
    F.w_up = args.in[8]; F.w_down = args.in[9]; F.g_ple = args.in[10]; F.w_gate = args.in[11]; F.b_gate = args.in[12]; F.w_proj = args.in[13]; F.g_final = args.in[14]; F.out = args.out;
    F.Wqkv_t = (bf16*)(ws + WS_WQKV); F.Wo_t = (bf16*)(ws + WS_WO); F.Wup_t = (bf16*)(ws + WS_WUP); F.Wdn_t = (bf16*)(ws + WS_WDN); F.Wg_t = (bf16*)(ws + WS_WG); F.Wp_t = (bf16*)(ws + WS_WP);
    F.XN = (bf16*)(ws + WS_XN); F.QB = (bf16*)(ws + WS_Q); F.KB = (bf16*)(ws + WS_K); F.VB = (bf16*)(ws + WS_V); F.OB = (bf16*)(ws + WS_O); F.UB = (bf16*)(ws + WS_U); F.PB = (bf16*)(ws + WS_PB); F.PP = (bf16*)(ws + WS_PP);
    F.ssq0 = (float*)(ws + WS_SSQ0); F.ssq1 = (float*)(ws + WS_SSQ1); F.ssq2 = (float*)(ws + WS_SSQ2); F.ssq3 = (float*)(ws + WS_SSQ3); F.kpart = (float*)(ws + WS_KPART);
    for (int u = F.tid; u < (LDS_BYTES - LDSCTL_OFF) / 4; u += NWAVES * 64) ((LAS unsigned*)(F.lds + LDSCTL_OFF))[u] = 0u;
    __syncthreads();
    XcdBarrier bar; bar.bar = (unsigned*)(F.ctl + CW_BAR); bar.x = 0; bar.st = nullptr;
    if (N_LAUNCHES == 1) bar = xcd_barrier_post((unsigned*)(F.ctl + CW_BAR), F.MISC + 8);
    PG8_LAS float* tab = (PG8_LAS float*)(F.lds + TAB_OFF);
    const int lo = args.ph_lo, hi = args.ph_hi;
#define IN(k) (lo <= (k) && (k) < hi)
#define SEAM(k) do { if (IN(k) && IN((k) + 1)) xcd_barrier(bar); } while (0)

    if (IN(0)) { p0_prologue(F); SEAM(0); }
    if (IN(1)) {
        { pg8::Gemm g{F.XN, F.Wqkv_t, M, NQKV, D}; pg8::StaticOrder S; S.init(M, NQKV, F.G, (int)blockIdx.x);
          pg8::EpiQKV E{F.QB, (size_t)(WS_K - WS_Q) / 2, F.kpart, C2};
          pg8::gemm_phase<pg8::EpiQKV, pg8::StaticOrder, true, true>(F.lds + RING_OFF, tab, g, S, E); }
        { pg8::Gemm g{F.PB, F.Wp_t, M, D, PLE}; pg8::StaticOrder S; S.init(M, D, F.G, (int)blockIdx.x);
          pg8::EpiBf16Plain E{F.PP, D};
          pg8::gemm_phase<pg8::EpiBf16Plain, pg8::StaticOrder, true, true>(F.lds + RING_OFF, tab, g, S, E); }
        SEAM(1);
    }
#if defined(ATT_NAIVE)
    if (IN(2)) { attn_naive(F); SEAM(2); }
#else
    if (IN(2)) { att::attn_phase(F); SEAM(2); }
#endif
    if (IN(3)) {
        pg8::Gemm g{F.OB, F.Wo_t, M, D, D}; pg8::StaticOrder S; S.init(M, D, F.G, (int)blockIdx.x);
        pg8::EpiRes<1> E{F.x, F.XN, F.ssq1, F.ssq0};
        pg8::gemm_phase<pg8::EpiRes<1>, pg8::StaticOrder, true, true>(F.lds + RING_OFF, tab, g, S, E);
        SEAM(3);
    }
    if (IN(4)) {
        pg8::Gemm g{F.XN, F.Wup_t, M, FF, D}; pg8::StaticOrder S; S.init(M, FF, F.G, (int)blockIdx.x);
        pg8::EpiUp E{F.UB, FF, F.ssq1};
        pg8::gemm_phase<pg8::EpiUp, pg8::StaticOrder, true, true>(F.lds + RING_OFF, tab, g, S, E);
        SEAM(4);
    }
    if (IN(5)) {
        pg8::Gemm g{F.UB, F.Wdn_t, M, D, FF}; pg8::StaticOrder S; S.init(M, D, F.G, (int)blockIdx.x);
        pg8::EpiRes<0> E{nullptr, F.XN, F.ssq2, nullptr};
        pg8::gemm_phase<pg8::EpiRes<0>, pg8::StaticOrder, true, true>(F.lds + RING_OFF, tab, g, S, E);
        SEAM(5);
    }
    if (IN(6)) {
        pg8::Gemm g{F.XN, F.Wg_t, M, D, D}; pg8::StaticOrder S; S.init(M, D, F.G, (int)blockIdx.x);
        pg8::EpiGate E{F.XN, F.PP, F.b_gate, F.ssq3, F.ssq2};
        pg8::gemm_phase<pg8::EpiGate, pg8::StaticOrder, true, true>(F.lds + RING_OFF, tab, g, S, E);
        SEAM(6);
    }
    if (IN(7)) { final_norm(F); }
#undef IN
#undef SEAM
}

extern "C" void kernel_launch(void* const* d_in, const int* in_sizes, int n_in, void* d_out, int out_size, void* d_ws, size_t ws_size, hipStream_t stream) {
    static int grid = 0;
    if (grid == 0) {
        if (n_in != 15 || in_sizes[0] != M * D || out_size != M * D || ws_size < WS_END) { fprintf(stderr, "kernel_launch: unexpected shapes (n_in %d, in0 %d, out %d, ws %zu); nothing launched\n", n_in, n_in > 0 ? in_sizes[0] : -1, out_size, ws_size); grid = -1; return; }
        int dev = 0, cus = 0, per_cu = 0;
        if (hipGetDevice(&dev) != hipSuccess || hipDeviceGetAttribute(&cus, hipDeviceAttributeMultiprocessorCount, dev) != hipSuccess) { grid = -1; return; }
        if (hipFuncSetAttribute((const void*)mk_fwd, hipFuncAttributeMaxDynamicSharedMemorySize, LDS_BYTES) != hipSuccess) { fprintf(stderr, "kernel_launch: hipFuncSetAttribute failed\n"); grid = -1; return; }
        if (hipOccupancyMaxActiveBlocksPerMultiprocessor(&per_cu, (const void*)mk_fwd, NWAVES * 64, LDS_BYTES) != hipSuccess || per_cu < 1) { fprintf(stderr, "kernel_launch: occupancy query reports %d blocks per CU\n", per_cu); }
        (void)hipGetLastError();
        grid = cus;
    }
    if (grid < 0) return;
    if (hipMemsetAsync((char*)d_ws + WS_CTL, 0, CTL_ZERO_BYTES, stream) != hipSuccess) { fprintf(stderr, "kernel_launch: hipMemsetAsync failed\n"); return; }
    Args a{};
    for (int i = 0; i < 15; ++i) a.in[i] = (const float*)d_in[i];
    a.out = (float*)d_out; a.ws = (unsigned char*)d_ws;
    for (int li = 0; li < N_LAUNCHES; ++li) {
        a.ph_lo = (N_LAUNCHES == 1) ? 0 : li; a.ph_hi = (N_LAUNCHES == 1) ? NPHASE : li + 1; a.li = li;
        hipLaunchKernelGGL(mk_fwd, dim3(grid), dim3(NWAVES * 64), LDS_BYTES, stream, a);
        const hipError_t le = hipPeekAtLastError();
        if (le != hipSuccess) { fprintf(stderr, "kernel_launch: launch %d failed: %s\n", li, hipGetErrorName(le)); break; }
    }
}
```

```cpp
#include <hip/hip_runtime.h>
#include <cstdio>
#include <cstdint>
namespace pg8 {
#define PG8_LAS __attribute__((address_space(3)))
typedef unsigned short bf16_t;
typedef short bf16x8 __attribute__((ext_vector_type(8)));
typedef float f32x4 __attribute__((ext_vector_type(4)));
typedef unsigned u32x4 __attribute__((ext_vector_type(4)));
constexpr int BM = 256, BK = 64, HALF = 128, HTB = HALF * BK * 2  , STAGE_BYTES = 8 * HTB, NXCD = 8, WGM = 8;

__host__ __device__ __forceinline__ int lds_byte(int r, int c) { const int st = (r >> 4) * 2 + (c >> 5), rr = r & 15, cc = c & 31, ob = rr * 64 + cc * 2; return st * 1024 + (ob ^ (((ob >> 9) & 1) << 5)); }
__host__ __device__ __forceinline__ void stage_rc(int b, int& R, int& C) { const int st = b / 1024, sb = b % 1024, swz = sb ^ (((sb >> 9) & 1) << 5); R = (st >> 1) * 16 + swz / 64; C = (st & 1) * 32 + (swz % 64) / 2; }
__host__ __device__ __forceinline__ int perm32(int rho) { const int n = rho >> 4, i = rho & 15; return 8 * (i >> 2) + 4 * n + (i & 3); }

struct Unit { int pm, pn; };
struct Gemm { const bf16_t* A; const bf16_t* Bt; int M, N, K; };

struct StaticOrder {
    int nM, nN, nwg, G, c;
    __host__ __device__ void init(int M, int N, int G_, int c_) { nM = M / BM; nN = N / BM; nwg = nM * nN; G = G_; c = c_; }
    __host__ __device__ bool next(int i, Unit& u) const {
        const long L = (long)i * G + c; if (L >= nwg) return false;
        int wgid = (int)L; { const int q = nwg / NXCD, r = nwg % NXCD, xcd = wgid % NXCD, off = wgid / NXCD; wgid = (xcd < r ? xcd * (q + 1) : r * (q + 1) + (xcd - r) * q) + off; }
        const int nig = WGM * nN, gid = wgid / nig, fm = gid * WGM, gsz = (nM - fm) < WGM ? (nM - fm) : WGM;
        u.pm = fm + ((wgid % nig) % gsz); u.pn = (wgid % nig) / gsz; return true;
    }
    __device__ __forceinline__ void a_ready(const Unit&) const {}
    __device__ __forceinline__ void done(const Unit&) const {}
};

__device__ __forceinline__ unsigned cvt_pk_bf16(float lo, float hi) { unsigned r; asm volatile("v_cvt_pk_bf16_f32 %0, %1, %2" : "=v"(r) : "v"(lo), "v"(hi)); return r; }
typedef unsigned u32x2 __attribute__((ext_vector_type(2)));
constexpr float RMS_EPS = 1e-6f;
__device__ __forceinline__ float sum4(f32x4 v) { return (v[0] + v[1]) + (v[2] + v[3]); }

struct EpiBf16Plain {
    static constexpr bool PERM = true, AFTER_DRAIN = false, MID = false, TABLE = false;
    bf16_t* O; int ldc;
    __device__ __forceinline__ void operator()(f32x4 (&acc)[2][2][4][2], const Unit& u, int wr, int wc, int fr, int fq, PG8_LAS float*, int) const {
        const int row0 = u.pm * BM + wr * 64 + fr, col0 = u.pn * BM + wc * 32 + 8 * fq;
#pragma unroll
        for (int ai = 0; ai < 2; ++ai)
#pragma unroll
            for (int m = 0; m < 4; ++m) { bf16_t* rowp = O + (size_t)(row0 + ai * HALF + m * 16) * ldc + col0;
#pragma unroll
                for (int bj = 0; bj < 2; ++bj) { const f32x4 v0 = acc[ai][bj][m][0], v1 = acc[ai][bj][m][1];
                    u32x4 w; w.x = cvt_pk_bf16(v0[0], v0[1]); w.y = cvt_pk_bf16(v0[2], v0[3]); w.z = cvt_pk_bf16(v1[0], v1[1]); w.w = cvt_pk_bf16(v1[2], v1[3]);
                    *(u32x4*)(rowp + bj * HALF) = w; } }
    }
};

struct EpiQKV {
    static constexpr bool PERM = true, AFTER_DRAIN = false, MID = false, TABLE = false;
    bf16_t* Q; size_t part_stride; float* kpart; float qscale;
    __device__ __forceinline__ void operator()(f32x4 (&acc)[2][2][4][2], const Unit& u, int wr, int wc, int fr, int fq, PG8_LAS float*, int) const {
        const int part = u.pn >> 2, pc = u.pn & 3; const bool ga = pc < 2;
        bf16_t* base = Q + (size_t)part * part_stride; const float sc = part == 0 ? qscale : 1.0f;
        const int row0 = u.pm * BM + wr * 64 + fr, col0 = pc * BM + wc * 32 + 8 * fq;
#pragma unroll
        for (int ai = 0; ai < 2; ++ai)
#pragma unroll
            for (int m = 0; m < 4; ++m) { const int row = row0 + ai * HALF + m * 16;
                const int rowd = ga ? ((row & ~4095) | ((row & 3) << 10) | ((row & 4095) >> 2)) : row;
                bf16_t* rowp = base + (size_t)rowd * 1024 + col0;
#pragma unroll
                for (int bj = 0; bj < 2; ++bj) { const f32x4 v0 = acc[ai][bj][m][0] * sc, v1 = acc[ai][bj][m][1] * sc;
                    u32x4 w; w.x = cvt_pk_bf16(v0[0], v0[1]); w.y = cvt_pk_bf16(v0[2], v0[3]); w.z = cvt_pk_bf16(v1[0], v1[1]); w.w = cvt_pk_bf16(v1[2], v1[3]);
                    *(u32x4*)(rowp + bj * HALF) = w; } }
        if (part == 1 && !ga) {
#pragma unroll
            for (int bj = 0; bj < 2; ++bj) {
                f32x4 s0 = acc[0][bj][0][0], s1 = acc[0][bj][0][1];
#pragma unroll
                for (int ai = 0; ai < 2; ++ai)
#pragma unroll
                    for (int m = 0; m < 4; ++m) if (ai + m) { s0 += acc[ai][bj][m][0]; s1 += acc[ai][bj][m][1]; }
#pragma unroll
                for (int e = 0; e < 4; ++e) {
#pragma unroll
                    for (int o = 1; o < 16; o <<= 1) { s0[e] += __shfl_xor(s0[e], o); s1[e] += __shfl_xor(s1[e], o); } }
                if (fr == 0) { float* kp = kpart + (size_t)(u.pm * 2 + wr) * 512 + (pc - 2) * BM + bj * HALF + wc * 32 + 8 * fq;
                    *(f32x4*)kp = s0; *(f32x4*)(kp + 4) = s1; }
            }
        }
    }
};

template <int KIND> __device__ __forceinline__ void fill_rowscale(const float* ssq, const Unit& u, int par, PG8_LAS float* tab, int tid) {
    if (tid < 256) {
        const f32x4* p = (const f32x4*)(ssq + (size_t)(u.pm * BM + tid) * 16);
        const f32x4 a0 = p[0], a1 = p[1], b0 = p[2], b1 = p[3];
        const float sa = sum4(a0) + sum4(a1), sb = sum4(b0) + sum4(b1);
        if (KIND == 1) { tab[par * 512 + 2 * tid] = 1.0f / sqrtf((sa + sb) * (1.0f / 1024.0f) + RMS_EPS); }
        else { const float ra = 1.0f / sqrtf(sa * (1.0f / 512.0f) + RMS_EPS), rb = 1.0f / sqrtf(sb * (1.0f / 512.0f) + RMS_EPS);
            tab[par * 512 + 2 * tid] = ra / rb; tab[par * 512 + 2 * tid + 1] = rb; }
    }
}

struct EpiUp {
    static constexpr bool PERM = true, AFTER_DRAIN = false, MID = false, TABLE = true;
    bf16_t* O; int ldc; const float* ssq;
    __device__ __forceinline__ void fill(const Unit& u, int par, PG8_LAS float* tab, int tid) const { fill_rowscale<1>(ssq, u, par, tab, tid); }
    __device__ __forceinline__ void operator()(f32x4 (&acc)[2][2][4][2], const Unit& u, int wr, int wc, int fr, int fq, PG8_LAS float* tab, int par) const {
        const int row0 = u.pm * BM + wr * 64 + fr, col0 = u.pn * BM + wc * 32 + 8 * fq;
#pragma unroll
        for (int ai = 0; ai < 2; ++ai)
#pragma unroll
            for (int m = 0; m < 4; ++m) { const int r = ai * HALF + wr * 64 + m * 16 + fr; const float rs = tab[par * 512 + 2 * r];
                bf16_t* rowp = O + (size_t)(row0 + ai * HALF + m * 16) * ldc + col0;
#pragma unroll
                for (int bj = 0; bj < 2; ++bj) { f32x4 v0 = acc[ai][bj][m][0] * rs, v1 = acc[ai][bj][m][1] * rs;
#pragma unroll
                    for (int e = 0; e < 4; ++e) { const float a = fmaxf(v0[e], 0.f), b = fmaxf(v1[e], 0.f); v0[e] = a * a; v1[e] = b * b; }
                    u32x4 w; w.x = cvt_pk_bf16(v0[0], v0[1]); w.y = cvt_pk_bf16(v0[2], v0[3]); w.z = cvt_pk_bf16(v1[0], v1[1]); w.w = cvt_pk_bf16(v1[2], v1[3]);
                    *(u32x4*)(rowp + bj * HALF) = w; } }
    }
};

template <int KIND> struct EpiRes {
    static constexpr bool PERM = true, AFTER_DRAIN = false, MID = (KIND == 1), TABLE = (KIND == 1);
    const float* res32; bf16_t* hb; float* ssq_out; const float* ssq_in;
    __device__ __forceinline__ void fill(const Unit& u, int par, PG8_LAS float* tab, int tid) const { fill_rowscale<2>(ssq_in, u, par, tab, tid); }
    __device__ __forceinline__ void mid(f32x4 (&acc)[2][2][4][2], int wr, int fr, PG8_LAS float* tab, int par) const {
#pragma unroll
        for (int ai = 0; ai < 2; ++ai)
#pragma unroll
            for (int m = 0; m < 4; ++m) { const float f = tab[par * 512 + 2 * (ai * HALF + wr * 64 + m * 16 + fr)];
#pragma unroll
                for (int bj = 0; bj < 2; ++bj)
#pragma unroll
                    for (int n = 0; n < 2; ++n) acc[ai][bj][m][n] *= f; }
    }
    __device__ __forceinline__ void operator()(f32x4 (&acc)[2][2][4][2], const Unit& u, int wr, int wc, int fr, int fq, PG8_LAS float* tab, int par) const {
        const int col0 = u.pn * BM + wc * 32 + 8 * fq;
#pragma unroll
        for (int ai = 0; ai < 2; ++ai) {
            f32x4 rv[4][2][2];
#pragma unroll
            for (int m = 0; m < 4; ++m) { const size_t off = (size_t)(u.pm * BM + ai * HALF + wr * 64 + m * 16 + fr) * 1024 + col0;
#pragma unroll
                for (int bj = 0; bj < 2; ++bj) {
                    if (KIND == 1) { rv[m][bj][0] = *(const f32x4*)(res32 + off + bj * HALF); rv[m][bj][1] = *(const f32x4*)(res32 + off + bj * HALF + 4); }
                    else { const u32x4 w = *(const u32x4*)(hb + off + bj * HALF);
                        rv[m][bj][0] = (f32x4){__uint_as_float(w.x << 16), __uint_as_float(w.x & 0xffff0000u), __uint_as_float(w.y << 16), __uint_as_float(w.y & 0xffff0000u)};
                        rv[m][bj][1] = (f32x4){__uint_as_float(w.z << 16), __uint_as_float(w.z & 0xffff0000u), __uint_as_float(w.w << 16), __uint_as_float(w.w & 0xffff0000u)}; } } }
#pragma unroll
            for (int m = 0; m < 4; ++m) { const int r = ai * HALF + wr * 64 + m * 16 + fr; const int rowg = u.pm * BM + r;
                const float rb = (KIND == 1) ? tab[par * 512 + 2 * r + 1] : 1.0f;
                const size_t off = (size_t)rowg * 1024 + col0; float ss = 0.f;
#pragma unroll
                for (int bj = 0; bj < 2; ++bj) { const f32x4 v0 = rv[m][bj][0] + acc[ai][bj][m][0] * rb, v1 = rv[m][bj][1] + acc[ai][bj][m][1] * rb;
                    u32x4 w; w.x = cvt_pk_bf16(v0[0], v0[1]); w.y = cvt_pk_bf16(v0[2], v0[3]); w.z = cvt_pk_bf16(v1[0], v1[1]); w.w = cvt_pk_bf16(v1[2], v1[3]);
                    *(u32x4*)(hb + off + bj * HALF) = w;
                    ss += ((v0[0] * v0[0] + v0[1] * v0[1]) + (v0[2] * v0[2] + v0[3] * v0[3])) + ((v1[0] * v1[0] + v1[1] * v1[1]) + (v1[2] * v1[2] + v1[3] * v1[3])); }
                ss += __shfl_xor(ss, 16); ss += __shfl_xor(ss, 32);
                if (fq == 0) ssq_out[(size_t)rowg * 16 + u.pn * 4 + wc] = ss; }
            asm volatile("" ::: "memory");
        }
    }
};

struct EpiGate {
    static constexpr bool PERM = true, AFTER_DRAIN = false, MID = false, TABLE = true;
    bf16_t* hb; const bf16_t* pp; const float* bias; float* ssq_out; const float* ssq_in;
    __device__ __forceinline__ void fill(const Unit& u, int par, PG8_LAS float* tab, int tid) const { fill_rowscale<1>(ssq_in, u, par, tab, tid); }
    __device__ __forceinline__ void operator()(f32x4 (&acc)[2][2][4][2], const Unit& u, int wr, int wc, int fr, int fq, PG8_LAS float* tab, int par) const {
        const int col0 = u.pn * BM + wc * 32 + 8 * fq;
        f32x4 bv[2][2];
#pragma unroll
        for (int bj = 0; bj < 2; ++bj)
#pragma unroll
            for (int n = 0; n < 2; ++n) bv[bj][n] = *(const f32x4*)(bias + col0 + bj * HALF + 4 * n);
#pragma unroll
        for (int ai = 0; ai < 2; ++ai) {
            u32x4 hv[4][2], pv[4][2];
#pragma unroll
            for (int m = 0; m < 4; ++m) { const size_t off = (size_t)(u.pm * BM + ai * HALF + wr * 64 + m * 16 + fr) * 1024 + col0;
#pragma unroll
                for (int bj = 0; bj < 2; ++bj) { hv[m][bj] = *(const u32x4*)(hb + off + bj * HALF); pv[m][bj] = *(const u32x4*)(pp + off + bj * HALF); } }
#pragma unroll
            for (int m = 0; m < 4; ++m) { const int r = ai * HALF + wr * 64 + m * 16 + fr; const int rowg = u.pm * BM + r;
                const float rs = tab[par * 512 + 2 * r];
                const size_t off = (size_t)rowg * 1024 + col0; float ss = 0.f;
#pragma unroll
                for (int bj = 0; bj < 2; ++bj) { float v[8];
#pragma unroll
                    for (int e = 0; e < 8; ++e) { const unsigned hw = hv[m][bj][e >> 1], pw = pv[m][bj][e >> 1];
                        const float h = __uint_as_float((e & 1) ? (hw & 0xffff0000u) : (hw << 16)), p = __uint_as_float((e & 1) ? (pw & 0xffff0000u) : (pw << 16));
                        const float z = acc[ai][bj][m][e >> 2][e & 3] * rs + bv[bj][e >> 2][e & 3];
                        v[e] = h + __builtin_amdgcn_rcpf(1.0f + __builtin_amdgcn_exp2f(-1.4426950408889634f * z)) * p; ss += v[e] * v[e]; }
                    u32x4 w; w.x = cvt_pk_bf16(v[0], v[1]); w.y = cvt_pk_bf16(v[2], v[3]); w.z = cvt_pk_bf16(v[4], v[5]); w.w = cvt_pk_bf16(v[6], v[7]);
                    *(u32x4*)(hb + off + bj * HALF) = w; }
                ss += __shfl_xor(ss, 16); ss += __shfl_xor(ss, 32);
                if (fq == 0) ssq_out[(size_t)rowg * 16 + u.pn * 4 + wc] = ss; }
            asm volatile("" ::: "memory");
        }
    }
};

template <class Epi, class Sched, bool ALIGN_EPI = false, bool SP2 = false>
__device__ __forceinline__ void gemm_phase(PG8_LAS unsigned char* lds, PG8_LAS float* tab, const Gemm g, const Sched& S, const Epi& E) {
    const int tid = threadIdx.x, wid = __builtin_amdgcn_readfirstlane(tid >> 6), lane = tid & 63, wr = wid >> 2, wc = wid & 3, fr = lane & 15, fq = lane >> 4;
    const int K = g.K, nt = K / BK;
    unsigned voffA[2], voffB[2];
#pragma unroll
    for (int i = 0; i < 2; ++i) { int R, C; stage_rc(tid * 16 + i * 8192, R, C); const int Rb = Epi::PERM ? ((R & ~31) + perm32(R & 31)) : R;
        voffA[i] = (unsigned)(R * K + C) * 2u; voffB[i] = (unsigned)(Rb * K + C) * 2u; }
    const size_t kstep = (size_t)(BK * 2);
    const size_t hstep = (size_t)HALF * K * 2;
    const size_t tstep = 2 * hstep;
    const unsigned ldsw = (unsigned)wid * 1024u;
    const int aoff = lds_byte(wr * 64 + fr, fq * 8), boff = lds_byte(wc * 32 + fr, fq * 8);
#define PG8_SA(b, h) (((b) * 2 + (h)) * HTB)
#define PG8_SB(b, h) ((4 + (b) * 2 + (h)) * HTB)
#define PG8_STAGE(bufoff, gbase, voff) do { _Pragma("unroll") for (int _i = 0; _i < 2; ++_i) \
        __builtin_amdgcn_global_load_lds((const unsigned*)((const char*)(gbase) + (voff)[_i]), (PG8_LAS unsigned*)(lds + (bufoff) + ldsw + _i * 8192), 16, 0, 0); } while (0)
#define PG8_LDA(dst, b, h) do { _Pragma("unroll") for (int m = 0; m < 4; ++m) _Pragma("unroll") for (int k = 0; k < 2; ++k) dst[m][k] = *(const PG8_LAS bf16x8*)(lds + PG8_SA(b, h) + aoff + m * 2048 + k * 1024); } while (0)
#define PG8_LDB(dst, b, h) do { _Pragma("unroll") for (int n = 0; n < 2; ++n) _Pragma("unroll") for (int k = 0; k < 2; ++k) dst[n][k] = *(const PG8_LAS bf16x8*)(lds + PG8_SB(b, h) + boff + n * 2048 + k * 1024); } while (0)
#define PG8_MMA(ai, bj, At, Bt) do { __builtin_amdgcn_s_setprio(1); _Pragma("unroll") for (int m = 0; m < 4; ++m) _Pragma("unroll") for (int n = 0; n < 2; ++n) _Pragma("unroll") for (int k = 0; k < 2; ++k) \
        acc[ai][bj][m][n] = __builtin_amdgcn_mfma_f32_16x16x32_bf16(Bt[n][k], At[m][k], acc[ai][bj][m][n], 0, 0, 0); __builtin_amdgcn_s_setprio(0); } while (0)
#define PG8_WAIT_V(n) asm volatile("s_waitcnt vmcnt(" #n ")" ::: "memory")
#define PG8_WAIT_L(n) asm volatile("s_waitcnt lgkmcnt(" #n ")" ::: "memory")
#define PG8_BAR __builtin_amdgcn_s_barrier()
#define PG8_SCHED __builtin_amdgcn_sched_barrier(0)
    Unit cur, nxt; int ui = 0;
    if (!S.next(0, cur)) return;
    if constexpr (Epi::TABLE) E.fill(cur, 0, tab, tid);
    f32x4 acc[2][2][4][2];
#pragma unroll
    for (int a = 0; a < 2; ++a)
#pragma unroll
        for (int b = 0; b < 2; ++b)
#pragma unroll
            for (int m = 0; m < 4; ++m)
#pragma unroll
                for (int n = 0; n < 2; ++n) acc[a][b][m][n] = (f32x4){0.f, 0.f, 0.f, 0.f};
    bf16x8 At[4][2], B0[2][2], B1[2][2];
    const char* cA = (const char*)g.A + (size_t)cur.pm * tstep; const char* cB = (const char*)g.Bt + (size_t)cur.pn * tstep;
    S.a_ready(cur);
    if constexpr (SP2) {
        PG8_STAGE(PG8_SB(0, 0), cB, voffB); PG8_STAGE(PG8_SB(0, 1), cB + hstep, voffB); PG8_STAGE(PG8_SA(0, 0), cA, voffA); PG8_STAGE(PG8_SA(0, 1), cA + hstep, voffA);
        if (wr == 1) PG8_BAR;
        PG8_WAIT_V(2); PG8_BAR;
        PG8_STAGE(PG8_SB(1, 0), cB + kstep, voffB); PG8_STAGE(PG8_SA(1, 0), cA + kstep, voffA); PG8_STAGE(PG8_SB(1, 1), cB + hstep + kstep, voffB);
        PG8_WAIT_V(6); PG8_BAR;
    } else {
        PG8_STAGE(PG8_SB(0, 0), cB, voffB); PG8_STAGE(PG8_SA(0, 0), cA, voffA); PG8_STAGE(PG8_SB(0, 1), cB + hstep, voffB); PG8_STAGE(PG8_SA(0, 1), cA + hstep, voffA);
        if (wr == 1) PG8_BAR;
        PG8_WAIT_V(4); PG8_BAR;
        PG8_STAGE(PG8_SB(1, 0), cB + kstep, voffB); PG8_STAGE(PG8_SA(1, 0), cA + kstep, voffA); PG8_STAGE(PG8_SB(1, 1), cB + hstep + kstep, voffB);
        PG8_WAIT_V(6); PG8_BAR;
    }
    for (;;) {
        const bool has_next = S.next(ui + 1, nxt);
        const char* nA = has_next ? (const char*)g.A + (size_t)nxt.pm * tstep : cA; const char* nB = has_next ? (const char*)g.Bt + (size_t)nxt.pn * tstep : cB;
        for (int t = 0; t < nt; t += 2) {
            const bool last = (t == nt - 2);
            if constexpr (Epi::MID) { if (t == (nt >> 1)) E.mid(acc, wr, fr, tab, ui & 1); }
            const char* a1 = cA + (size_t)(t + 1) * kstep;
            const char* a2 = last ? nA : cA + (size_t)(t + 2) * kstep; const char* b2 = last ? nB : cB + (size_t)(t + 2) * kstep;
            const char* a3 = a2 + kstep; const char* b3 = b2 + kstep;
            if (last && has_next) S.a_ready(nxt);
            if constexpr (SP2) {
            PG8_LDB(B0, 0, 0); PG8_LDB(B1, 0, 1); PG8_SCHED; PG8_LDA(At, 0, 0); PG8_STAGE(PG8_SA(1, 1), a1 + hstep, voffA);
            PG8_WAIT_V(8); PG8_WAIT_L(0); PG8_BAR; PG8_MMA(0, 0, At, B0); PG8_MMA(0, 1, At, B1); PG8_BAR; PG8_SCHED;
            PG8_LDA(At, 0, 1); PG8_STAGE(PG8_SB(0, 0), b2, voffB); PG8_STAGE(PG8_SB(0, 1), b2 + hstep, voffB); PG8_STAGE(PG8_SA(0, 0), a2, voffA);
            PG8_WAIT_V(8); PG8_WAIT_L(0); PG8_BAR; PG8_MMA(1, 0, At, B0); PG8_MMA(1, 1, At, B1); PG8_BAR; PG8_SCHED;
            PG8_LDB(B0, 1, 0); PG8_LDB(B1, 1, 1); PG8_SCHED; PG8_LDA(At, 1, 0); PG8_STAGE(PG8_SA(0, 1), a2 + hstep, voffA);
            PG8_WAIT_V(8); PG8_WAIT_L(0); PG8_BAR; PG8_MMA(0, 0, At, B0); PG8_MMA(0, 1, At, B1); PG8_BAR; PG8_SCHED;
            PG8_LDA(At, 1, 1); PG8_STAGE(PG8_SB(1, 0), b3, voffB); PG8_STAGE(PG8_SB(1, 1), b3 + hstep, voffB); PG8_STAGE(PG8_SA(1, 0), a3, voffA);
            PG8_WAIT_V(8); PG8_WAIT_L(0); PG8_BAR; PG8_MMA(1, 0, At, B0); PG8_MMA(1, 1, At, B1); PG8_BAR; PG8_SCHED;
            } else {
            PG8_LDB(B0, 0, 0); PG8_SCHED; PG8_LDA(At, 0, 0); PG8_STAGE(PG8_SA(1, 1), a1 + hstep, voffA);
            PG8_WAIT_L(8); PG8_BAR; PG8_WAIT_L(0); PG8_MMA(0, 0, At, B0); PG8_BAR; PG8_SCHED;
            PG8_LDB(B1, 0, 1); PG8_STAGE(PG8_SB(0, 0), b2, voffB);
            PG8_BAR; PG8_WAIT_L(0); PG8_MMA(0, 1, At, B1); PG8_BAR;
            PG8_LDA(At, 0, 1); PG8_STAGE(PG8_SA(0, 0), a2, voffA);
            PG8_BAR; PG8_WAIT_L(0); PG8_MMA(1, 0, At, B0); PG8_BAR; PG8_SCHED;
            PG8_STAGE(PG8_SB(0, 1), b2 + hstep, voffB);
            PG8_WAIT_V(6); PG8_BAR; PG8_MMA(1, 1, At, B1); PG8_BAR;
            PG8_LDB(B0, 1, 0); PG8_SCHED; PG8_LDA(At, 1, 0); PG8_STAGE(PG8_SA(0, 1), a2 + hstep, voffA);
            PG8_WAIT_L(8); PG8_BAR; PG8_WAIT_L(0); PG8_MMA(0, 0, At, B0); PG8_BAR; PG8_SCHED;
            PG8_LDB(B1, 1, 1); PG8_STAGE(PG8_SB(1, 0), b3, voffB);
            PG8_BAR; PG8_WAIT_L(0); PG8_MMA(0, 1, At, B1); PG8_BAR;
            PG8_LDA(At, 1, 1); PG8_STAGE(PG8_SA(1, 0), a3, voffA);
            PG8_BAR; PG8_WAIT_L(0); PG8_MMA(1, 0, At, B0); PG8_BAR; PG8_SCHED;
            PG8_STAGE(PG8_SB(1, 1), b3 + hstep, voffB);
            PG8_WAIT_V(6); PG8_BAR; PG8_MMA(1, 1, At, B1); PG8_BAR;
            }
        }
        if constexpr (ALIGN_EPI) { if (wr == 0) PG8_BAR; }
        if constexpr (!Epi::AFTER_DRAIN) { int tid_e = threadIdx.x; asm volatile("" : "+v"(tid_e)); const int lane_e = tid_e & 63;
            E(acc, cur, wr, wc, lane_e & 15, lane_e >> 4, tab, ui & 1); S.done(cur); }
        if (!has_next) break;
#pragma unroll
        for (int a = 0; a < 2; ++a)
#pragma unroll
            for (int b = 0; b < 2; ++b)
#pragma unroll
                for (int m = 0; m < 4; ++m)
#pragma unroll
                    for (int n = 0; n < 2; ++n) acc[a][b][m][n] = (f32x4){0.f, 0.f, 0.f, 0.f};
        cur = nxt; cA = nA; cB = nB; ++ui;
        if constexpr (Epi::TABLE) E.fill(cur, ui & 1, tab, tid);
        if constexpr (ALIGN_EPI) { if (wr == 1) PG8_BAR; }
    }
    PG8_WAIT_V(0);
    if constexpr (!ALIGN_EPI) { if (wr == 0) PG8_BAR; }
    PG8_BAR;
    if constexpr (Epi::AFTER_DRAIN) { E.fused(acc, cur, wr, wc, fr, fq, lds, wid, lane); S.done(cur); }
#undef PG8_SA
#undef PG8_SB
#undef PG8_STAGE
#undef PG8_LDA
#undef PG8_LDB
#undef PG8_MMA
#undef PG8_WAIT_V
#undef PG8_WAIT_L
#undef PG8_BAR
#undef PG8_SCHED
}
}
#define GAS __attribute__((address_space(1)))
#define LAS __attribute__((address_space(3)))
typedef unsigned short bf16;
typedef unsigned v4u __attribute__((ext_vector_type(4)));
typedef float f32x4 __attribute__((ext_vector_type(4)));
typedef short bf16x8 __attribute__((ext_vector_type(8)));
typedef GAS unsigned gu32;
typedef GAS unsigned long long gu64;
#define RLX_AGENT __ATOMIC_RELAXED, __HIP_MEMORY_SCOPE_AGENT
#define LDS_WAIT() asm volatile("s_waitcnt lgkmcnt(0)" ::: "memory")
#define VM_WAIT() asm volatile("s_waitcnt vmcnt(0)" ::: "memory")
__device__ __forceinline__ unsigned long long rt() { return __builtin_amdgcn_s_memrealtime(); }
__device__ __forceinline__ unsigned f2bf(float f) { unsigned u = __builtin_bit_cast(unsigned, f); return (u + 0x7fffu + ((u >> 16) & 1u)) >> 16; }
__device__ __forceinline__ unsigned pk2(float lo, float hi) { return f2bf(lo) | (f2bf(hi) << 16); }

#define XB_TMO      128
#define XB_XCNT(j)  (256  + 64 * (j))
#define XB_XSUB(j)  (1280 + 64 * (j))
#define XB_XGEN(j)  (2304 + 64 * (j))
#define XB_TOP      3328
#define XB_TOPGEN   3392
#define XCD_BAR_WORDS 3456
#define XB_SPIN_CAP (1u << 18)

__device__ __forceinline__ unsigned xb_ld(unsigned* p)              { return __hip_atomic_load(p, __ATOMIC_RELAXED, __HIP_MEMORY_SCOPE_AGENT); }
__device__ __forceinline__ unsigned xb_add(unsigned* p, unsigned v) { return __hip_atomic_fetch_add(p, v, __ATOMIC_RELAXED, __HIP_MEMORY_SCOPE_AGENT); }
__device__ __forceinline__ unsigned xb_xcc_id() { return (unsigned)__builtin_amdgcn_s_getreg((3 << 11) | 20) & 0xFu; }
#define XB_SPIN(cond, bar) do { unsigned _sp = 0; while (cond) { __builtin_amdgcn_s_sleep(1); \
    if ((++_sp & 255u) == 0u) { if (xb_ld(&(bar)[XB_TMO])) break; if (_sp > XB_SPIN_CAP) { atomicAdd(&(bar)[XB_TMO], 1u); break; } } } } while (0)

struct XcdBarrier {
    unsigned* bar; unsigned x;
    volatile LAS unsigned* st;
};

__device__ __forceinline__ XcdBarrier xcd_barrier_post(unsigned* bar, volatile LAS unsigned* st) {
    XcdBarrier b; b.bar = bar; b.x = xb_xcc_id(); b.st = st;
    if (threadIdx.x == 0) (void)xb_add(&bar[XB_XCNT(b.x)], 1u);
    return b;
}
__device__ __forceinline__ void xcd_barrier_complete(unsigned* bar, unsigned x, unsigned& nloc, unsigned& nx) {
    const unsigned G = gridDim.x * gridDim.y * gridDim.z;
    unsigned sum, cnt, mine, sp = 0u;
    for (;;) {
        sum = 0u; cnt = 0u; mine = 0u;
#pragma unroll
        for (unsigned j = 0; j < 16; ++j) { const unsigned c = xb_ld(&bar[XB_XCNT(j)]); sum += c; cnt += (c > 0u) ? 1u : 0u; mine = (j == x) ? c : mine; }
        if (sum == G) break;
        __builtin_amdgcn_s_sleep(1);
        if ((++sp & 255u) == 0u) { if (xb_ld(&bar[XB_TMO])) break; if (sp > XB_SPIN_CAP) { atomicAdd(&bar[XB_TMO], 1u); break; } }
    }
    nloc = mine > 0u ? mine : 1u; nx = cnt > 0u ? cnt : 1u;
}

__device__ __forceinline__ void xcd_barrier(const XcdBarrier& b) {
    asm volatile("s_waitcnt vmcnt(0)" ::: "memory");
    __syncthreads();
    if (threadIdx.x == 0) {
        unsigned* bar = b.bar;
        __builtin_amdgcn_s_waitcnt(0);
        unsigned nloc = b.st[0], nx = b.st[1];
        if (nloc == 0u) { xcd_barrier_complete(bar, b.x, nloc, nx); b.st[0] = nloc; b.st[1] = nx; }
        const unsigned old = xb_add(&bar[XB_XSUB(b.x)], 1u);
        const unsigned gen = old / nloc;
        if (old + 1u == (gen + 1u) * nloc) {
            __builtin_amdgcn_fence(__ATOMIC_RELEASE, "agent");
            asm volatile("s_waitcnt vmcnt(0)" ::: "memory");
            const unsigned og = xb_add(&bar[XB_TOP], 1u);
            const unsigned tg = og / nx;
            if (og + 1u == (tg + 1u) * nx) xb_add(&bar[XB_TOPGEN], 1u);
            else XB_SPIN(xb_ld(&bar[XB_TOPGEN]) == tg, bar);
            __builtin_amdgcn_fence(__ATOMIC_ACQUIRE, "agent");
            xb_add(&bar[XB_XGEN(b.x)], 1u);
            asm volatile("s_waitcnt vmcnt(0)" ::: "memory");
        } else {
            XB_SPIN(xb_ld(&bar[XB_XGEN(b.x)]) == gen, bar);
            __builtin_amdgcn_fence(__ATOMIC_ACQUIRE, "agent");
            asm volatile("s_waitcnt vmcnt(0)" ::: "memory");
        }
    }
    __syncthreads();
}

constexpr int NWAVES = 8;
#ifndef MK_N_LAUNCHES
#define MK_N_LAUNCHES 1
#endif
constexpr int N_LAUNCHES = MK_N_LAUNCHES;
constexpr int NPHASE = 8;
static_assert(N_LAUNCHES == 1 || N_LAUNCHES == NPHASE, "MK_N_LAUNCHES is 1 or NPHASE");

constexpr int BATCH = 8, SEQ = 4096, D = 1024, NH = 16, HD = 64, FF = 4096, PLE = 256;
constexpr int M = BATCH * SEQ;
constexpr int NQKV = 3 * D;
constexpr float EPS = 1e-6f;
constexpr float LOG2E = 1.4426950408889634f;
constexpr float C2 = 0.125f * LOG2E;

constexpr size_t MiB = 1u << 20;
constexpr size_t WS_CTL = 0, CTL_ZERO_BYTES = 64 * 1024;
constexpr size_t WS_WQKV = 1 * MiB, WS_WO = 7 * MiB, WS_WUP = 9 * MiB, WS_WDN = 17 * MiB, WS_WG = 25 * MiB, WS_WP = 27 * MiB;
constexpr size_t WS_SSQ0 = 28 * MiB, WS_SSQ1 = 30 * MiB, WS_SSQ2 = 32 * MiB, WS_SSQ3 = 34 * MiB;
constexpr size_t WS_KPART = 36 * MiB;
constexpr size_t WS_PB = 40 * MiB;
constexpr size_t WS_PP = 56 * MiB;
constexpr size_t WS_XN = 120 * MiB;
constexpr size_t WS_Q = 184 * MiB, WS_K = 248 * MiB, WS_V = 312 * MiB, WS_O = 376 * MiB;
constexpr size_t WS_U = 184 * MiB;
constexpr size_t WS_END = 440 * MiB;
constexpr int CW_BAR = 1024;

constexpr int RING_OFF = 0, RING_BYTES = 131072;
constexpr int LDSCTL_OFF = RING_BYTES, MISC_OFF = LDSCTL_OFF + 320;
constexpr int TAB_OFF = RING_BYTES + 1024;
constexpr int LDS_BYTES = 147456;
static_assert(TAB_OFF + 4096 <= LDS_BYTES, "LDS map");

struct Frame {
    LAS unsigned char* lds;
    volatile LAS unsigned* MISC;
    gu32* ctl;
    int tid, lane, wave;
    int vcu, G;
    const float *x, *p, *g_attn, *w_in, *g_out_a, *g_out_b, *w_out, *g_mlp, *w_up, *w_down, *g_ple, *w_gate, *b_gate, *w_proj, *g_final;
    float* out;
    bf16 *Wqkv_t, *Wo_t, *Wup_t, *Wdn_t, *Wg_t, *Wp_t;
    bf16 *XN, *QB, *KB, *VB, *OB, *UB, *PB, *PP;
    float *ssq0, *ssq1, *ssq2, *ssq3, *kpart;
};

__device__ __forceinline__ float wave_sum(float v) {
#pragma unroll
    for (int o = 1; o < 64; o <<= 1) v += __shfl_xor(v, o);
    return v;
}
__device__ __forceinline__ void p0_transpose_item(const float* W, int K, int N, bf16* dst, const float* g, LAS float* scr, int k0, int n0, int lane) {
    f32x4 wv[8];
#pragma unroll
    for (int i = 0; i < 8; ++i) wv[i] = *(const GAS f32x4*)(W + (size_t)(k0 + 8 * i + (lane >> 3)) * N + n0 + 4 * (lane & 7));
#pragma unroll
    for (int i = 0; i < 8; ++i) { const int kk = 8 * i + (lane >> 3); f32x4 v = wv[i]; if (g) v = v * g[k0 + kk]; LAS float* d = scr + kk * 33 + 4 * (lane & 7); d[0] = v.x; d[1] = v.y; d[2] = v.z; d[3] = v.w; }
    LDS_WAIT(); asm volatile("" ::: "memory");
    const int c = lane & 7;
#pragma unroll
    for (int j = 0; j < 4; ++j) { const int n = (lane >> 3) + 8 * j; const LAS float* s = scr + (8 * c) * 33 + n;
        v4u o; o.x = pk2(s[0 * 33], s[1 * 33]); o.y = pk2(s[2 * 33], s[3 * 33]); o.z = pk2(s[4 * 33], s[5 * 33]); o.w = pk2(s[6 * 33], s[7 * 33]);
        *(GAS v4u*)(dst + (size_t)n * K + k0 + 8 * c) = o; }
    LDS_WAIT(); asm volatile("" ::: "memory");
}
__device__ __forceinline__ int qkv_dst_row(int n0) {
    if (n0 < 1536) return (n0 / 512) * 1024 + (n0 % 512);
    const int n1 = n0 - 1536; return (n1 / 512) * 1024 + 512 + (n1 % 512);
}
__device__ __forceinline__ void p0_prologue(Frame& F) {
    LAS float* scr = (LAS float*)(F.lds + RING_OFF + F.wave * 16384);
    const int gw = F.vcu * NWAVES + F.wave, NGW = F.G * NWAVES;
    constexpr int I_IN = (D / 64) * (NQKV / 32), I_O = (D / 64) * (D / 32), I_UP = (D / 64) * (FF / 32), I_DN = (FF / 64) * (D / 32), I_G = I_O, I_P = (PLE / 64) * (D / 32);
    constexpr int NITEMS = I_IN + I_O + I_UP + I_DN + I_G + I_P;
    for (int it = gw; it < NITEMS; it += NGW) {
        int r = it;
        if (r < I_IN) { const int nb = r % (NQKV / 32), kb = r / (NQKV / 32); p0_transpose_item(F.w_in, D, NQKV, F.Wqkv_t + (size_t)qkv_dst_row(32 * nb) * D, F.g_attn, scr, 64 * kb, 32 * nb, F.lane); continue; } r -= I_IN;
        if (r < I_O) { const int nb = r % (D / 32), kb = r / (D / 32); const float* g = (64 * kb < 512) ? F.g_out_a : (F.g_out_b - 512);
            p0_transpose_item(F.w_out, D, D, F.Wo_t + (size_t)(32 * nb) * D, g, scr, 64 * kb, 32 * nb, F.lane); continue; } r -= I_O;
        if (r < I_UP) { const int nb = r % (FF / 32), kb = r / (FF / 32); p0_transpose_item(F.w_up, D, FF, F.Wup_t + (size_t)(32 * nb) * D, F.g_mlp, scr, 64 * kb, 32 * nb, F.lane); continue; } r -= I_UP;
        if (r < I_DN) { const int nb = r % (D / 32), kb = r / (D / 32); p0_transpose_item(F.w_down, FF, D, F.Wdn_t + (size_t)(32 * nb) * FF, nullptr, scr, 64 * kb, 32 * nb, F.lane); continue; } r -= I_DN;
        if (r < I_G) { const int nb = r % (D / 32), kb = r / (D / 32); p0_transpose_item(F.w_gate, D, D, F.Wg_t + (size_t)(32 * nb) * D, F.g_ple, scr, 64 * kb, 32 * nb, F.lane); continue; } r -= I_G;
        { const int nb = r % (D / 32), kb = r / (D / 32); p0_transpose_item(F.w_proj, PLE, D, F.Wp_t + (size_t)(32 * nb) * PLE, nullptr, scr, 64 * kb, 32 * nb, F.lane); }
    }
    for (int m0 = 2 * gw; m0 < M; m0 += 2 * NGW) {
        f32x4 v[2][4]; f32x4 pv[2]; float s[2] = {0.f, 0.f};
#pragma unroll
        for (int q = 0; q < 2; ++q) { const GAS f32x4* xr = (const GAS f32x4*)(F.x + (size_t)(m0 + q) * D) + F.lane;
#pragma unroll
            for (int j = 0; j < 4; ++j) v[q][j] = xr[64 * j];
            pv[q] = ((const GAS f32x4*)(F.p + (size_t)(m0 + q) * PLE))[F.lane]; }
#pragma unroll
        for (int q = 0; q < 2; ++q) {
#pragma unroll
            for (int j = 0; j < 4; ++j) s[q] += (v[q][j].x * v[q][j].x + v[q][j].y * v[q][j].y) + (v[q][j].z * v[q][j].z + v[q][j].w * v[q][j].w);
            const float rstd = 1.f / sqrtf(wave_sum(s[q]) * (1.f / D) + EPS);
            GAS unsigned long long* o8 = (GAS unsigned long long*)(F.XN + (size_t)(m0 + q) * D) + F.lane;
#pragma unroll
            for (int j = 0; j < 4; ++j) o8[64 * j] = (unsigned long long)pk2(v[q][j].x * rstd, v[q][j].y * rstd) | ((unsigned long long)pk2(v[q][j].z * rstd, v[q][j].w * rstd) << 32);
            ((GAS unsigned long long*)(F.PB + (size_t)(m0 + q) * PLE))[F.lane] = (unsigned long long)pk2(pv[q].x, pv[q].y) | ((unsigned long long)pk2(pv[q].z, pv[q].w) << 32); }
    }
}

__device__ __forceinline__ float bf2f(unsigned short h) { return __uint_as_float((unsigned)h << 16); }
__device__ __forceinline__ void naive_key(const bf16* kp, const bf16* vp, const float (&q)[64], float bias, float& mx, float& l, float (&acc)[64]) {
    float s = 0.f;
#pragma unroll
    for (int c = 0; c < 8; ++c) { const v4u kw = *(const v4u*)(kp + 8 * c);
        s += q[8 * c + 0] * __uint_as_float(kw.x << 16) + q[8 * c + 1] * __uint_as_float(kw.x & 0xffff0000u) + q[8 * c + 2] * __uint_as_float(kw.y << 16) + q[8 * c + 3] * __uint_as_float(kw.y & 0xffff0000u)
           + q[8 * c + 4] * __uint_as_float(kw.z << 16) + q[8 * c + 5] * __uint_as_float(kw.z & 0xffff0000u) + q[8 * c + 6] * __uint_as_float(kw.w << 16) + q[8 * c + 7] * __uint_as_float(kw.w & 0xffff0000u); }
    s += bias;
    const float mn = fmaxf(mx, s), sc = __builtin_amdgcn_exp2f(mx - mn), pe = __builtin_amdgcn_exp2f(s - mn);
    mx = mn; l = l * sc + pe;
#pragma unroll
    for (int c = 0; c < 8; ++c) { const v4u vw = *(const v4u*)(vp + 8 * c);
        acc[8 * c + 0] = acc[8 * c + 0] * sc + pe * __uint_as_float(vw.x << 16); acc[8 * c + 1] = acc[8 * c + 1] * sc + pe * __uint_as_float(vw.x & 0xffff0000u);
        acc[8 * c + 2] = acc[8 * c + 2] * sc + pe * __uint_as_float(vw.y << 16); acc[8 * c + 3] = acc[8 * c + 3] * sc + pe * __uint_as_float(vw.y & 0xffff0000u);
        acc[8 * c + 4] = acc[8 * c + 4] * sc + pe * __uint_as_float(vw.z << 16); acc[8 * c + 5] = acc[8 * c + 5] * sc + pe * __uint_as_float(vw.z & 0xffff0000u);
        acc[8 * c + 6] = acc[8 * c + 6] * sc + pe * __uint_as_float(vw.w << 16); acc[8 * c + 7] = acc[8 * c + 7] * sc + pe * __uint_as_float(vw.w & 0xffff0000u); }
}
__device__ __forceinline__ void attn_naive(Frame& F) {
    const long NT = (long)F.G * NWAVES * 64;
    for (long idx = (long)blockIdx.x * (NWAVES * 64) + F.tid; idx < (long)M * NH; idx += NT) {
        const int tok = (int)(idx % M), hh = (int)(idx / M); const int b = tok / SEQ, t = tok % SEQ; const int grp = hh >> 3, h = hh & 7;
        float q[64], acc[64]; float mx = -1e30f, l = 0.f;
#pragma unroll
        for (int d = 0; d < 64; ++d) acc[d] = 0.f;
        if (grp == 0) {
            const float sl2 = exp2f(-0.5f * (float)(2 * h + 1)) * LOG2E;
            const size_t qrow = (size_t)b * SEQ + (size_t)(t & 3) * 1024 + (t >> 2);
            const bf16* qp = F.QB + qrow * D + h * 64;
#pragma unroll
            for (int d = 0; d < 64; ++d) q[d] = bf2f(qp[d]);
            for (int br = 0; br < 3; ++br) { const int dil = br == 0 ? 1 : (br == 1 ? 4 : 16);
                for (int mm = 0; mm <= 128; ++mm) { const int key = t - dil * mm; if (key < 0) break;
                    const size_t krow = (size_t)b * SEQ + (size_t)(key & 3) * 1024 + (key >> 2);
                    naive_key(F.KB + krow * D + h * 64, F.VB + krow * D + h * 64, q, -sl2 * (float)(dil * mm), mx, l, acc); } }
        } else {
            const float sl2 = exp2f(-(float)(h + 1)) * LOG2E;
            const bf16* qp = F.QB + (size_t)tok * D + 512 + h * 64;
#pragma unroll
            for (int d = 0; d < 64; ++d) q[d] = bf2f(qp[d]);
            const int own = t >> 8; int i0 = -1, i1 = -1, i2 = -1; float g0 = -INFINITY, g1 = -INFINITY, g2 = -INFINITY;
            for (int n = 0; n < own; ++n) { const float* k0 = F.kpart + (size_t)((b * 16 + n) * 2) * 512 + h * 64; const float* k1 = k0 + 512; float g = 0.f;
#pragma unroll
                for (int d = 0; d < 64; ++d) g += q[d] * (k0[d] + k1[d]);
                if (g > g0) { g2 = g1; i2 = i1; g1 = g0; i1 = i0; g0 = g; i0 = n; } else if (g > g1) { g2 = g1; i2 = i1; g1 = g; i1 = n; } else if (g > g2) { g2 = g; i2 = n; } }
            for (int j = 0; j < 4; ++j) { const int n = j == 0 ? i0 : (j == 1 ? i1 : (j == 2 ? i2 : own)); if (n < 0) continue;
                const int kend = (j == 3) ? t : 256 * n + 255;
                for (int key = 256 * n; key <= kend; ++key) { const size_t krow = (size_t)b * SEQ + key;
                    naive_key(F.KB + krow * D + 512 + h * 64, F.VB + krow * D + 512 + h * 64, q, -sl2 * (float)(t - key), mx, l, acc); } }
        }
        const float rl = 1.0f / l; float ss = 0.f; bf16* op = F.OB + (size_t)tok * D + grp * 512 + h * 64;
#pragma unroll
        for (int d = 0; d < 64; d += 2) { const float a = acc[d] * rl, c = acc[d + 1] * rl; ss += a * a + c * c; *(unsigned*)(op + d) = pk2(a, c); }
        F.ssq0[(size_t)tok * 16 + hh] = ss;
    }
}


namespace att {
typedef short bf16x8 __attribute__((ext_vector_type(8)));
typedef short s16x4 __attribute__((ext_vector_type(4)));
typedef float f32x16 __attribute__((ext_vector_type(16)));
typedef unsigned u32x4 __attribute__((ext_vector_type(4)));
typedef LAS const char* lds_cptr;
constexpr int NSLOT = 4, SLOTB = 8192;
constexpr int L_K = 0, L_V = NSLOT * SLOTB, L_WS = 2 * NSLOT * SLOTB, L_OST = L_WS + 8 * 256, L_TAB = L_OST + 8 * 4096, L_END = L_TAB + 16384;
static_assert(L_END <= RING_BYTES, "attention LDS map");
typedef short v4i16_t __attribute__((ext_vector_type(4)));
#define ATT_NEG (-INFINITY)
__device__ __forceinline__ int crow(int r, int hi) { return (r & 3) + 8 * (r >> 2) + 4 * hi; }
__device__ __forceinline__ void glds16(const void* gsrc, unsigned lds_dst) { unsigned keep;
    asm volatile("s_mov_b32 %0, m0\n\ts_mov_b32 m0, %2\n\ts_nop 0\n\tglobal_load_lds_dwordx4 %1, off\n\ts_mov_b32 m0, %0" : "=&s"(keep) : "v"(gsrc), "s"(lds_dst) : "memory"); }
typedef float f32x2_t __attribute__((ext_vector_type(2))); typedef __bf16 bf16x2_t __attribute__((ext_vector_type(2)));
__device__ __forceinline__ unsigned cvtpk_s(float lo, float hi) { f32x2_t v = {lo, hi}; bf16x2_t b = __builtin_convertvector(v, bf16x2_t); return __builtin_bit_cast(unsigned, b); }
#define ATT_WAIT_BAR(N) asm volatile("s_waitcnt vmcnt(" #N ") lgkmcnt(0)\n\ts_barrier" ::: "memory")
#define ATT_SBAR() __builtin_amdgcn_sched_barrier(0)

__device__ __forceinline__ void qkt(f32x16& p0, f32x16& p1, lds_cptr kb, const bf16x8 (&qr)[4]) {
#pragma unroll
    for (int d0 = 0; d0 < 4; ++d0) {
        const bf16x8 b0 = *(LAS const bf16x8*)(kb + d0 * 2048);
        const bf16x8 b1 = *(LAS const bf16x8*)(kb + d0 * 2048 + 512);
        p0 = __builtin_amdgcn_mfma_f32_32x32x16_bf16(b0, qr[d0], p0, 0, 0, 0);
        p1 = __builtin_amdgcn_mfma_f32_32x32x16_bf16(b1, qr[d0], p1, 0, 0, 0); }
}
__device__ __forceinline__ void pv(f32x16 (&o)[2], int vb, bf16x8 pa0, bf16x8 pa1, bf16x8 pa2, bf16x8 pa3) {
#pragma unroll
    for (int d0 = 0; d0 < 2; ++d0) { s16x4 lo[4], hi[4];
#pragma unroll
        for (int ks = 0; ks < 4; ++ks) {
            asm volatile("ds_read_b64_tr_b16 %0,%1 offset:%c2" : "=&v"(lo[ks]) : "v"(vb), "i"(d0 * 4096 + ks * 1024) : "memory");
            asm volatile("ds_read_b64_tr_b16 %0,%1 offset:%c2" : "=&v"(hi[ks]) : "v"(vb), "i"(d0 * 4096 + ks * 1024 + 512) : "memory"); }
        asm volatile("s_waitcnt lgkmcnt(0)" ::: "memory"); ATT_SBAR();
#define ATT_PK(k) (bf16x8){lo[k][0], lo[k][1], lo[k][2], lo[k][3], hi[k][0], hi[k][1], hi[k][2], hi[k][3]}
        o[d0] = __builtin_amdgcn_mfma_f32_32x32x16_bf16(pa0, ATT_PK(0), o[d0], 0, 0, 0);
        o[d0] = __builtin_amdgcn_mfma_f32_32x32x16_bf16(pa1, ATT_PK(1), o[d0], 0, 0, 0);
        o[d0] = __builtin_amdgcn_mfma_f32_32x32x16_bf16(pa2, ATT_PK(2), o[d0], 0, 0, 0);
        o[d0] = __builtin_amdgcn_mfma_f32_32x32x16_bf16(pa3, ATT_PK(3), o[d0], 0, 0, 0);
#undef ATT_PK
    }
}

struct PolA {
    int b, r, T0, NT, NT_own, jmin, jpmin, per, iq;
    LAS const float* tab; int hi;
    __device__ __forceinline__ void init(int b_, int r_, int Tblk, int wid, int r32, int hi_, LAS const float* tab_) {
        b = b_; r = r_; T0 = 256 * Tblk; jmin = T0 >= 512 ? 0 : (512 - T0) / 64; NT_own = 12 - jmin; jpmin = T0 == 0 ? 1 : 0; per = 5 - jpmin; NT = NT_own + 3 * per;
        iq = T0 + 32 * wid + r32; tab = tab_; hi = hi_; }
    __device__ __forceinline__ void tile(int t, int& rho, int& ik0, int& k) const {
        if (t < NT_own) { k = 0; rho = r; ik0 = T0 - 512 + 64 * (jmin + t); }
        else { const int tp = t - NT_own; k = 1 + tp / per; rho = (r + k) & 3; ik0 = T0 - 64 + 64 * (jpmin + tp % per); } }
    __device__ __forceinline__ long row0(int t) const { int rho, ik0, k; tile(t, rho, ik0, k); return (long)b * SEQ + rho * 1024 + ik0; }
    __device__ __forceinline__ long qrow(int wid, int r32) const { return (long)b * SEQ + r * 1024 + T0 + 32 * wid + r32; }
    __device__ __forceinline__ long orow(int wid, int row) const { return (long)b * SEQ + 4 * (T0 + 32 * wid + row) + r; }
    __device__ __forceinline__ bool active(int t, int wid) const {
        int rho, ik0, k; tile(t, rho, ik0, k); const int dmax = T0 + 32 * wid + 31 - ik0, dmin = T0 + 32 * wid - ik0 - 63; return dmax >= 0 && dmin <= (k == 0 ? 512 : 32); }
    __device__ __forceinline__ void cinit(int t, f32x16& p0, f32x16& p1) const {
        int rho, ik0, k; tile(t, rho, ik0, k);
        LAS const float* tb = tab + (k == 0 ? 0 : 1024 + (k - 1) * 576) + (iq - ik0 - 4 * hi + 256 - 63);
#pragma unroll
        for (int rr = 0; rr < 16; ++rr) { const int c = (rr & 3) + 8 * (rr >> 2); p0[rr] = tb[63 - c]; p1[rr] = tb[31 - c]; }
    }
};
__device__ __forceinline__ void fill_tab_A(LAS float* tab, int h, int r, int tid) {
    const float sl2 = exp2f(-0.5f * (float)(2 * h + 1)) * LOG2E;
    for (int idx = tid; idx < 1024; idx += NWAVES * 64) { const int dl = idx - 256; float v = ATT_NEG;
        if (dl >= 0 && dl <= 512) { const int w = (dl <= 32 ? 1 : 0) + (dl <= 128 ? 1 : 0) + ((dl & 3) == 0 ? 1 : 0);
            if (w > 0) v = (w == 1 ? 0.f : (w == 2 ? 1.f : 1.5849625007211562f)) - sl2 * (float)(4 * dl); }
        tab[idx] = v; }
    for (int idx = tid; idx < 3 * 576; idx += NWAVES * 64) { const int k = 1 + idx / 576, dl = idx % 576 - 256; const int rho = (r + k) & 3; const int dist = 4 * dl + (r - rho);
        tab[1024 + idx] = (dist >= 0 && dist <= 128) ? -sl2 * (float)dist : ATT_NEG; }
}

struct PolB {
    int b, i, NT, dq0, hi; unsigned sel; float sl2;
    __device__ __forceinline__ long row0(int t) const { return (long)b * SEQ + 64 * t; }
    __device__ __forceinline__ long qrow(int wid, int r32) const { return (long)b * SEQ + 256 * i + 32 * wid + r32; }
    __device__ __forceinline__ long orow(int wid, int row) const { return (long)b * SEQ + 256 * i + 32 * wid + row; }
    __device__ __forceinline__ bool active(int t, int) const { return __any((int)((sel >> (t >> 2)) & 1u)) != 0; }
    __device__ __forceinline__ void cinit(int t, f32x16& p0, f32x16& p1) const {
        const int dqi = 64 * t + dq0;
        float base = sl2 * (float)dqi; if (!((sel >> (t >> 2)) & 1u)) base = ATT_NEG;
        const float base1 = base + 32.0f * sl2;
#pragma unroll
        for (int rr = 0; rr < 16; ++rr) { const int c = (rr & 3) + 8 * (rr >> 2); p0[rr] = base + sl2 * (float)c; p1[rr] = base1 + sl2 * (float)c; }
        if (t >= 4 * i) {
            asm volatile("; causal band tile" ::: "memory");
#pragma unroll
            for (int rr = 0; rr < 16; ++rr) { const int c = (rr & 3) + 8 * (rr >> 2); if (dqi + c > 0) p0[rr] = ATT_NEG; if (dqi + c + 32 > 0) p1[rr] = ATT_NEG; }
        }
    }
    __device__ __forceinline__ void select(const bf16x8 (&qr)[4], LAS const float* km) {
        float qf[32];
#pragma unroll
        for (int d0 = 0; d0 < 4; ++d0)
#pragma unroll
            for (int j = 0; j < 8; ++j) qf[8 * d0 + j] = __uint_as_float((unsigned)(unsigned short)qr[d0][j] << 16);
        int i0 = -1, i1 = -1, i2 = -1; float g0 = ATT_NEG, g1 = ATT_NEG, g2 = ATT_NEG;
        for (int n = 0; n < i; ++n) { float g = 0.f;
#pragma unroll
            for (int d0 = 0; d0 < 4; ++d0) { const f32x4 ka = *(LAS const f32x4*)(km + n * 64 + 16 * d0 + 8 * hi), kb = *(LAS const f32x4*)(km + n * 64 + 16 * d0 + 8 * hi + 4);
                g += (qf[8 * d0 + 0] * ka.x + qf[8 * d0 + 1] * ka.y) + (qf[8 * d0 + 2] * ka.z + qf[8 * d0 + 3] * ka.w) + (qf[8 * d0 + 4] * kb.x + qf[8 * d0 + 5] * kb.y) + (qf[8 * d0 + 6] * kb.z + qf[8 * d0 + 7] * kb.w); }
            g += __shfl_xor(g, 32);
            if (g > g0) { g2 = g1; i2 = i1; g1 = g0; i1 = i0; g0 = g; i0 = n; } else if (g > g1) { g2 = g1; i2 = i1; g1 = g; i1 = n; } else if (g > g2) { g2 = g; i2 = n; } }
        sel = 1u << i; if (i0 >= 0) sel |= 1u << i0; if (i1 >= 0) sel |= 1u << i1; if (i2 >= 0) sel |= 1u << i2;
    }
};

template <class P, bool SELECT>
__device__ __forceinline__ void attn_unit(P& pol, const bf16* Qc, const bf16* Kc, const bf16* Vc, bf16* Oc, float* ssq, int hh, LAS unsigned char* shm, LAS const float* km) {
    int tid = threadIdx.x; asm volatile("" : "+v"(tid)); const int lane = tid & 63, r32 = lane & 31, hi = lane >> 5; const int wid = __builtin_amdgcn_readfirstlane(tid >> 6);
    const unsigned lds0 = (unsigned)(uintptr_t)shm;
    LAS float* wsf = (LAS float*)(shm + L_WS) + wid * 64;
    const int NT = pol.NT;
    const bf16* ksrc = Kc + (long)lane * D + wid * 8;
    const bf16* vsrc = Vc + (long)(16 * (wid & 3) + (lane >> 2)) * D + (wid >> 2) * 32 + (lane & 3) * 8;
    const unsigned kdst = lds0 + L_K + wid * 1024, vdst = lds0 + L_V + wid * 1024;
#define ATT_DMA(t, slot) do { const long r0_ = pol.row0(t); glds16(ksrc + r0_ * D, (unsigned)__builtin_amdgcn_readfirstlane(kdst + (slot))); glds16(vsrc + r0_ * D, (unsigned)__builtin_amdgcn_readfirstlane(vdst + (slot))); } while (0)
    bf16x8 qr[4];
    { const bf16* qp = Qc + pol.qrow(wid, r32) * D + hi * 8;
#pragma unroll
      for (int d0 = 0; d0 < 4; ++d0) qr[d0] = *(const bf16x8*)(qp + d0 * 16); }
    ATT_DMA(0, 0); ATT_DMA(1, SLOTB); ATT_DMA(2, 2 * SLOTB);
    if constexpr (SELECT) pol.select(qr, km);
    f32x16 o[2]; o[0] = f32x16{}; o[1] = f32x16{}; float l_reg = 0.f;
    const lds_cptr kp0 = (lds_cptr)shm + L_K + hi * 1024 + r32 * 16;
    const int vb0 = (int)(lds0 + L_V) + ((lane >> 4) & 1) * 32 + (lane & 3) * 8 + (4 * hi + ((lane & 15) >> 2)) * 64;
#define ATT_EXP(P0, P1) do { _Pragma("unroll") for (int rr = 0; rr < 16; ++rr) { P0[rr] = __builtin_amdgcn_exp2f(P0[rr]); P1[rr] = __builtin_amdgcn_exp2f(P1[rr]); } } while (0)
#define ATT_SOFTMAX_PV(P0, P1, slotoff) do { float sacc = 0.f; \
        _Pragma("unroll") for (int rr = 0; rr < 16; ++rr) { sacc += P0[rr] + P1[rr]; } \
        l_reg += sacc; \
        const u32x4 pw0 = (u32x4){cvtpk_s(P0[0], P0[1]), cvtpk_s(P0[2], P0[3]), cvtpk_s(P0[4], P0[5]), cvtpk_s(P0[6], P0[7])}; \
        const u32x4 pw1 = (u32x4){cvtpk_s(P0[8], P0[9]), cvtpk_s(P0[10], P0[11]), cvtpk_s(P0[12], P0[13]), cvtpk_s(P0[14], P0[15])}; \
        const u32x4 pw2 = (u32x4){cvtpk_s(P1[0], P1[1]), cvtpk_s(P1[2], P1[3]), cvtpk_s(P1[4], P1[5]), cvtpk_s(P1[6], P1[7])}; \
        const u32x4 pw3 = (u32x4){cvtpk_s(P1[8], P1[9]), cvtpk_s(P1[10], P1[11]), cvtpk_s(P1[12], P1[13]), cvtpk_s(P1[14], P1[15])}; \
        ATT_SBAR(); pv(o, vb0 + (slotoff), __builtin_bit_cast(bf16x8, pw0), __builtin_bit_cast(bf16x8, pw1), __builtin_bit_cast(bf16x8, pw2), __builtin_bit_cast(bf16x8, pw3)); ATT_SBAR(); } while (0)
#define ATT_BODY(PC0, PC1, PN0, PN1, t) do { \
        if ((t) + 2 < NT) { ATT_WAIT_BAR(2); } else { ATT_WAIT_BAR(0); } \
        if ((t) + 3 < NT) ATT_DMA((t) + 3, (((t) + 3) & 3) * SLOTB); \
        const bool an_ = ((t) + 1 < NT) && pol.active((t) + 1, wid); const int tn_ = ((t) + 1 < NT) ? (t) + 1 : (t); \
        if (acur || an_) { pol.cinit(tn_, PN0, PN1); ATT_SBAR(); qkt(PN0, PN1, kp0 + (tn_ & 3) * SLOTB, qr); ATT_EXP(PC0, PC1); ATT_SBAR(); ATT_SOFTMAX_PV(PC0, PC1, ((t) & 3) * SLOTB); } \
        else { _Pragma("unroll") for (int rr = 0; rr < 16; ++rr) { PN0[rr] = ATT_NEG; PN1[rr] = ATT_NEG; } } \
        acur = an_; } while (0)
    f32x16 pA0, pA1, pB0, pB1;
    asm volatile("s_waitcnt vmcnt(4) lgkmcnt(0)\n\ts_barrier" ::: "memory");
    bool acur = pol.active(0, wid);
    { pol.cinit(0, pA0, pA1); qkt(pA0, pA1, kp0, qr); }
    for (int t = 0; t < NT; t += 2) {
        ATT_BODY(pA0, pA1, pB0, pB1, t);
        if (t + 1 < NT) ATT_BODY(pB0, pB1, pA0, pA1, t + 1);
    }
#undef ATT_BODY
#undef ATT_SOFTMAX_PV
#undef ATT_EXP
#undef ATT_DMA
    l_reg += __shfl_xor(l_reg, 32);
    if (hi == 0) wsf[32 + r32] = l_reg;
    asm volatile("s_waitcnt lgkmcnt(0)" ::: "memory");
    float rli[16];
#pragma unroll
    for (int rr = 0; rr < 16; ++rr) rli[rr] = 1.0f / wsf[32 + crow(rr, hi)];
    { LAS unsigned short* stg = (LAS unsigned short*)(shm + L_OST) + wid * 2048;
#pragma unroll
      for (int rr = 0; rr < 16; ++rr) { const int orow = crow(rr, hi);
#pragma unroll
          for (int d0 = 0; d0 < 2; ++d0) stg[orow * 64 + d0 * 32 + r32] = (unsigned short)f2bf(o[d0][rr] * rli[rr]); }
      asm volatile("s_waitcnt lgkmcnt(0)" ::: "memory");
#pragma unroll
      for (int i4 = 0; i4 < 4; ++i4) { const int row = i4 * 8 + (lane >> 3), ch = lane & 7; const u32x4 v = *(LAS const u32x4*)(stg + row * 64 + ch * 8);
          const long grow = pol.orow(wid, row);
          *(u32x4*)(Oc + grow * D + ch * 8) = v;
          float ss = 0.f;
#pragma unroll
          for (int e = 0; e < 4; ++e) { const float a = __uint_as_float(v[e] << 16), c = __uint_as_float(v[e] & 0xffff0000u); ss += a * a + c * c; }
          ss += __shfl_xor(ss, 1); ss += __shfl_xor(ss, 2); ss += __shfl_xor(ss, 4);
          if (ch == 0) ssq[grow * 16 + hh] = ss; } }
    asm volatile("s_waitcnt vmcnt(0) lgkmcnt(0)\n\ts_barrier" ::: "memory");
}

__device__ __forceinline__ void attn_phase(Frame& F) {
    LAS unsigned char* shm = F.lds + RING_OFF;
    LAS float* tab = (LAS float*)(shm + L_TAB);
    int tid_a = threadIdx.x; asm volatile("" : "+v"(tid_a)); const int r32 = tid_a & 31, hi = (tid_a >> 5) & 1;
    for (int su = F.vcu; su < 256; su += F.G) {
        const int b = su >> 5, h = (su >> 2) & 7, r = su & 3;
        fill_tab_A(tab, h, r, F.tid);
        asm volatile("s_waitcnt lgkmcnt(0)\n\ts_barrier" ::: "memory");
        for (int Tb = 0; Tb < 4; ++Tb) { PolA pol; pol.init(b, r, Tb, F.wave, r32, hi, tab);
            attn_unit<PolA, false>(pol, F.QB + h * 64, F.KB + h * 64, F.VB + h * 64, F.OB + h * 64, F.ssq0, h, shm, nullptr); }
    }
    for (int su = F.vcu; su < 256; su += F.G) {
        const int b = su >> 5, h = (su >> 2) & 7, qt = su & 3;
        for (int idx = F.tid; idx < 1024; idx += NWAVES * 64) { const int n = idx >> 6, d = idx & 63; const float* kp = F.kpart + (size_t)((b * 16 + n) * 2) * 512 + h * 64 + d; tab[idx] = kp[0] + kp[512]; }
        asm volatile("s_waitcnt vmcnt(0) lgkmcnt(0)\n\ts_barrier" ::: "memory");
        for (int u4 = 0; u4 < 4; ++u4) { const int s = 2 * qt + (u4 >> 1); const int i = (u4 & 1) ? 15 - s : s;
            PolB pol; pol.b = b; pol.i = i; pol.NT = 4 * (i + 1); pol.hi = hi; pol.dq0 = 4 * hi - (256 * i + 32 * F.wave + r32); pol.sl2 = exp2f(-(float)(h + 1)) * LOG2E; pol.sel = 0u;
            attn_unit<PolB, true>(pol, F.QB + 512 + h * 64, F.KB + 512 + h * 64, F.VB + 512 + h * 64, F.OB + 512 + h * 64, F.ssq0, 8 + h, shm, tab); }
    }
}
#undef ATT_WAIT_BAR
#undef ATT_SBAR
}

__device__ __forceinline__ void final_norm(Frame& F) {
    int tid_f = threadIdx.x; asm volatile("" : "+v"(tid_f)); const int lane_f = tid_f & 63;
    const int gw = F.vcu * NWAVES + F.wave, NGW = F.G * NWAVES;
    f32x4 g[2][2];
#pragma unroll
    for (int j = 0; j < 2; ++j) { g[j][0] = *(const GAS f32x4*)(F.g_final + 512 * j + 8 * lane_f); g[j][1] = *(const GAS f32x4*)(F.g_final + 512 * j + 8 * lane_f + 4); }
    for (int m = gw; m < M; m += NGW) {
        const GAS f32x4* sp = (const GAS f32x4*)(F.ssq3 + (size_t)m * 16);
        const f32x4 a = sp[0], b = sp[1], c = sp[2], d = sp[3];
        const float s = ((a.x + a.y) + (a.z + a.w)) + ((b.x + b.y) + (b.z + b.w)) + ((c.x + c.y) + (c.z + c.w)) + ((d.x + d.y) + (d.z + d.w));
        const float rstd = 1.f / sqrtf(s * (1.f / D) + EPS);
#pragma unroll
        for (int j = 0; j < 2; ++j) { const v4u w = *(const GAS v4u*)(F.XN + (size_t)m * D + 512 * j + 8 * lane_f);
            f32x4 o0 = (f32x4){__uint_as_float(w.x << 16), __uint_as_float(w.x & 0xffff0000u), __uint_as_float(w.y << 16), __uint_as_float(w.y & 0xffff0000u)};
            f32x4 o1 = (f32x4){__uint_as_float(w.z << 16), __uint_as_float(w.z & 0xffff0000u), __uint_as_float(w.w << 16), __uint_as_float(w.w & 0xffff0000u)};
            GAS f32x4* op = (GAS f32x4*)(F.out + (size_t)m * D + 512 * j + 8 * lane_f);
            op[0] = o0 * rstd * g[j][0]; op[1] = o1 * rstd * g[j][1]; }
    }
}

struct Args { const float* in[15]; float* out; unsigned char* ws; int ph_lo, ph_hi, li, pad; };
__global__ void __launch_bounds__(NWAVES * 64, 2) mk_fwd(Args args) {
    extern __shared__ __attribute__((aligned(16))) unsigned char lds[];
    Frame F;
    F.lds = (LAS unsigned char*)lds;
    F.MISC = (volatile LAS unsigned*)(F.lds + MISC_OFF);
    F.tid = threadIdx.x; F.lane = F.tid & 63; F.wave = __builtin_amdgcn_readfirstlane(F.tid >> 6);
    F.G = gridDim.x; { const int bx = blockIdx.x; F.vcu = (F.G % 8 == 0) ? (bx % 8) * (F.G / 8) + bx / 8 : bx; }
    unsigned char* ws = args.ws;
    F.ctl = (gu32*)(ws + WS_CTL);
    F.x = args.in[0]; F.p = args.in[1]; F.g_attn = args.in[2]; F.w_in = args.in[3]; F.g_out_a = args.in[4]; F.g_out_b = args.in[5]; F.w_out = args.in[6]; F.g_mlp = args.in[7];
    F.w_up = args.in[8]; F.w_down = args.in[9]; F.g_ple = args.in[10]; F.w_gate = args.in[11]; F.b_gate = args.in[12]; F.w_proj = args.in[13]; F.g_final = args.in[14]; F.out = args.out;
    F.Wqkv_t = (bf16*)(ws + WS_WQKV); F.Wo_t = (bf16*)(ws + WS_WO); F.Wup_t = (bf16*)(ws + WS_WUP); F.Wdn_t = (bf16*)(ws + WS_WDN); F.Wg_t = (bf16*)(ws + WS_WG); F.Wp_t = (bf16*)(ws + WS_WP);
    F.XN = (bf16*)(ws + WS_XN); F.QB = (bf16*)(ws + WS_Q); F.KB = (bf16*)(ws + WS_K); F.VB = (bf16*)(ws + WS_V); F.OB = (bf16*)(ws + WS_O); F.UB = (bf16*)(ws + WS_U); F.PB = (bf16*)(ws + WS_PB); F.PP = (bf16*)(ws + WS_PP);
    F.ssq0 = (float*)(ws + WS_SSQ0); F.ssq1 = (float*)(ws + WS_SSQ1); F.ssq2 = (float*)(ws + WS_SSQ2); F.ssq3 = (float*)(ws + WS_SSQ3); F.kpart = (float*)(ws + WS_KPART);
    for (int u = F.tid; u < (LDS_BYTES - LDSCTL_OFF) / 4; u += NWAVES * 64) ((LAS unsigned*)(F.lds + LDSCTL_OFF))[u] = 0u;
    __syncthreads();
    XcdBarrier bar; bar.bar = (unsigned*)(F.ctl + CW_BAR); bar.x = 0; bar.st = nullptr;
    if (N_LAUNCHES == 1) bar = xcd_barrier_post((unsigned*)(F.ctl + CW_BAR), F.MISC + 8);
    PG8_LAS float* tab = (PG8_LAS float*)(F.lds + TAB_OFF);
    const int lo = args.ph_lo, hi = args.ph_hi;
#define IN(k) (lo <= (k) && (k) < hi)
#define SEAM(k) do { if (IN(k) && IN((k) + 1)) xcd_barrier(bar); } while (0)

    if (IN(0)) { p0_prologue(F); SEAM(0); }
    if (IN(1)) {
        { pg8::Gemm g{F.XN, F.Wqkv_t, M, NQKV, D}; pg8::StaticOrder S; S.init(M, NQKV, F.G, (int)blockIdx.x);
          pg8::EpiQKV E{F.QB, (size_t)(WS_K - WS_Q) / 2, F.kpart, C2};
          pg8::gemm_phase<pg8::EpiQKV, pg8::StaticOrder, true, true>(F.lds + RING_OFF, tab, g, S, E); }
        { pg8::Gemm g{F.PB, F.Wp_t, M, D, PLE}; pg8::StaticOrder S; S.init(M, D, F.G, (int)blockIdx.x);
          pg8::EpiBf16Plain E{F.PP, D};
          pg8::gemm_phase<pg8::EpiBf16Plain, pg8::StaticOrder, true, true>(F.lds + RING_OFF, tab, g, S, E); }
        SEAM(1);
    }
#if defined(ATT_NAIVE)
    if (IN(2)) { attn_naive(F); SEAM(2); }
#else
    if (IN(2)) { att::attn_phase(F); SEAM(2); }
#endif
    if (IN(3)) {
        pg8::Gemm g{F.OB, F.Wo_t, M, D, D}; pg8::StaticOrder S; S.init(M, D, F.G, (int)blockIdx.x);
        pg8::EpiRes<1> E{F.x, F.XN, F.ssq1, F.ssq0};
        pg8::gemm_phase<pg8::EpiRes<1>, pg8::StaticOrder, true, true>(F.lds + RING_OFF, tab, g, S, E);
        SEAM(3);
    }
    if (IN(4)) {
        pg8::Gemm g{F.XN, F.Wup_t, M, FF, D}; pg8::StaticOrder S; S.init(M, FF, F.G, (int)blockIdx.x);
        pg8::EpiUp E{F.UB, FF, F.ssq1};
        pg8::gemm_phase<pg8::EpiUp, pg8::StaticOrder, true, true>(F.lds + RING_OFF, tab, g, S, E);
        SEAM(4);
    }
    if (IN(5)) {
        pg8::Gemm g{F.UB, F.Wdn_t, M, D, FF}; pg8::StaticOrder S; S.init(M, D, F.G, (int)blockIdx.x);
        pg8::EpiRes<0> E{nullptr, F.XN, F.ssq2, nullptr};
        pg8::gemm_phase<pg8::EpiRes<0>, pg8::StaticOrder, true, true>(F.lds + RING_OFF, tab, g, S, E);
        SEAM(5);
    }
    if (IN(6)) {
        pg8::Gemm g{F.XN, F.Wg_t, M, D, D}; pg8::StaticOrder S; S.init(M, D, F.G, (int)blockIdx.x);
        pg8::EpiGate E{F.XN, F.PP, F.b_gate, F.ssq3, F.ssq2};
        pg8::gemm_phase<pg8::EpiGate, pg8::StaticOrder, true, true>(F.lds + RING_OFF, tab, g, S, E);
        SEAM(6);
    }
    if (IN(7)) { final_norm(F); }
#undef IN
#undef SEAM
}

extern "C" void kernel_launch(void* const* d_in, const int* in_sizes, int n_in, void* d_out, int out_size, void* d_ws, size_t ws_size, hipStream_t stream) {
    static int grid = 0;
    if (grid == 0) {
        if (n_in != 15 || in_sizes[0] != M * D || out_size != M * D || ws_size < WS_END) { fprintf(stderr, "kernel_launch: unexpected shapes (n_in %d, in0 %d, out %d, ws %zu); nothing launched\n", n_in, n_in > 0 ? in_sizes[0] : -1, out_size, ws_size); grid = -1; return; }
        int dev = 0, cus = 0, per_cu = 0;
        if (hipGetDevice(&dev) != hipSuccess || hipDeviceGetAttribute(&cus, hipDeviceAttributeMultiprocessorCount, dev) != hipSuccess) { grid = -1; return; }
        if (hipFuncSetAttribute((const void*)mk_fwd, hipFuncAttributeMaxDynamicSharedMemorySize, LDS_BYTES) != hipSuccess) { fprintf(stderr, "kernel_launch: hipFuncSetAttribute failed\n"); grid = -1; return; }
        if (hipOccupancyMaxActiveBlocksPerMultiprocessor(&per_cu, (const void*)mk_fwd, NWAVES * 64, LDS_BYTES) != hipSuccess || per_cu < 1) { fprintf(stderr, "kernel_launch: occupancy query reports %d blocks per CU\n", per_cu); }
        (void)hipGetLastError();
        grid = cus;
    }
    if (grid < 0) return;
    if (hipMemsetAsync((char*)d_ws + WS_CTL, 0, CTL_ZERO_BYTES, stream) != hipSuccess) { fprintf(stderr, "kernel_launch: hipMemsetAsync failed\n"); return; }
    Args a{};
    for (int i = 0; i < 15; ++i) a.in[i] = (const float*)d_in[i];
    a.out = (float*)d_out; a.ws = (unsigned char*)d_ws;
    for (int li = 0; li < N_LAUNCHES; ++li) {
        a.ph_lo = (N_LAUNCHES == 1) ? 0 : li; a.ph_hi = (N_LAUNCHES == 1) ? NPHASE : li + 1; a.li = li;
        hipLaunchKernelGGL(mk_fwd, dim3(grid), dim3(NWAVES * 64), LDS_BYTES, stream, a);
        const hipError_t le = hipPeekAtLastError();
        if (le != hipSuccess) { fprintf(stderr, "kernel_launch: launch %d failed: %s\n", li, hipGetErrorName(le)); break; }
    }
}
```

```cpp
#include <hip/hip_runtime.h>
#include <cstdio>
#include <cstdint>
namespace pg8 {
#define PG8_LAS __attribute__((address_space(3)))
typedef unsigned short bf16_t;
typedef short bf16x8 __attribute__((ext_vector_type(8)));
typedef float f32x4 __attribute__((ext_vector_type(4)));
typedef unsigned u32x4 __attribute__((ext_vector_type(4)));
constexpr int BM = 256, BK = 64, HALF = 128, HTB = HALF * BK * 2  , STAGE_BYTES = 8 * HTB, NXCD = 8, WGM = 8;

__host__ __device__ __forceinline__ int lds_byte(int r, int c) { const int st = (r >> 4) * 2 + (c >> 5), rr = r & 15, cc = c & 31, ob = rr * 64 + cc * 2; return st * 1024 + (ob ^ (((ob >> 9) & 1) << 5)); }
__host__ __device__ __forceinline__ void stage_rc(int b, int& R, int& C) { const int st = b / 1024, sb = b % 1024, swz = sb ^ (((sb >> 9) & 1) << 5); R = (st >> 1) * 16 + swz / 64; C = (st & 1) * 32 + (swz % 64) / 2; }
__host__ __device__ __forceinline__ int perm32(int rho) { const int n = rho >> 4, i = rho & 15; return 8 * (i >> 2) + 4 * n + (i & 3); }

struct Unit { int pm, pn; };
struct Gemm { const bf16_t* A; const bf16_t* Bt; int M, N, K; };

struct StaticOrder {
    int nM, nN, nwg, G, c;
    __host__ __device__ void init(int M, int N, int G_, int c_) { nM = M / BM; nN = N / BM; nwg = nM * nN; G = G_; c = c_; }
    __host__ __device__ bool next(int i, Unit& u) const {
        const long L = (long)i * G + c; if (L >= nwg) return false;
        int wgid = (int)L; { const int q = nwg / NXCD, r = nwg % NXCD, xcd = wgid % NXCD, off = wgid / NXCD; wgid = (xcd < r ? xcd * (q + 1) : r * (q + 1) + (xcd - r) * q) + off; }
        const int nig = WGM * nN, gid = wgid / nig, fm = gid * WGM, gsz = (nM - fm) < WGM ? (nM - fm) : WGM;
        u.pm = fm + ((wgid % nig) % gsz); u.pn = (wgid % nig) / gsz; return true;
    }
    __device__ __forceinline__ void a_ready(const Unit&) const {}
    __device__ __forceinline__ void done(const Unit&) const {}
};

__device__ __forceinline__ unsigned cvt_pk_bf16(float lo, float hi) { unsigned r; asm volatile("v_cvt_pk_bf16_f32 %0, %1, %2" : "=v"(r) : "v"(lo), "v"(hi)); return r; }
typedef unsigned u32x2 __attribute__((ext_vector_type(2)));
constexpr float RMS_EPS = 1e-6f;
__device__ __forceinline__ float sum4(f32x4 v) { return (v[0] + v[1]) + (v[2] + v[3]); }

struct EpiBf16Plain {
    static constexpr bool PERM = true, AFTER_DRAIN = false, MID = false, TABLE = false;
    bf16_t* O; int ldc;
    __device__ __forceinline__ void operator()(f32x4 (&acc)[2][2][4][2], const Unit& u, int wr, int wc, int fr, int fq, PG8_LAS float*, int) const {
        const int row0 = u.pm * BM + wr * 64 + fr, col0 = u.pn * BM + wc * 32 + 8 * fq;
#pragma unroll
        for (int ai = 0; ai < 2; ++ai)
#pragma unroll
            for (int m = 0; m < 4; ++m) { bf16_t* rowp = O + (size_t)(row0 + ai * HALF + m * 16) * ldc + col0;
#pragma unroll
                for (int bj = 0; bj < 2; ++bj) { const f32x4 v0 = acc[ai][bj][m][0], v1 = acc[ai][bj][m][1];
                    u32x4 w; w.x = cvt_pk_bf16(v0[0], v0[1]); w.y = cvt_pk_bf16(v0[2], v0[3]); w.z = cvt_pk_bf16(v1[0], v1[1]); w.w = cvt_pk_bf16(v1[2], v1[3]);
                    *(u32x4*)(rowp + bj * HALF) = w; } }
    }
};

struct EpiQKV {
    static constexpr bool PERM = true, AFTER_DRAIN = false, MID = false, TABLE = false;
    bf16_t* Q; size_t part_stride; float* kpart; float qscale;
    __device__ __forceinline__ void operator()(f32x4 (&acc)[2][2][4][2], const Unit& u, int wr, int wc, int fr, int fq, PG8_LAS float*, int) const {
        const int part = u.pn >> 2, pc = u.pn & 3; const bool ga = pc < 2;
        bf16_t* base = Q + (size_t)part * part_stride; const float sc = part == 0 ? qscale : 1.0f;
        const int row0 = u.pm * BM + wr * 64 + fr, col0 = pc * BM + wc * 32 + 8 * fq;
#pragma unroll
        for (int ai = 0; ai < 2; ++ai)
#pragma unroll
            for (int m = 0; m < 4; ++m) { const int row = row0 + ai * HALF + m * 16;
                const int rowd = ga ? ((row & ~4095) | ((row & 3) << 10) | ((row & 4095) >> 2)) : row;
                bf16_t* rowp = base + (size_t)rowd * 1024 + col0;
#pragma unroll
                for (int bj = 0; bj < 2; ++bj) { const f32x4 v0 = acc[ai][bj][m][0] * sc, v1 = acc[ai][bj][m][1] * sc;
                    u32x4 w; w.x = cvt_pk_bf16(v0[0], v0[1]); w.y = cvt_pk_bf16(v0[2], v0[3]); w.z = cvt_pk_bf16(v1[0], v1[1]); w.w = cvt_pk_bf16(v1[2], v1[3]);
                    *(u32x4*)(rowp + bj * HALF) = w; } }
        if (part == 1 && !ga) {
#pragma unroll
            for (int bj = 0; bj < 2; ++bj) {
                f32x4 s0 = acc[0][bj][0][0], s1 = acc[0][bj][0][1];
#pragma unroll
                for (int ai = 0; ai < 2; ++ai)
#pragma unroll
                    for (int m = 0; m < 4; ++m) if (ai + m) { s0 += acc[ai][bj][m][0]; s1 += acc[ai][bj][m][1]; }
#pragma unroll
                for (int e = 0; e < 4; ++e) {
#pragma unroll
                    for (int o = 1; o < 16; o <<= 1) { s0[e] += __shfl_xor(s0[e], o); s1[e] += __shfl_xor(s1[e], o); } }
                if (fr == 0) { float* kp = kpart + (size_t)(u.pm * 2 + wr) * 512 + (pc - 2) * BM + bj * HALF + wc * 32 + 8 * fq;
                    *(f32x4*)kp = s0; *(f32x4*)(kp + 4) = s1; }
            }
        }
    }
};

template <int KIND> __device__ __forceinline__ void fill_rowscale(const float* ssq, const Unit& u, int par, PG8_LAS float* tab, int tid) {
    if (tid < 256) {
        const f32x4* p = (const f32x4*)(ssq + (size_t)(u.pm * BM + tid) * 16);
        const f32x4 a0 = p[0], a1 = p[1], b0 = p[2], b1 = p[3];
        const float sa = sum4(a0) + sum4(a1), sb = sum4(b0) + sum4(b1);
        if (KIND == 1) { tab[par * 512 + 2 * tid] = 1.0f / sqrtf((sa + sb) * (1.0f / 1024.0f) + RMS_EPS); }
        else { const float ra = 1.0f / sqrtf(sa * (1.0f / 512.0f) + RMS_EPS), rb = 1.0f / sqrtf(sb * (1.0f / 512.0f) + RMS_EPS);
            tab[par * 512 + 2 * tid] = ra / rb; tab[par * 512 + 2 * tid + 1] = rb; }
    }
}

struct EpiUp {
    static constexpr bool PERM = true, AFTER_DRAIN = false, MID = false, TABLE = true;
    bf16_t* O; int ldc; const float* ssq;
    __device__ __forceinline__ void fill(const Unit& u, int par, PG8_LAS float* tab, int tid) const { fill_rowscale<1>(ssq, u, par, tab, tid); }
    __device__ __forceinline__ void operator()(f32x4 (&acc)[2][2][4][2], const Unit& u, int wr, int wc, int fr, int fq, PG8_LAS float* tab, int par) const {
        const int row0 = u.pm * BM + wr * 64 + fr, col0 = u.pn * BM + wc * 32 + 8 * fq;
#pragma unroll
        for (int ai = 0; ai < 2; ++ai)
#pragma unroll
            for (int m = 0; m < 4; ++m) { const int r = ai * HALF + wr * 64 + m * 16 + fr; const float rs = tab[par * 512 + 2 * r];
                bf16_t* rowp = O + (size_t)(row0 + ai * HALF + m * 16) * ldc + col0;
#pragma unroll
                for (int bj = 0; bj < 2; ++bj) { f32x4 v0 = acc[ai][bj][m][0] * rs, v1 = acc[ai][bj][m][1] * rs;
#pragma unroll
                    for (int e = 0; e < 4; ++e) { const float a = fmaxf(v0[e], 0.f), b = fmaxf(v1[e], 0.f); v0[e] = a * a; v1[e] = b * b; }
                    u32x4 w; w.x = cvt_pk_bf16(v0[0], v0[1]); w.y = cvt_pk_bf16(v0[2], v0[3]); w.z = cvt_pk_bf16(v1[0], v1[1]); w.w = cvt_pk_bf16(v1[2], v1[3]);
                    *(u32x4*)(rowp + bj * HALF) = w; } }
    }
};

template <int KIND> struct EpiRes {
    static constexpr bool PERM = true, AFTER_DRAIN = false, MID = (KIND == 1), TABLE = (KIND == 1);
    const float* res32; bf16_t* hb; float* ssq_out; const float* ssq_in;
    __device__ __forceinline__ void fill(const Unit& u, int par, PG8_LAS float* tab, int tid) const { fill_rowscale<2>(ssq_in, u, par, tab, tid); }
    __device__ __forceinline__ void mid(f32x4 (&acc)[2][2][4][2], int wr, int fr, PG8_LAS float* tab, int par) const {
#pragma unroll
        for (int ai = 0; ai < 2; ++ai)
#pragma unroll
            for (int m = 0; m < 4; ++m) { const float f = tab[par * 512 + 2 * (ai * HALF + wr * 64 + m * 16 + fr)];
#pragma unroll
                for (int bj = 0; bj < 2; ++bj)
#pragma unroll
                    for (int n = 0; n < 2; ++n) acc[ai][bj][m][n] *= f; }
    }
    __device__ __forceinline__ void operator()(f32x4 (&acc)[2][2][4][2], const Unit& u, int wr, int wc, int fr, int fq, PG8_LAS float* tab, int par) const {
        const int col0 = u.pn * BM + wc * 32 + 8 * fq;
#pragma unroll
        for (int ai = 0; ai < 2; ++ai) {
            f32x4 rv[4][2][2];
#pragma unroll
            for (int m = 0; m < 4; ++m) { const size_t off = (size_t)(u.pm * BM + ai * HALF + wr * 64 + m * 16 + fr) * 1024 + col0;
#pragma unroll
                for (int bj = 0; bj < 2; ++bj) {
                    if (KIND == 1) { rv[m][bj][0] = *(const f32x4*)(res32 + off + bj * HALF); rv[m][bj][1] = *(const f32x4*)(res32 + off + bj * HALF + 4); }
                    else { const u32x4 w = *(const u32x4*)(hb + off + bj * HALF);
                        rv[m][bj][0] = (f32x4){__uint_as_float(w.x << 16), __uint_as_float(w.x & 0xffff0000u), __uint_as_float(w.y << 16), __uint_as_float(w.y & 0xffff0000u)};
                        rv[m][bj][1] = (f32x4){__uint_as_float(w.z << 16), __uint_as_float(w.z & 0xffff0000u), __uint_as_float(w.w << 16), __uint_as_float(w.w & 0xffff0000u)}; } } }
#pragma unroll
            for (int m = 0; m < 4; ++m) { const int r = ai * HALF + wr * 64 + m * 16 + fr; const int rowg = u.pm * BM + r;
                const float rb = (KIND == 1) ? tab[par * 512 + 2 * r + 1] : 1.0f;
                const size_t off = (size_t)rowg * 1024 + col0; float ss = 0.f;
#pragma unroll
                for (int bj = 0; bj < 2; ++bj) { const f32x4 v0 = rv[m][bj][0] + acc[ai][bj][m][0] * rb, v1 = rv[m][bj][1] + acc[ai][bj][m][1] * rb;
                    u32x4 w; w.x = cvt_pk_bf16(v0[0], v0[1]); w.y = cvt_pk_bf16(v0[2], v0[3]); w.z = cvt_pk_bf16(v1[0], v1[1]); w.w = cvt_pk_bf16(v1[2], v1[3]);
                    *(u32x4*)(hb + off + bj * HALF) = w;
                    ss += ((v0[0] * v0[0] + v0[1] * v0[1]) + (v0[2] * v0[2] + v0[3] * v0[3])) + ((v1[0] * v1[0] + v1[1] * v1[1]) + (v1[2] * v1[2] + v1[3] * v1[3])); }
                ss += __shfl_xor(ss, 16); ss += __shfl_xor(ss, 32);
                if (fq == 0) ssq_out[(size_t)rowg * 16 + u.pn * 4 + wc] = ss; }
            asm volatile("" ::: "memory");
        }
    }
};

struct EpiGate {
    static constexpr bool PERM = true, AFTER_DRAIN = false, MID = false, TABLE = true;
    bf16_t* hb; const bf16_t* pp; const float* bias; float* ssq_out; const float* ssq_in;
    __device__ __forceinline__ void fill(const Unit& u, int par, PG8_LAS float* tab, int tid) const { fill_rowscale<1>(ssq_in, u, par, tab, tid); }
    __device__ __forceinline__ void operator()(f32x4 (&acc)[2][2][4][2], const Unit& u, int wr, int wc, int fr, int fq, PG8_LAS float* tab, int par) const {
        const int col0 = u.pn * BM + wc * 32 + 8 * fq;
        f32x4 bv[2][2];
#pragma unroll
        for (int bj = 0; bj < 2; ++bj)
#pragma unroll
            for (int n = 0; n < 2; ++n) bv[bj][n] = *(const f32x4*)(bias + col0 + bj * HALF + 4 * n);
#pragma unroll
        for (int ai = 0; ai < 2; ++ai) {
            u32x4 hv[4][2], pv[4][2];
#pragma unroll
            for (int m = 0; m < 4; ++m) { const size_t off = (size_t)(u.pm * BM + ai * HALF + wr * 64 + m * 16 + fr) * 1024 + col0;
#pragma unroll
                for (int bj = 0; bj < 2; ++bj) { hv[m][bj] = *(const u32x4*)(hb + off + bj * HALF); pv[m][bj] = *(const u32x4*)(pp + off + bj * HALF); } }
#pragma unroll
            for (int m = 0; m < 4; ++m) { const int r = ai * HALF + wr * 64 + m * 16 + fr; const int rowg = u.pm * BM + r;
                const float rs = tab[par * 512 + 2 * r];
                const size_t off = (size_t)rowg * 1024 + col0; float ss = 0.f;
#pragma unroll
                for (int bj = 0; bj < 2; ++bj) { float v[8];
#pragma unroll
                    for (int e = 0; e < 8; ++e) { const unsigned hw = hv[m][bj][e >> 1], pw = pv[m][bj][e >> 1];
                        const float h = __uint_as_float((e & 1) ? (hw & 0xffff0000u) : (hw << 16)), p = __uint_as_float((e & 1) ? (pw & 0xffff0000u) : (pw << 16));
                        const float z = acc[ai][bj][m][e >> 2][e & 3] * rs + bv[bj][e >> 2][e & 3];
                        v[e] = h + __builtin_amdgcn_rcpf(1.0f + __builtin_amdgcn_exp2f(-1.4426950408889634f * z)) * p; ss += v[e] * v[e]; }
                    u32x4 w; w.x = cvt_pk_bf16(v[0], v[1]); w.y = cvt_pk_bf16(v[2], v[3]); w.z = cvt_pk_bf16(v[4], v[5]); w.w = cvt_pk_bf16(v[6], v[7]);
                    *(u32x4*)(hb + off + bj * HALF) = w; }
                ss += __shfl_xor(ss, 16); ss += __shfl_xor(ss, 32);
                if (fq == 0) ssq_out[(size_t)rowg * 16 + u.pn * 4 + wc] = ss; }
            asm volatile("" ::: "memory");
        }
    }
};

template <class Epi, class Sched, bool ALIGN_EPI = false, bool SP2 = false>
__device__ __forceinline__ void gemm_phase(PG8_LAS unsigned char* lds, PG8_LAS float* tab, const Gemm g, const Sched& S, const Epi& E) {
    const int tid = threadIdx.x, wid = __builtin_amdgcn_readfirstlane(tid >> 6), lane = tid & 63, wr = wid >> 2, wc = wid & 3, fr = lane & 15, fq = lane >> 4;
    const int K = g.K, nt = K / BK;
    unsigned voffA[2], voffB[2];
#pragma unroll
    for (int i = 0; i < 2; ++i) { int R, C; stage_rc(tid * 16 + i * 8192, R, C); const int Rb = Epi::PERM ? ((R & ~31) + perm32(R & 31)) : R;
        voffA[i] = (unsigned)(R * K + C) * 2u; voffB[i] = (unsigned)(Rb * K + C) * 2u; }
    const size_t kstep = (size_t)(BK * 2);
    const size_t hstep = (size_t)HALF * K * 2;
    const size_t tstep = 2 * hstep;
    const unsigned ldsw = (unsigned)wid * 1024u;
    const int aoff = lds_byte(wr * 64 + fr, fq * 8), boff = lds_byte(wc * 32 + fr, fq * 8);
#define PG8_SA(b, h) (((b) * 2 + (h)) * HTB)
#define PG8_SB(b, h) ((4 + (b) * 2 + (h)) * HTB)
#define PG8_STAGE(bufoff, gbase, voff) do { _Pragma("unroll") for (int _i = 0; _i < 2; ++_i) \
        __builtin_amdgcn_global_load_lds((const unsigned*)((const char*)(gbase) + (voff)[_i]), (PG8_LAS unsigned*)(lds + (bufoff) + ldsw + _i * 8192), 16, 0, 0); } while (0)
#define PG8_LDA(dst, b, h) do { _Pragma("unroll") for (int m = 0; m < 4; ++m) _Pragma("unroll") for (int k = 0; k < 2; ++k) dst[m][k] = *(const PG8_LAS bf16x8*)(lds + PG8_SA(b, h) + aoff + m * 2048 + k * 1024); } while (0)
#define PG8_LDB(dst, b, h) do { _Pragma("unroll") for (int n = 0; n < 2; ++n) _Pragma("unroll") for (int k = 0; k < 2; ++k) dst[n][k] = *(const PG8_LAS bf16x8*)(lds + PG8_SB(b, h) + boff + n * 2048 + k * 1024); } while (0)
#define PG8_MMA(ai, bj, At, Bt) do { __builtin_amdgcn_s_setprio(1); _Pragma("unroll") for (int m = 0; m < 4; ++m) _Pragma("unroll") for (int n = 0; n < 2; ++n) _Pragma("unroll") for (int k = 0; k < 2; ++k) \
        acc[ai][bj][m][n] = __builtin_amdgcn_mfma_f32_16x16x32_bf16(Bt[n][k], At[m][k], acc[ai][bj][m][n], 0, 0, 0); __builtin_amdgcn_s_setprio(0); } while (0)
#define PG8_WAIT_V(n) asm volatile("s_waitcnt vmcnt(" #n ")" ::: "memory")
#define PG8_WAIT_L(n) asm volatile("s_waitcnt lgkmcnt(" #n ")" ::: "memory")
#define PG8_BAR __builtin_amdgcn_s_barrier()
#define PG8_SCHED __builtin_amdgcn_sched_barrier(0)
    Unit cur, nxt; int ui = 0;
    if (!S.next(0, cur)) return;
    if constexpr (Epi::TABLE) E.fill(cur, 0, tab, tid);
    f32x4 acc[2][2][4][2];
#pragma unroll
    for (int a = 0; a < 2; ++a)
#pragma unroll
        for (int b = 0; b < 2; ++b)
#pragma unroll
            for (int m = 0; m < 4; ++m)
#pragma unroll
                for (int n = 0; n < 2; ++n) acc[a][b][m][n] = (f32x4){0.f, 0.f, 0.f, 0.f};
    bf16x8 At[4][2], B0[2][2], B1[2][2];
    const char* cA = (const char*)g.A + (size_t)cur.pm * tstep; const char* cB = (const char*)g.Bt + (size_t)cur.pn * tstep;
    S.a_ready(cur);
    if constexpr (SP2) {
        PG8_STAGE(PG8_SB(0, 0), cB, voffB); PG8_STAGE(PG8_SB(0, 1), cB + hstep, voffB); PG8_STAGE(PG8_SA(0, 0), cA, voffA); PG8_STAGE(PG8_SA(0, 1), cA + hstep, voffA);
        if (wr == 1) PG8_BAR;
        PG8_WAIT_V(2); PG8_BAR;
        PG8_STAGE(PG8_SB(1, 0), cB + kstep, voffB); PG8_STAGE(PG8_SA(1, 0), cA + kstep, voffA); PG8_STAGE(PG8_SB(1, 1), cB + hstep + kstep, voffB);
        PG8_WAIT_V(6); PG8_BAR;
    } else {
        PG8_STAGE(PG8_SB(0, 0), cB, voffB); PG8_STAGE(PG8_SA(0, 0), cA, voffA); PG8_STAGE(PG8_SB(0, 1), cB + hstep, voffB); PG8_STAGE(PG8_SA(0, 1), cA + hstep, voffA);
        if (wr == 1) PG8_BAR;
        PG8_WAIT_V(4); PG8_BAR;
        PG8_STAGE(PG8_SB(1, 0), cB + kstep, voffB); PG8_STAGE(PG8_SA(1, 0), cA + kstep, voffA); PG8_STAGE(PG8_SB(1, 1), cB + hstep + kstep, voffB);
        PG8_WAIT_V(6); PG8_BAR;
    }
    for (;;) {
        const bool has_next = S.next(ui + 1, nxt);
        const char* nA = has_next ? (const char*)g.A + (size_t)nxt.pm * tstep : cA; const char* nB = has_next ? (const char*)g.Bt + (size_t)nxt.pn * tstep : cB;
        for (int t = 0; t < nt; t += 2) {
            const bool last = (t == nt - 2);
            if constexpr (Epi::MID) { if (t == (nt >> 1)) E.mid(acc, wr, fr, tab, ui & 1); }
            const char* a1 = cA + (size_t)(t + 1) * kstep;
            const char* a2 = last ? nA : cA + (size_t)(t + 2) * kstep; const char* b2 = last ? nB : cB + (size_t)(t + 2) * kstep;
            const char* a3 = a2 + kstep; const char* b3 = b2 + kstep;
            if (last && has_next) S.a_ready(nxt);
            if constexpr (SP2) {
            PG8_LDB(B0, 0, 0); PG8_LDB(B1, 0, 1); PG8_SCHED; PG8_LDA(At, 0, 0); PG8_STAGE(PG8_SA(1, 1), a1 + hstep, voffA);
            PG8_WAIT_V(8); PG8_WAIT_L(0); PG8_BAR; PG8_MMA(0, 0, At, B0); PG8_MMA(0, 1, At, B1); PG8_BAR; PG8_SCHED;
            PG8_LDA(At, 0, 1); PG8_STAGE(PG8_SB(0, 0), b2, voffB); PG8_STAGE(PG8_SB(0, 1), b2 + hstep, voffB); PG8_STAGE(PG8_SA(0, 0), a2, voffA);
            PG8_WAIT_V(8); PG8_WAIT_L(0); PG8_BAR; PG8_MMA(1, 0, At, B0); PG8_MMA(1, 1, At, B1); PG8_BAR; PG8_SCHED;
            PG8_LDB(B0, 1, 0); PG8_LDB(B1, 1, 1); PG8_SCHED; PG8_LDA(At, 1, 0); PG8_STAGE(PG8_SA(0, 1), a2 + hstep, voffA);
            PG8_WAIT_V(8); PG8_WAIT_L(0); PG8_BAR; PG8_MMA(0, 0, At, B0); PG8_MMA(0, 1, At, B1); PG8_BAR; PG8_SCHED;
            PG8_LDA(At, 1, 1); PG8_STAGE(PG8_SB(1, 0), b3, voffB); PG8_STAGE(PG8_SB(1, 1), b3 + hstep, voffB); PG8_STAGE(PG8_SA(1, 0), a3, voffA);
            PG8_WAIT_V(8); PG8_WAIT_L(0); PG8_BAR; PG8_MMA(1, 0, At, B0); PG8_MMA(1, 1, At, B1); PG8_BAR; PG8_SCHED;
            } else {
            PG8_LDB(B0, 0, 0); PG8_SCHED; PG8_LDA(At, 0, 0); PG8_STAGE(PG8_SA(1, 1), a1 + hstep, voffA);
            PG8_WAIT_L(8); PG8_BAR; PG8_WAIT_L(0); PG8_MMA(0, 0, At, B0); PG8_BAR; PG8_SCHED;
            PG8_LDB(B1, 0, 1); PG8_STAGE(PG8_SB(0, 0), b2, voffB);
            PG8_BAR; PG8_WAIT_L(0); PG8_MMA(0, 1, At, B1); PG8_BAR;
            PG8_LDA(At, 0, 1); PG8_STAGE(PG8_SA(0, 0), a2, voffA);
            PG8_BAR; PG8_WAIT_L(0); PG8_MMA(1, 0, At, B0); PG8_BAR; PG8_SCHED;
            PG8_STAGE(PG8_SB(0, 1), b2 + hstep, voffB);
            PG8_WAIT_V(6); PG8_BAR; PG8_MMA(1, 1, At, B1); PG8_BAR;
            PG8_LDB(B0, 1, 0); PG8_SCHED; PG8_LDA(At, 1, 0); PG8_STAGE(PG8_SA(0, 1), a2 + hstep, voffA);
            PG8_WAIT_L(8); PG8_BAR; PG8_WAIT_L(0); PG8_MMA(0, 0, At, B0); PG8_BAR; PG8_SCHED;
            PG8_LDB(B1, 1, 1); PG8_STAGE(PG8_SB(1, 0), b3, voffB);
            PG8_BAR; PG8_WAIT_L(0); PG8_MMA(0, 1, At, B1); PG8_BAR;
            PG8_LDA(At, 1, 1); PG8_STAGE(PG8_SA(1, 0), a3, voffA);
            PG8_BAR; PG8_WAIT_L(0); PG8_MMA(1, 0, At, B0); PG8_BAR; PG8_SCHED;
            PG8_STAGE(PG8_SB(1, 1), b3 + hstep, voffB);
            PG8_WAIT_V(6); PG8_BAR; PG8_MMA(1, 1, At, B1); PG8_BAR;
            }
        }
        if constexpr (ALIGN_EPI) { if (wr == 0) PG8_BAR; }
        if constexpr (!Epi::AFTER_DRAIN) { int tid_e = threadIdx.x; asm volatile("" : "+v"(tid_e)); const int lane_e = tid_e & 63;
            E(acc, cur, wr, wc, lane_e & 15, lane_e >> 4, tab, ui & 1); S.done(cur); }
        if (!has_next) break;
#pragma unroll
        for (int a = 0; a < 2; ++a)
#pragma unroll
            for (int b = 0; b < 2; ++b)
#pragma unroll
                for (int m = 0; m < 4; ++m)
#pragma unroll
                    for (int n = 0; n < 2; ++n) acc[a][b][m][n] = (f32x4){0.f, 0.f, 0.f, 0.f};
        cur = nxt; cA = nA; cB = nB; ++ui;
        if constexpr (Epi::TABLE) E.fill(cur, ui & 1, tab, tid);
        if constexpr (ALIGN_EPI) { if (wr == 1) PG8_BAR; }
    }
    PG8_WAIT_V(0);
    if constexpr (!ALIGN_EPI) { if (wr == 0) PG8_BAR; }
    PG8_BAR;
    if constexpr (Epi::AFTER_DRAIN) { E.fused(acc, cur, wr, wc, fr, fq, lds, wid, lane); S.done(cur); }
#undef PG8_SA
#undef PG8_SB
#undef PG8_STAGE
#undef PG8_LDA
#undef PG8_LDB
#undef PG8_MMA
#undef PG8_WAIT_V
#undef PG8_WAIT_L
#undef PG8_BAR
#undef PG8_SCHED
}
}
#define GAS __attribute__((address_space(1)))
#define LAS __attribute__((address_space(3)))
typedef unsigned short bf16;
typedef unsigned v4u __attribute__((ext_vector_type(4)));
typedef float f32x4 __attribute__((ext_vector_type(4)));
typedef short bf16x8 __attribute__((ext_vector_type(8)));
typedef GAS unsigned gu32;
typedef GAS unsigned long long gu64;
#define RLX_AGENT __ATOMIC_RELAXED, __HIP_MEMORY_SCOPE_AGENT
#define LDS_WAIT() asm volatile("s_waitcnt lgkmcnt(0)" ::: "memory")
#define VM_WAIT() asm volatile("s_waitcnt vmcnt(0)" ::: "memory")
__device__ __forceinline__ unsigned long long rt() { return __builtin_amdgcn_s_memrealtime(); }
__device__ __forceinline__ unsigned f2bf(float f) { unsigned u = __builtin_bit_cast(unsigned, f); return (u + 0x7fffu + ((u >> 16) & 1u)) >> 16; }
__device__ __forceinline__ unsigned pk2(float lo, float hi) { return f2bf(lo) | (f2bf(hi) << 16); }

#define XB_TMO      128
#define XB_XCNT(j)  (256  + 64 * (j))
#define XB_XSUB(j)  (1280 + 64 * (j))
#define XB_XGEN(j)  (2304 + 64 * (j))
#define XB_TOP      3328
#define XB_TOPGEN   3392
#define XCD_BAR_WORDS 3456
#define XB_SPIN_CAP (1u << 18)

__device__ __forceinline__ unsigned xb_ld(unsigned* p)              { return __hip_atomic_load(p, __ATOMIC_RELAXED, __HIP_MEMORY_SCOPE_AGENT); }
__device__ __forceinline__ unsigned xb_add(unsigned* p, unsigned v) { return __hip_atomic_fetch_add(p, v, __ATOMIC_RELAXED, __HIP_MEMORY_SCOPE_AGENT); }
__device__ __forceinline__ unsigned xb_xcc_id() { return (unsigned)__builtin_amdgcn_s_getreg((3 << 11) | 20) & 0xFu; }
#define XB_SPIN(cond, bar) do { unsigned _sp = 0; while (cond) { __builtin_amdgcn_s_sleep(1); \
    if ((++_sp & 255u) == 0u) { if (xb_ld(&(bar)[XB_TMO])) break; if (_sp > XB_SPIN_CAP) { atomicAdd(&(bar)[XB_TMO], 1u); break; } } } } while (0)

struct XcdBarrier {
    unsigned* bar; unsigned x;
    volatile LAS unsigned* st;
};

__device__ __forceinline__ XcdBarrier xcd_barrier_post(unsigned* bar, volatile LAS unsigned* st) {
    XcdBarrier b; b.bar = bar; b.x = xb_xcc_id(); b.st = st;
    if (threadIdx.x == 0) (void)xb_add(&bar[XB_XCNT(b.x)], 1u);
    return b;
}
__device__ __forceinline__ void xcd_barrier_complete(unsigned* bar, unsigned x, unsigned& nloc, unsigned& nx) {
    const unsigned G = gridDim.x * gridDim.y * gridDim.z;
    unsigned sum, cnt, mine, sp = 0u;
    for (;;) {
        sum = 0u; cnt = 0u; mine = 0u;
#pragma unroll
        for (unsigned j = 0; j < 16; ++j) { const unsigned c = xb_ld(&bar[XB_XCNT(j)]); sum += c; cnt += (c > 0u) ? 1u : 0u; mine = (j == x) ? c : mine; }
        if (sum == G) break;
        __builtin_amdgcn_s_sleep(1);
        if ((++sp & 255u) == 0u) { if (xb_ld(&bar[XB_TMO])) break; if (sp > XB_SPIN_CAP) { atomicAdd(&bar[XB_TMO], 1u); break; } }
    }
    nloc = mine > 0u ? mine : 1u; nx = cnt > 0u ? cnt : 1u;
}

__device__ __forceinline__ void xcd_barrier(const XcdBarrier& b) {
    asm volatile("s_waitcnt vmcnt(0)" ::: "memory");
    __syncthreads();
    if (threadIdx.x == 0) {
        unsigned* bar = b.bar;
        __builtin_amdgcn_s_waitcnt(0);
        unsigned nloc = b.st[0], nx = b.st[1];
        if (nloc == 0u) { xcd_barrier_complete(bar, b.x, nloc, nx); b.st[0] = nloc; b.st[1] = nx; }
        const unsigned old = xb_add(&bar[XB_XSUB(b.x)], 1u);
        const unsigned gen = old / nloc;
        if (old + 1u == (gen + 1u) * nloc) {
            __builtin_amdgcn_fence(__ATOMIC_RELEASE, "agent");
            asm volatile("s_waitcnt vmcnt(0)" ::: "memory");
            const unsigned og = xb_add(&bar[XB_TOP], 1u);
            const unsigned tg = og / nx;
            if (og + 1u == (tg + 1u) * nx) xb_add(&bar[XB_TOPGEN], 1u);
            else XB_SPIN(xb_ld(&bar[XB_TOPGEN]) == tg, bar);
            __builtin_amdgcn_fence(__ATOMIC_ACQUIRE, "agent");
            xb_add(&bar[XB_XGEN(b.x)], 1u);
            asm volatile("s_waitcnt vmcnt(0)" ::: "memory");
        } else {
            XB_SPIN(xb_ld(&bar[XB_XGEN(b.x)]) == gen, bar);
            __builtin_amdgcn_fence(__ATOMIC_ACQUIRE, "agent");
            asm volatile("s_waitcnt vmcnt(0)" ::: "memory");
        }
    }
    __syncthreads();
}

constexpr int NWAVES = 8;
#ifndef MK_N_LAUNCHES
#define MK_N_LAUNCHES 1
#endif
constexpr int N_LAUNCHES = MK_N_LAUNCHES;
constexpr int NPHASE = 8;
static_assert(N_LAUNCHES == 1 || N_LAUNCHES == NPHASE, "MK_N_LAUNCHES is 1 or NPHASE");

constexpr int BATCH = 8, SEQ = 4096, D = 1024, NH = 16, HD = 64, FF = 4096, PLE = 256;
constexpr int M = BATCH * SEQ;
constexpr int NQKV = 3 * D;
constexpr float EPS = 1e-6f;
constexpr float LOG2E = 1.4426950408889634f;
constexpr float C2 = 0.125f * LOG2E;

constexpr size_t MiB = 1u << 20;
constexpr size_t WS_CTL = 0, CTL_ZERO_BYTES = 64 * 1024;
constexpr size_t WS_WQKV = 1 * MiB, WS_WO = 7 * MiB, WS_WUP = 9 * MiB, WS_WDN = 17 * MiB, WS_WG = 25 * MiB, WS_WP = 27 * MiB;
constexpr size_t WS_SSQ0 = 28 * MiB, WS_SSQ1 = 30 * MiB, WS_SSQ2 = 32 * MiB, WS_SSQ3 = 34 * MiB;
constexpr size_t WS_KPART = 36 * MiB;
constexpr size_t WS_PB = 40 * MiB;
constexpr size_t WS_PP = 56 * MiB;
constexpr size_t WS_XN = 120 * MiB;
constexpr size_t WS_Q = 184 * MiB, WS_K = 248 * MiB, WS_V = 312 * MiB, WS_O = 376 * MiB;
constexpr size_t WS_U = 184 * MiB;
constexpr size_t WS_END = 440 * MiB;
constexpr int CW_BAR = 1024;

constexpr int RING_OFF = 0, RING_BYTES = 131072;
constexpr int LDSCTL_OFF = RING_BYTES, MISC_OFF = LDSCTL_OFF + 320;
constexpr int TAB_OFF = RING_BYTES + 1024;
constexpr int LDS_BYTES = 147456;
static_assert(TAB_OFF + 4096 <= LDS_BYTES, "LDS map");

struct Frame {
    LAS unsigned char* lds;
    volatile LAS unsigned* MISC;
    gu32* ctl;
    int tid, lane, wave;
    int vcu, G;
    const float *x, *p, *g_attn, *w_in, *g_out_a, *g_out_b, *w_out, *g_mlp, *w_up, *w_down, *g_ple, *w_gate, *b_gate, *w_proj, *g_final;
    float* out;
    bf16 *Wqkv_t, *Wo_t, *Wup_t, *Wdn_t, *Wg_t, *Wp_t;
    bf16 *XN, *QB, *KB, *VB, *OB, *UB, *PB, *PP;
    float *ssq0, *ssq1, *ssq2, *ssq3, *kpart;
};

__device__ __forceinline__ float wave_sum(float v) {
#pragma unroll
    for (int o = 1; o < 64; o <<= 1) v += __shfl_xor(v, o);
    return v;
}
__device__ __forceinline__ void p0_transpose_item(const float* W, int K, int N, bf16* dst, const float* g, LAS float* scr, int k0, int n0, int lane) {
    f32x4 wv[8];
#pragma unroll
    for (int i = 0; i < 8; ++i) wv[i] = *(const GAS f32x4*)(W + (size_t)(k0 + 8 * i + (lane >> 3)) * N + n0 + 4 * (lane & 7));
#pragma unroll
    for (int i = 0; i < 8; ++i) { const int kk = 8 * i + (lane >> 3); f32x4 v = wv[i]; if (g) v = v * g[k0 + kk]; LAS float* d = scr + kk * 33 + 4 * (lane & 7); d[0] = v.x; d[1] = v.y; d[2] = v.z; d[3] = v.w; }
    LDS_WAIT(); asm volatile("" ::: "memory");
    const int c = lane & 7;
#pragma unroll
    for (int j = 0; j < 4; ++j) { const int n = (lane >> 3) + 8 * j; const LAS float* s = scr + (8 * c) * 33 + n;
        v4u o; o.x = pk2(s[0 * 33], s[1 * 33]); o.y = pk2(s[2 * 33], s[3 * 33]); o.z = pk2(s[4 * 33], s[5 * 33]); o.w = pk2(s[6 * 33], s[7 * 33]);
        *(GAS v4u*)(dst + (size_t)n * K + k0 + 8 * c) = o; }
    LDS_WAIT(); asm volatile("" ::: "memory");
}
__device__ __forceinline__ int qkv_dst_row(int n0) {
    if (n0 < 1536) return (n0 / 512) * 1024 + (n0 % 512);
    const int n1 = n0 - 1536; return (n1 / 512) * 1024 + 512 + (n1 % 512);
}
__device__ __forceinline__ void p0_prologue(Frame& F) {
    LAS float* scr = (LAS float*)(F.lds + RING_OFF + F.wave * 16384);
    const int gw = F.vcu * NWAVES + F.wave, NGW = F.G * NWAVES;
    constexpr int I_IN = (D / 64) * (NQKV / 32), I_O = (D / 64) * (D / 32), I_UP = (D / 64) * (FF / 32), I_DN = (FF / 64) * (D / 32), I_G = I_O, I_P = (PLE / 64) * (D / 32);
    constexpr int NITEMS = I_IN + I_O + I_UP + I_DN + I_G + I_P;
    for (int it = gw; it < NITEMS; it += NGW) {
        int r = it;
        if (r < I_IN) { const int nb = r % (NQKV / 32), kb = r / (NQKV / 32); p0_transpose_item(F.w_in, D, NQKV, F.Wqkv_t + (size_t)qkv_dst_row(32 * nb) * D, F.g_attn, scr, 64 * kb, 32 * nb, F.lane); continue; } r -= I_IN;
        if (r < I_O) { const int nb = r % (D / 32), kb = r / (D / 32); const float* g = (64 * kb < 512) ? F.g_out_a : (F.g_out_b - 512);
            p0_transpose_item(F.w_out, D, D, F.Wo_t + (size_t)(32 * nb) * D, g, scr, 64 * kb, 32 * nb, F.lane); continue; } r -= I_O;
        if (r < I_UP) { const int nb = r % (FF / 32), kb = r / (FF / 32); p0_transpose_item(F.w_up, D, FF, F.Wup_t + (size_t)(32 * nb) * D, F.g_mlp, scr, 64 * kb, 32 * nb, F.lane); continue; } r -= I_UP;
        if (r < I_DN) { const int nb = r % (D / 32), kb = r / (D / 32); p0_transpose_item(F.w_down, FF, D, F.Wdn_t + (size_t)(32 * nb) * FF, nullptr, scr, 64 * kb, 32 * nb, F.lane); continue; } r -= I_DN;
        if (r < I_G) { const int nb = r % (D / 32), kb = r / (D / 32); p0_transpose_item(F.w_gate, D, D, F.Wg_t + (size_t)(32 * nb) * D, F.g_ple, scr, 64 * kb, 32 * nb, F.lane); continue; } r -= I_G;
        { const int nb = r % (D / 32), kb = r / (D / 32); p0_transpose_item(F.w_proj, PLE, D, F.Wp_t + (size_t)(32 * nb) * PLE, nullptr, scr, 64 * kb, 32 * nb, F.lane); }
    }
    for (int m0 = 2 * gw; m0 < M; m0 += 2 * NGW) {
        f32x4 v[2][4]; f32x4 pv[2]; float s[2] = {0.f, 0.f};
#pragma unroll
        for (int q = 0; q < 2; ++q) { const GAS f32x4* xr = (const GAS f32x4*)(F.x + (size_t)(m0 + q) * D) + F.lane;
#pragma unroll
            for (int j = 0; j < 4; ++j) v[q][j] = xr[64 * j];
            pv[q] = ((const GAS f32x4*)(F.p + (size_t)(m0 + q) * PLE))[F.lane]; }
#pragma unroll
        for (int q = 0; q < 2; ++q) {
#pragma unroll
            for (int j = 0; j < 4; ++j) s[q] += (v[q][j].x * v[q][j].x + v[q][j].y * v[q][j].y) + (v[q][j].z * v[q][j].z + v[q][j].w * v[q][j].w);
            const float rstd = 1.f / sqrtf(wave_sum(s[q]) * (1.f / D) + EPS);
            GAS unsigned long long* o8 = (GAS unsigned long long*)(F.XN + (size_t)(m0 + q) * D) + F.lane;
#pragma unroll
            for (int j = 0; j < 4; ++j) o8[64 * j] = (unsigned long long)pk2(v[q][j].x * rstd, v[q][j].y * rstd) | ((unsigned long long)pk2(v[q][j].z * rstd, v[q][j].w * rstd) << 32);
            ((GAS unsigned long long*)(F.PB + (size_t)(m0 + q) * PLE))[F.lane] = (unsigned long long)pk2(pv[q].x, pv[q].y) | ((unsigned long long)pk2(pv[q].z, pv[q].w) << 32); }
    }
}

__device__ __forceinline__ float bf2f(unsigned short h) { return __uint_as_float((unsigned)h << 16); }
__device__ __forceinline__ void naive_key(const bf16* kp, const bf16* vp, const float (&q)[64], float bias, float& mx, float& l, float (&acc)[64]) {
    float s = 0.f;
#pragma unroll
    for (int c = 0; c < 8; ++c) { const v4u kw = *(const v4u*)(kp + 8 * c);
        s += q[8 * c + 0] * __uint_as_float(kw.x << 16) + q[8 * c + 1] * __uint_as_float(kw.x & 0xffff0000u) + q[8 * c + 2] * __uint_as_float(kw.y << 16) + q[8 * c + 3] * __uint_as_float(kw.y & 0xffff0000u)
           + q[8 * c + 4] * __uint_as_float(kw.z << 16) + q[8 * c + 5] * __uint_as_float(kw.z & 0xffff0000u) + q[8 * c + 6] * __uint_as_float(kw.w << 16) + q[8 * c + 7] * __uint_as_float(kw.w & 0xffff0000u); }
    s += bias;
    const float mn = fmaxf(mx, s), sc = __builtin_amdgcn_exp2f(mx - mn), pe = __builtin_amdgcn_exp2f(s - mn);
    mx = mn; l = l * sc + pe;
#pragma unroll
    for (int c = 0; c < 8; ++c) { const v4u vw = *(const v4u*)(vp + 8 * c);
        acc[8 * c + 0] = acc[8 * c + 0] * sc + pe * __uint_as_float(vw.x << 16); acc[8 * c + 1] = acc[8 * c + 1] * sc + pe * __uint_as_float(vw.x & 0xffff0000u);
        acc[8 * c + 2] = acc[8 * c + 2] * sc + pe * __uint_as_float(vw.y << 16); acc[8 * c + 3] = acc[8 * c + 3] * sc + pe * __uint_as_float(vw.y & 0xffff0000u);
        acc[8 * c + 4] = acc[8 * c + 4] * sc + pe * __uint_as_float(vw.z << 16); acc[8 * c + 5] = acc[8 * c + 5] * sc + pe * __uint_as_float(vw.z & 0xffff0000u);
        acc[8 * c + 6] = acc[8 * c + 6] * sc + pe * __uint_as_float(vw.w << 16); acc[8 * c + 7] = acc[8 * c + 7] * sc + pe * __uint_as_float(vw.w & 0xffff0000u); }
}
__device__ __forceinline__ void attn_naive(Frame& F) {
    const long NT = (long)F.G * NWAVES * 64;
    for (long idx = (long)blockIdx.x * (NWAVES * 64) + F.tid; idx < (long)M * NH; idx += NT) {
        const int tok = (int)(idx % M), hh = (int)(idx / M); const int b = tok / SEQ, t = tok % SEQ; const int grp = hh >> 3, h = hh & 7;
        float q[64], acc[64]; float mx = -1e30f, l = 0.f;
#pragma unroll
        for (int d = 0; d < 64; ++d) acc[d] = 0.f;
        if (grp == 0) {
            const float sl2 = exp2f(-0.5f * (float)(2 * h + 1)) * LOG2E;
            const size_t qrow = (size_t)b * SEQ + (size_t)(t & 3) * 1024 + (t >> 2);
            const bf16* qp = F.QB + qrow * D + h * 64;
#pragma unroll
            for (int d = 0; d < 64; ++d) q[d] = bf2f(qp[d]);
            for (int br = 0; br < 3; ++br) { const int dil = br == 0 ? 1 : (br == 1 ? 4 : 16);
                for (int mm = 0; mm <= 128; ++mm) { const int key = t - dil * mm; if (key < 0) break;
                    const size_t krow = (size_t)b * SEQ + (size_t)(key & 3) * 1024 + (key >> 2);
                    naive_key(F.KB + krow * D + h * 64, F.VB + krow * D + h * 64, q, -sl2 * (float)(dil * mm), mx, l, acc); } }
        } else {
            const float sl2 = exp2f(-(float)(h + 1)) * LOG2E;
            const bf16* qp = F.QB + (size_t)tok * D + 512 + h * 64;
#pragma unroll
            for (int d = 0; d < 64; ++d) q[d] = bf2f(qp[d]);
            const int own = t >> 8; int i0 = -1, i1 = -1, i2 = -1; float g0 = -INFINITY, g1 = -INFINITY, g2 = -INFINITY;
            for (int n = 0; n < own; ++n) { const float* k0 = F.kpart + (size_t)((b * 16 + n) * 2) * 512 + h * 64; const float* k1 = k0 + 512; float g = 0.f;
#pragma unroll
                for (int d = 0; d < 64; ++d) g += q[d] * (k0[d] + k1[d]);
                if (g > g0) { g2 = g1; i2 = i1; g1 = g0; i1 = i0; g0 = g; i0 = n; } else if (g > g1) { g2 = g1; i2 = i1; g1 = g; i1 = n; } else if (g > g2) { g2 = g; i2 = n; } }
            for (int j = 0; j < 4; ++j) { const int n = j == 0 ? i0 : (j == 1 ? i1 : (j == 2 ? i2 : own)); if (n < 0) continue;
                const int kend = (j == 3) ? t : 256 * n + 255;
                for (int key = 256 * n; key <= kend; ++key) { const size_t krow = (size_t)b * SEQ + key;
                    naive_key(F.KB + krow * D + 512 + h * 64, F.VB + krow * D + 512 + h * 64, q, -sl2 * (float)(t - key), mx, l, acc); } }
        }
        const float rl = 1.0f / l; float ss = 0.f; bf16* op = F.OB + (size_t)tok * D + grp * 512 + h * 64;
#pragma unroll
        for (int d = 0; d < 64; d += 2) { const float a = acc[d] * rl, c = acc[d + 1] * rl; ss += a * a + c * c; *(unsigned*)(op + d) = pk2(a, c); }
        F.ssq0[(size_t)tok * 16 + hh] = ss;
    }
}


namespace att {
typedef short bf16x8 __attribute__((ext_vector_type(8)));
typedef short s16x4 __attribute__((ext_vector_type(4)));
typedef float f32x16 __attribute__((ext_vector_type(16)));
typedef unsigned u32x4 __attribute__((ext_vector_type(4)));
typedef LAS const char* lds_cptr;
constexpr int NSLOT = 4, SLOTB = 8192;
constexpr int L_K = 0, L_V = NSLOT * SLOTB, L_WS = 2 * NSLOT * SLOTB, L_OST = L_WS + 8 * 256, L_TAB = L_OST + 8 * 4096, L_END = L_TAB + 16384;
static_assert(L_END <= RING_BYTES, "attention LDS map");
typedef short v4i16_t __attribute__((ext_vector_type(4)));
#define ATT_NEG (-INFINITY)
__device__ __forceinline__ int crow(int r, int hi) { return (r & 3) + 8 * (r >> 2) + 4 * hi; }
__device__ __forceinline__ void glds16(const void* gsrc, unsigned lds_dst) { unsigned keep;
    asm volatile("s_mov_b32 %0, m0\n\ts_mov_b32 m0, %2\n\ts_nop 0\n\tglobal_load_lds_dwordx4 %1, off\n\ts_mov_b32 m0, %0" : "=&s"(keep) : "v"(gsrc), "s"(lds_dst) : "memory"); }
typedef float f32x2_t __attribute__((ext_vector_type(2))); typedef __bf16 bf16x2_t __attribute__((ext_vector_type(2)));
__device__ __forceinline__ unsigned cvtpk_s(float lo, float hi) { f32x2_t v = {lo, hi}; bf16x2_t b = __builtin_convertvector(v, bf16x2_t); return __builtin_bit_cast(unsigned, b); }
#define ATT_WAIT_BAR(N) asm volatile("s_waitcnt vmcnt(" #N ") lgkmcnt(0)\n\ts_barrier" ::: "memory")
#define ATT_SBAR() __builtin_amdgcn_sched_barrier(0)

__device__ __forceinline__ void qkt(f32x16& p0, f32x16& p1, lds_cptr kb, const bf16x8 (&qr)[4]) {
#pragma unroll
    for (int d0 = 0; d0 < 4; ++d0) {
        const bf16x8 b0 = *(LAS const bf16x8*)(kb + d0 * 2048);
        const bf16x8 b1 = *(LAS const bf16x8*)(kb + d0 * 2048 + 512);
        p0 = __builtin_amdgcn_mfma_f32_32x32x16_bf16(b0, qr[d0], p0, 0, 0, 0);
        p1 = __builtin_amdgcn_mfma_f32_32x32x16_bf16(b1, qr[d0], p1, 0, 0, 0); }
}
__device__ __forceinline__ void pv(f32x16 (&o)[2], int vb, bf16x8 pa0, bf16x8 pa1, bf16x8 pa2, bf16x8 pa3) {
#pragma unroll
    for (int d0 = 0; d0 < 2; ++d0) { s16x4 lo[4], hi[4];
#pragma unroll
        for (int ks = 0; ks < 4; ++ks) {
            asm volatile("ds_read_b64_tr_b16 %0,%1 offset:%c2" : "=&v"(lo[ks]) : "v"(vb), "i"(d0 * 4096 + ks * 1024) : "memory");
            asm volatile("ds_read_b64_tr_b16 %0,%1 offset:%c2" : "=&v"(hi[ks]) : "v"(vb), "i"(d0 * 4096 + ks * 1024 + 512) : "memory"); }
        asm volatile("s_waitcnt lgkmcnt(0)" ::: "memory"); ATT_SBAR();
#define ATT_PK(k) (bf16x8){lo[k][0], lo[k][1], lo[k][2], lo[k][3], hi[k][0], hi[k][1], hi[k][2], hi[k][3]}
        o[d0] = __builtin_amdgcn_mfma_f32_32x32x16_bf16(pa0, ATT_PK(0), o[d0], 0, 0, 0);
        o[d0] = __builtin_amdgcn_mfma_f32_32x32x16_bf16(pa1, ATT_PK(1), o[d0], 0, 0, 0);
        o[d0] = __builtin_amdgcn_mfma_f32_32x32x16_bf16(pa2, ATT_PK(2), o[d0], 0, 0, 0);
        o[d0] = __builtin_amdgcn_mfma_f32_32x32x16_bf16(pa3, ATT_PK(3), o[d0], 0, 0, 0);
#undef ATT_PK
    }
}

struct PolA {
    int b, r, T0, NT, NT_own, jmin, jpmin, per, iq;
    LAS const float* tab; int hi;
    __device__ __forceinline__ void init(int b_, int r_, int Tblk, int wid, int r32, int hi_, LAS const float* tab_) {
        b = b_; r = r_; T0 = 256 * Tblk; jmin = T0 >= 512 ? 0 : (512 - T0) / 64; NT_own = 12 - jmin; jpmin = T0 == 0 ? 1 : 0; per = 5 - jpmin; NT = NT_own + 3 * per;
        iq = T0 + 32 * wid + r32; tab = tab_; hi = hi_; }
    __device__ __forceinline__ void tile(int t, int& rho, int& ik0, int& k) const {
        if (t < NT_own) { k = 0; rho = r; ik0 = T0 - 512 + 64 * (jmin + t); }
        else { const int tp = t - NT_own; k = 1 + tp / per; rho = (r + k) & 3; ik0 = T0 - 64 + 64 * (jpmin + tp % per); } }
    __device__ __forceinline__ long row0(int t) const { int rho, ik0, k; tile(t, rho, ik0, k); return (long)b * SEQ + rho * 1024 + ik0; }
    __device__ __forceinline__ long qrow(int wid, int r32) const { return (long)b * SEQ + r * 1024 + T0 + 32 * wid + r32; }
    __device__ __forceinline__ long orow(int wid, int row) const { return (long)b * SEQ + 4 * (T0 + 32 * wid + row) + r; }
    __device__ __forceinline__ bool active(int t, int wid) const {
        int rho, ik0, k; tile(t, rho, ik0, k); const int dmax = T0 + 32 * wid + 31 - ik0, dmin = T0 + 32 * wid - ik0 - 63; return dmax >= 0 && dmin <= (k == 0 ? 512 : 32); }
    __device__ __forceinline__ void cinit(int t, f32x16& p0, f32x16& p1) const {
        int rho, ik0, k; tile(t, rho, ik0, k);
        LAS const float* tb = tab + (k == 0 ? 0 : 1024 + (k - 1) * 576) + (iq - ik0 - 4 * hi + 256 - 63);
#pragma unroll
        for (int rr = 0; rr < 16; ++rr) { const int c = (rr & 3) + 8 * (rr >> 2); p0[rr] = tb[63 - c]; p1[rr] = tb[31 - c]; }
    }
};
__device__ __forceinline__ void fill_tab_A(LAS float* tab, int h, int r, int tid) {
    const float sl2 = exp2f(-0.5f * (float)(2 * h + 1)) * LOG2E;
    for (int idx = tid; idx < 1024; idx += NWAVES * 64) { const int dl = idx - 256; float v = ATT_NEG;
        if (dl >= 0 && dl <= 512) { const int w = (dl <= 32 ? 1 : 0) + (dl <= 128 ? 1 : 0) + ((dl & 3) == 0 ? 1 : 0);
            if (w > 0) v = (w == 1 ? 0.f : (w == 2 ? 1.f : 1.5849625007211562f)) - sl2 * (float)(4 * dl); }
        tab[idx] = v; }
    for (int idx = tid; idx < 3 * 576; idx += NWAVES * 64) { const int k = 1 + idx / 576, dl = idx % 576 - 256; const int rho = (r + k) & 3; const int dist = 4 * dl + (r - rho);
        tab[1024 + idx] = (dist >= 0 && dist <= 128) ? -sl2 * (float)dist : ATT_NEG; }
}

struct PolB {
    int b, i, NT, dq0, hi; unsigned sel; float sl2;
    __device__ __forceinline__ long row0(int t) const { return (long)b * SEQ + 64 * t; }
    __device__ __forceinline__ long qrow(int wid, int r32) const { return (long)b * SEQ + 256 * i + 32 * wid + r32; }
    __device__ __forceinline__ long orow(int wid, int row) const { return (long)b * SEQ + 256 * i + 32 * wid + row; }
    __device__ __forceinline__ bool active(int t, int) const { return __any((int)((sel >> (t >> 2)) & 1u)) != 0; }
    __device__ __forceinline__ void cinit(int t, f32x16& p0, f32x16& p1) const {
        const int dqi = 64 * t + dq0;
        float base = sl2 * (float)dqi; if (!((sel >> (t >> 2)) & 1u)) base = ATT_NEG;
        const float base1 = base + 32.0f * sl2;
#pragma unroll
        for (int rr = 0; rr < 16; ++rr) { const int c = (rr & 3) + 8 * (rr >> 2); p0[rr] = base + sl2 * (float)c; p1[rr] = base1 + sl2 * (float)c; }
        if (t >= 4 * i) {
            asm volatile("; causal band tile" ::: "memory");
#pragma unroll
            for (int rr = 0; rr < 16; ++rr) { const int c = (rr & 3) + 8 * (rr >> 2); if (dqi + c > 0) p0[rr] = ATT_NEG; if (dqi + c + 32 > 0) p1[rr] = ATT_NEG; }
        }
    }
    __device__ __forceinline__ void select(const bf16x8 (&qr)[4], LAS const float* km) {
        float qf[32];
#pragma unroll
        for (int d0 = 0; d0 < 4; ++d0)
#pragma unroll
            for (int j = 0; j < 8; ++j) qf[8 * d0 + j] = __uint_as_float((unsigned)(unsigned short)qr[d0][j] << 16);
        int i0 = -1, i1 = -1, i2 = -1; float g0 = ATT_NEG, g1 = ATT_NEG, g2 = ATT_NEG;
        for (int n = 0; n < i; ++n) { float g = 0.f;
#pragma unroll
            for (int d0 = 0; d0 < 4; ++d0) { const f32x4 ka = *(LAS const f32x4*)(km + n * 64 + 16 * d0 + 8 * hi), kb = *(LAS const f32x4*)(km + n * 64 + 16 * d0 + 8 * hi + 4);
                g += (qf[8 * d0 + 0] * ka.x + qf[8 * d0 + 1] * ka.y) + (qf[8 * d0 + 2] * ka.z + qf[8 * d0 + 3] * ka.w) + (qf[8 * d0 + 4] * kb.x + qf[8 * d0 + 5] * kb.y) + (qf[8 * d0 + 6] * kb.z + qf[8 * d0 + 7] * kb.w); }
            g += __shfl_xor(g, 32);
            if (g > g0) { g2 = g1; i2 = i1; g1 = g0; i1 = i0; g0 = g; i0 = n; } else if (g > g1) { g2 = g1; i2 = i1; g1 = g; i1 = n; } else if (g > g2) { g2 = g; i2 = n; } }
        sel = 1u << i; if (i0 >= 0) sel |= 1u << i0; if (i1 >= 0) sel |= 1u << i1; if (i2 >= 0) sel |= 1u << i2;
    }
};

template <class P, bool SELECT>
__device__ __forceinline__ void attn_unit(P& pol, const bf16* Qc, const bf16* Kc, const bf16* Vc, bf16* Oc, float* ssq, int hh, LAS unsigned char* shm, LAS const float* km) {
    int tid = threadIdx.x; asm volatile("" : "+v"(tid)); const int lane = tid & 63, r32 = lane & 31, hi = lane >> 5; const int wid = __builtin_amdgcn_readfirstlane(tid >> 6);
    const unsigned lds0 = (unsigned)(uintptr_t)shm;
    LAS float* wsf = (LAS float*)(shm + L_WS) + wid * 64;
    const int NT = pol.NT;
    const bf16* ksrc = Kc + (long)lane * D + wid * 8;
    const bf16* vsrc = Vc + (long)(16 * (wid & 3) + (lane >> 2)) * D + (wid >> 2) * 32 + (lane & 3) * 8;
    const unsigned kdst = lds0 + L_K + wid * 1024, vdst = lds0 + L_V + wid * 1024;
#define ATT_DMA(t, slot) do { const long r0_ = pol.row0(t); glds16(ksrc + r0_ * D, (unsigned)__builtin_amdgcn_readfirstlane(kdst + (slot))); glds16(vsrc + r0_ * D, (unsigned)__builtin_amdgcn_readfirstlane(vdst + (slot))); } while (0)
    bf16x8 qr[4];
    { const bf16* qp = Qc + pol.qrow(wid, r32) * D + hi * 8;
#pragma unroll
      for (int d0 = 0; d0 < 4; ++d0) qr[d0] = *(const bf16x8*)(qp + d0 * 16); }
    ATT_DMA(0, 0); ATT_DMA(1, SLOTB); ATT_DMA(2, 2 * SLOTB);
    if constexpr (SELECT) pol.select(qr, km);
    f32x16 o[2]; o[0] = f32x16{}; o[1] = f32x16{}; float l_reg = 0.f;
    const lds_cptr kp0 = (lds_cptr)shm + L_K + hi * 1024 + r32 * 16;
    const int vb0 = (int)(lds0 + L_V) + ((lane >> 4) & 1) * 32 + (lane & 3) * 8 + (4 * hi + ((lane & 15) >> 2)) * 64;
#define ATT_EXP(P0, P1) do { _Pragma("unroll") for (int rr = 0; rr < 16; ++rr) { P0[rr] = __builtin_amdgcn_exp2f(P0[rr]); P1[rr] = __builtin_amdgcn_exp2f(P1[rr]); } } while (0)
#define ATT_SOFTMAX_PV(P0, P1, slotoff) do { float sacc = 0.f; \
        _Pragma("unroll") for (int rr = 0; rr < 16; ++rr) { sacc += P0[rr] + P1[rr]; } \
        l_reg += sacc; \
        const u32x4 pw0 = (u32x4){cvtpk_s(P0[0], P0[1]), cvtpk_s(P0[2], P0[3]), cvtpk_s(P0[4], P0[5]), cvtpk_s(P0[6], P0[7])}; \
        const u32x4 pw1 = (u32x4){cvtpk_s(P0[8], P0[9]), cvtpk_s(P0[10], P0[11]), cvtpk_s(P0[12], P0[13]), cvtpk_s(P0[14], P0[15])}; \
        const u32x4 pw2 = (u32x4){cvtpk_s(P1[0], P1[1]), cvtpk_s(P1[2], P1[3]), cvtpk_s(P1[4], P1[5]), cvtpk_s(P1[6], P1[7])}; \
        const u32x4 pw3 = (u32x4){cvtpk_s(P1[8], P1[9]), cvtpk_s(P1[10], P1[11]), cvtpk_s(P1[12], P1[13]), cvtpk_s(P1[14], P1[15])}; \
        ATT_SBAR(); pv(o, vb0 + (slotoff), __builtin_bit_cast(bf16x8, pw0), __builtin_bit_cast(bf16x8, pw1), __builtin_bit_cast(bf16x8, pw2), __builtin_bit_cast(bf16x8, pw3)); ATT_SBAR(); } while (0)
#define ATT_BODY(PC0, PC1, PN0, PN1, t) do { \
        if ((t) + 2 < NT) { ATT_WAIT_BAR(2); } else { ATT_WAIT_BAR(0); } \
        if ((t) + 3 < NT) ATT_DMA((t) + 3, (((t) + 3) & 3) * SLOTB); \
        const bool an_ = ((t) + 1 < NT) && pol.active((t) + 1, wid); const int tn_ = ((t) + 1 < NT) ? (t) + 1 : (t); \
        if (acur || an_) { pol.cinit(tn_, PN0, PN1); ATT_SBAR(); qkt(PN0, PN1, kp0 + (tn_ & 3) * SLOTB, qr); ATT_EXP(PC0, PC1); ATT_SBAR(); ATT_SOFTMAX_PV(PC0, PC1, ((t) & 3) * SLOTB); } \
        else { _Pragma("unroll") for (int rr = 0; rr < 16; ++rr) { PN0[rr] = ATT_NEG; PN1[rr] = ATT_NEG; } } \
        acur = an_; } while (0)
    f32x16 pA0, pA1, pB0, pB1;
    asm volatile("s_waitcnt vmcnt(4) lgkmcnt(0)\n\ts_barrier" ::: "memory");
    bool acur = pol.active(0, wid);
    { pol.cinit(0, pA0, pA1); qkt(pA0, pA1, kp0, qr); }
    for (int t = 0; t < NT; t += 2) {
        ATT_BODY(pA0, pA1, pB0, pB1, t);
        if (t + 1 < NT) ATT_BODY(pB0, pB1, pA0, pA1, t + 1);
    }
#undef ATT_BODY
#undef ATT_SOFTMAX_PV
#undef ATT_EXP
#undef ATT_DMA
    l_reg += __shfl_xor(l_reg, 32);
    if (hi == 0) wsf[32 + r32] = l_reg;
    asm volatile("s_waitcnt lgkmcnt(0)" ::: "memory");
    float rli[16];
#pragma unroll
    for (int rr = 0; rr < 16; ++rr) rli[rr] = 1.0f / wsf[32 + crow(rr, hi)];
    { LAS unsigned short* stg = (LAS unsigned short*)(shm + L_OST) + wid * 2048;
#pragma unroll
      for (int rr = 0; rr < 16; ++rr) { const int orow = crow(rr, hi);
#pragma unroll
          for (int d0 = 0; d0 < 2; ++d0) stg[orow * 64 + d0 * 32 + r32] = (unsigned short)f2bf(o[d0][rr] * rli[rr]); }
      asm volatile("s_waitcnt lgkmcnt(0)" ::: "memory");
#pragma unroll
      for (int i4 = 0; i4 < 4; ++i4) { const int row = i4 * 8 + (lane >> 3), ch = lane & 7; const u32x4 v = *(LAS const u32x4*)(stg + row * 64 + ch * 8);
          const long grow = pol.orow(wid, row);
          *(u32x4*)(Oc + grow * D + ch * 8) = v;
          float ss = 0.f;
#pragma unroll
          for (int e = 0; e < 4; ++e) { const float a = __uint_as_float(v[e] << 16), c = __uint_as_float(v[e] & 0xffff0000u); ss += a * a + c * c; }
          ss += __shfl_xor(ss, 1); ss += __shfl_xor(ss, 2); ss += __shfl_xor(ss, 4);
          if (ch == 0) ssq[grow * 16 + hh] = ss; } }
    asm volatile("s_waitcnt vmcnt(0) lgkmcnt(0)\n\ts_barrier" ::: "memory");
}


constexpr int M_NSLOT = 3;
constexpr int M_K = 0, M_V = M_NSLOT * SLOTB;
static_assert(2 * M_NSLOT * SLOTB <= L_WS, "MoBA rings fit in front of the per-wave scratch");
__device__ __forceinline__ void kload8(bf16x8* kf, lds_cptr kp) {
    kf[0] = *(LAS const bf16x8*)(kp);        kf[1] = *(LAS const bf16x8*)(kp + 512);
    kf[2] = *(LAS const bf16x8*)(kp + 2048); kf[3] = *(LAS const bf16x8*)(kp + 2560);
    kf[4] = *(LAS const bf16x8*)(kp + 4096); kf[5] = *(LAS const bf16x8*)(kp + 4608);
    kf[6] = *(LAS const bf16x8*)(kp + 6144); kf[7] = *(LAS const bf16x8*)(kp + 6656);
}
__device__ __forceinline__ void kload2(bf16x8* kf, lds_cptr kp, int j) { kf[2 * j] = *(LAS const bf16x8*)(kp + j * 2048); kf[2 * j + 1] = *(LAS const bf16x8*)(kp + j * 2048 + 512); }
__device__ __forceinline__ s16x4 vtr(lds_cptr p) { return __builtin_bit_cast(s16x4, __builtin_amdgcn_ds_read_tr16_b64_v4i16((LAS v4i16_t*)p)); }

__device__ __forceinline__ void attn_unit_moba(PolB& pol, const bf16* Qc, const bf16* Kc, const bf16* Vc, bf16* Oc, float* ssq, int hh, LAS unsigned char* shm, LAS const float* km) {
    int tid = threadIdx.x; asm volatile("" : "+v"(tid)); const int lane = tid & 63, r32 = lane & 31, hi = lane >> 5; const int wid = __builtin_amdgcn_readfirstlane(tid >> 6);
    const unsigned lds0 = (unsigned)(uintptr_t)shm;
    LAS float* wsf = (LAS float*)(shm + L_WS) + wid * 64;
    const int NT = pol.NT;
    const bf16* ksrc = Kc + ((long)pol.b * SEQ + lane) * D + wid * 8;
    const bf16* vsrc = Vc + ((long)pol.b * SEQ + 16 * (wid & 3) + (lane >> 2)) * D + (wid >> 2) * 32 + (lane & 3) * 8;
    const unsigned kdst = lds0 + M_K + wid * 1024, vdst = lds0 + M_V + wid * 1024;
#define DMA_K(t, slot) glds16(ksrc + (long)(t) * 64 * D, (unsigned)__builtin_amdgcn_readfirstlane(kdst + (slot)))
#define DMA_V(t, slot) glds16(vsrc + (long)(t) * 64 * D, (unsigned)__builtin_amdgcn_readfirstlane(vdst + (slot)))
    bf16x8 qr[4];
    { const bf16* qp = Qc + pol.qrow(wid, r32) * D + hi * 8;
#pragma unroll
      for (int d0 = 0; d0 < 4; ++d0) qr[d0] = *(const bf16x8*)(qp + d0 * 16); }
    DMA_K(0, 0); DMA_V(0, 0); DMA_K(1, SLOTB); DMA_K(2, 2 * SLOTB);
    pol.select(qr, km);
    const lds_cptr shm3 = (lds_cptr)shm; const lds_cptr kp0 = shm3 + M_K + hi * 1024 + r32 * 16; const lds_cptr vp0 = shm3 + M_V + ((lane >> 4) & 1) * 32 + (lane & 3) * 8 + (4 * hi + ((lane & 15) >> 2)) * 64;
    f32x16 o[2]; o[0] = f32x16{}; o[1] = f32x16{}; float l_reg = 0.f;
    bf16x8 kf[8];
    f32x16 pA0, pA1, pB0, pB1;
    int sl_prev = 0, sl_cur = 0, sl_next = SLOTB;
#define ROT() do { sl_prev = sl_cur; sl_cur = sl_next; sl_next = (sl_next == (M_NSLOT - 1) * SLOTB) ? 0 : sl_next + SLOTB; } while (0)
    const float sl2 = pol.sl2, s8 = 8.0f * pol.sl2; const int dq0 = pol.dq0; const unsigned sel = pol.sel; const int i4 = 4 * pol.i;
#define CBASE(tt) const int dqi_ = 64 * (tt) + dq0; float cb0_ = sl2 * (float)dqi_; if (!((sel >> ((tt) >> 2)) & 1u)) cb0_ = ATT_NEG; float cb1_ = cb0_ + 32.0f * sl2
#define CEL(X, B, cb, off, BAND) do { float v0_ = (cb), v1_ = v0_ + sl2, v2_ = v1_ + sl2, v3_ = v2_ + sl2; (cb) = v0_ + s8; \
        if (BAND) { const int c_ = 8 * ((B) >> 2) + (off); if (dqi_ + c_ > 0) v0_ = ATT_NEG; if (dqi_ + c_ + 1 > 0) v1_ = ATT_NEG; if (dqi_ + c_ + 2 > 0) v2_ = ATT_NEG; if (dqi_ + c_ + 3 > 0) v3_ = ATT_NEG; } \
        X[(B)] = v0_; X[(B) + 1] = v1_; X[(B) + 2] = v2_; X[(B) + 3] = v3_; } while (0)
    asm volatile("s_waitcnt vmcnt(3) lgkmcnt(0)\n\ts_barrier" ::: "memory");
    { CBASE(0); const bool band0 = (i4 == 0);
#pragma unroll
      for (int b4 = 0; b4 < 16; b4 += 4) { if (band0) { CEL(pA0, b4, cb0_, 0, true); CEL(pA1, b4, cb1_, 32, true); } else { CEL(pA0, b4, cb0_, 0, false); CEL(pA1, b4, cb1_, 32, false); } }
      qkt(pA0, pA1, kp0, qr);
#pragma unroll
      for (int rr = 0; rr < 16; ++rr) { pA0[rr] = __builtin_amdgcn_exp2f(pA0[rr]); pA1[rr] = __builtin_amdgcn_exp2f(pA1[rr]); } }
    { CBASE(1); const bool band1 = (1 >= i4);
#pragma unroll
      for (int b4 = 0; b4 < 16; b4 += 4) { if (band1) { CEL(pB0, b4, cb0_, 0, true); CEL(pB1, b4, cb1_, 32, true); } else { CEL(pB0, b4, cb0_, 0, false); CEL(pB1, b4, cb1_, 32, false); } } }
    asm volatile("s_waitcnt vmcnt(0) lgkmcnt(0)\n\ts_barrier" ::: "memory");
    DMA_K(3, 0); DMA_V(1, SLOTB);
    ROT();
    kload8(kf, kp0 + sl_cur);
    asm volatile("s_waitcnt vmcnt(2) lgkmcnt(0)\n\ts_barrier" ::: "memory");
    s16x4 vlo[8], vhi[8]; u32x4 pw0, pw1, pw2, pw3;
#define PKW(P, B) cvtpk_s(P[B], P[B + 1])
#define PAF(k) __builtin_bit_cast(bf16x8, pw##k)
#define VFR(i) (bf16x8){vlo[i][0], vlo[i][1], vlo[i][2], vlo[i][3], vhi[i][0], vhi[i][1], vhi[i][2], vhi[i][3]}
#define PIN(x) asm volatile("" : "+v"(x))
#define GAPA(MF, A0, A1, A2, A3, W0, W1, PW) do { MF; sacc += A0; sacc += A1; sacc += A2; sacc += A3; PIN(sacc); W0; W1; PIN(PW); ATT_SBAR(); } while (0)
#define EX(v) __builtin_amdgcn_exp2f(v)
#define GAPB(MF, X, B, Y, CB_, OFF_, CI, BAND) do { MF; X[B] = EX(X[B]); X[B + 1] = EX(X[B + 1]); X[B + 2] = EX(X[B + 2]); X[B + 3] = EX(X[B + 3]); PIN(X); if (CI) { CEL(Y, B, CB_, OFF_, BAND); PIN(Y); } ATT_SBAR(); } while (0)
#define VRD(i) do { vlo[i] = vtr(vp_ + (((i) >> 2) * 4096 + ((i) & 3) * 1024)); vhi[i] = vtr(vp_ + (((i) >> 2) * 4096 + ((i) & 3) * 1024 + 512)); } while (0)
#define KRD(G, j) do { if (G) { kload2(kf, kp0 + sl_next, j); ATT_SBAR(); } } while (0)
#define STEP(C0, C1, P0, P1, t, GK, GV, GL, CI, BAND) do { ATT_SBAR(); \
    const lds_cptr vp_ = vp0 + sl_prev; CBASE((t) + 1); \
    VRD(0); ATT_SBAR(); float sacc = (P0[0] + P0[1]); \
    GAPA(C0 = __builtin_amdgcn_mfma_f32_32x32x16_bf16(kf[0], qr[0], C0, 0, 0, 0), P0[2], P0[3], P0[4], P0[5],     pw0[0] = PKW(P0, 0), pw0[1] = PKW(P0, 2), pw0); \
    VRD(4); ATT_SBAR(); GAPA(C1 = __builtin_amdgcn_mfma_f32_32x32x16_bf16(kf[1], qr[0], C1, 0, 0, 0), P0[6], P0[7], P0[8], P0[9],     pw0[2] = PKW(P0, 4), pw0[3] = PKW(P0, 6), pw0); \
    VRD(1); ATT_SBAR(); GAPA(C0 = __builtin_amdgcn_mfma_f32_32x32x16_bf16(kf[2], qr[1], C0, 0, 0, 0), P0[10], P0[11], P0[12], P0[13], pw1[0] = PKW(P0, 8), pw1[1] = PKW(P0, 10), pw1); \
    VRD(5); ATT_SBAR(); GAPA(C1 = __builtin_amdgcn_mfma_f32_32x32x16_bf16(kf[3], qr[1], C1, 0, 0, 0), P0[14], P0[15], P1[0], P1[1],   pw1[2] = PKW(P0, 12), pw1[3] = PKW(P0, 14), pw1); \
    VRD(2); ATT_SBAR(); GAPA(C0 = __builtin_amdgcn_mfma_f32_32x32x16_bf16(kf[4], qr[2], C0, 0, 0, 0), P1[2], P1[3], P1[4], P1[5],     pw2[0] = PKW(P1, 0), pw2[1] = PKW(P1, 2), pw2); \
    VRD(6); ATT_SBAR(); GAPA(C1 = __builtin_amdgcn_mfma_f32_32x32x16_bf16(kf[5], qr[2], C1, 0, 0, 0), P1[6], P1[7], P1[8], P1[9],     pw2[2] = PKW(P1, 4), pw2[3] = PKW(P1, 6), pw2); \
    VRD(3); ATT_SBAR(); GAPA(C0 = __builtin_amdgcn_mfma_f32_32x32x16_bf16(kf[6], qr[3], C0, 0, 0, 0), P1[10], P1[11], P1[12], P1[13], pw3[0] = PKW(P1, 8), pw3[1] = PKW(P1, 10), pw3); \
    VRD(7); ATT_SBAR(); GAPA(C1 = __builtin_amdgcn_mfma_f32_32x32x16_bf16(kf[7], qr[3], C1, 0, 0, 0), P1[14], P1[15], 0.f, 0.f,       pw3[2] = PKW(P1, 12), pw3[3] = PKW(P1, 14), pw3); \
    l_reg += sacc; \
    if (GK) { DMA_K((t) + 3, sl_cur); } if (GV) { DMA_V((t) + 1, sl_next); } \
    ATT_SBAR(); \
    GAPB(o[0] = __builtin_amdgcn_mfma_f32_32x32x16_bf16(PAF(0), VFR(0), o[0], 0, 0, 0), C0, 0, P0, cb0_, 0, CI, BAND); \
    GAPB(o[1] = __builtin_amdgcn_mfma_f32_32x32x16_bf16(PAF(0), VFR(4), o[1], 0, 0, 0), C0, 4, P0, cb0_, 0, CI, BAND); \
    KRD(GL, 0); GAPB(o[0] = __builtin_amdgcn_mfma_f32_32x32x16_bf16(PAF(1), VFR(1), o[0], 0, 0, 0), C0, 8, P0, cb0_, 0, CI, BAND); \
    KRD(GL, 1); GAPB(o[1] = __builtin_amdgcn_mfma_f32_32x32x16_bf16(PAF(1), VFR(5), o[1], 0, 0, 0), C0, 12, P0, cb0_, 0, CI, BAND); \
    KRD(GL, 2); GAPB(o[0] = __builtin_amdgcn_mfma_f32_32x32x16_bf16(PAF(2), VFR(2), o[0], 0, 0, 0), C1, 0, P1, cb1_, 32, CI, BAND); \
    KRD(GL, 3); GAPB(o[1] = __builtin_amdgcn_mfma_f32_32x32x16_bf16(PAF(2), VFR(6), o[1], 0, 0, 0), C1, 4, P1, cb1_, 32, CI, BAND); \
    GAPB(o[0] = __builtin_amdgcn_mfma_f32_32x32x16_bf16(PAF(3), VFR(3), o[0], 0, 0, 0), C1, 8, P1, cb1_, 32, CI, BAND); \
    GAPB(o[1] = __builtin_amdgcn_mfma_f32_32x32x16_bf16(PAF(3), VFR(7), o[1], 0, 0, 0), C1, 12, P1, cb1_, 32, CI, BAND); \
    } while (0)
#define M_WAIT_BAR(N) asm volatile("s_waitcnt vmcnt(" #N ") lgkmcnt(0)\n\ts_barrier" ::: "memory")
    int t = 1;
    for (; t + 5 < NT; t += 2) {
        STEP(pB0, pB1, pA0, pA1, t, true, true, true, true, false);     M_WAIT_BAR(2); ROT();
        STEP(pA0, pA1, pB0, pB1, t + 1, true, true, true, true, false); M_WAIT_BAR(2); ROT();
    }
#define ENDW(tt) do { if ((tt) + 3 < NT) { M_WAIT_BAR(2); } else if ((tt) + 2 < NT) { M_WAIT_BAR(1); } else { M_WAIT_BAR(0); } } while (0)
    for (; t + 1 < NT; t += 2) {
        STEP(pB0, pB1, pA0, pA1, t, (t + 3 < NT), (t + 1 < NT), (t + 1 < NT), true, true);       ENDW(t);     ROT();
        STEP(pA0, pA1, pB0, pB1, t + 1, (t + 4 < NT), (t + 2 < NT), (t + 2 < NT), (t + 2 < NT), true); ENDW(t + 1); ROT();
    }
    STEP(pB0, pB1, pA0, pA1, NT - 1, false, false, false, false, false);
    { float sacc = pB0[0] + pB0[1];
#pragma unroll
      for (int rr = 2; rr < 16; ++rr) sacc += pB0[rr];
#pragma unroll
      for (int rr = 0; rr < 16; ++rr) sacc += pB1[rr];
      l_reg += sacc;
      pw0 = (u32x4){PKW(pB0, 0), PKW(pB0, 2), PKW(pB0, 4), PKW(pB0, 6)}; pw1 = (u32x4){PKW(pB0, 8), PKW(pB0, 10), PKW(pB0, 12), PKW(pB0, 14)};
      pw2 = (u32x4){PKW(pB1, 0), PKW(pB1, 2), PKW(pB1, 4), PKW(pB1, 6)}; pw3 = (u32x4){PKW(pB1, 8), PKW(pB1, 10), PKW(pB1, 12), PKW(pB1, 14)};
      ATT_SBAR(); pv(o, (int)(lds0 + M_V) + ((lane >> 4) & 1) * 32 + (lane & 3) * 8 + (4 * hi + ((lane & 15) >> 2)) * 64 + sl_cur, PAF(0), PAF(1), PAF(2), PAF(3)); }
#undef PKW
#undef PAF
#undef VFR
#undef PIN
#undef GAPA
#undef GAPB
#undef EX
#undef VRD
#undef KRD
#undef STEP
#undef ENDW
#undef M_WAIT_BAR
#undef CBASE
#undef CEL
#undef ROT
#undef DMA_K
#undef DMA_V
    l_reg += __shfl_xor(l_reg, 32);
    if (hi == 0) wsf[32 + r32] = l_reg;
    asm volatile("s_waitcnt lgkmcnt(0)" ::: "memory");
    float rli[16];
#pragma unroll
    for (int rr = 0; rr < 16; ++rr) rli[rr] = 1.0f / wsf[32 + crow(rr, hi)];
    { LAS unsigned short* stg = (LAS unsigned short*)(shm + L_OST) + wid * 2048;
#pragma unroll
      for (int rr = 0; rr < 16; ++rr) { const int orow = crow(rr, hi);
#pragma unroll
          for (int d0 = 0; d0 < 2; ++d0) stg[orow * 64 + d0 * 32 + r32] = (unsigned short)f2bf(o[d0][rr] * rli[rr]); }
      asm volatile("s_waitcnt lgkmcnt(0)" ::: "memory");
#pragma unroll
      for (int i4_ = 0; i4_ < 4; ++i4_) { const int row = i4_ * 8 + (lane >> 3), ch = lane & 7; const u32x4 v = *(LAS const u32x4*)(stg + row * 64 + ch * 8);
          const long grow = pol.orow(wid, row);
          *(u32x4*)(Oc + grow * D + ch * 8) = v;
          float ss = 0.f;
#pragma unroll
          for (int e = 0; e < 4; ++e) { const float a = __uint_as_float(v[e] << 16), c = __uint_as_float(v[e] & 0xffff0000u); ss += a * a + c * c; }
          ss += __shfl_xor(ss, 1); ss += __shfl_xor(ss, 2); ss += __shfl_xor(ss, 4);
          if (ch == 0) ssq[grow * 16 + hh] = ss; } }
    asm volatile("s_waitcnt vmcnt(0) lgkmcnt(0)\n\ts_barrier" ::: "memory");
}

__device__ __forceinline__ void attn_phase(Frame& F) {
    LAS unsigned char* shm = F.lds + RING_OFF;
    LAS float* tab = (LAS float*)(shm + L_TAB);
    int tid_a = threadIdx.x; asm volatile("" : "+v"(tid_a)); const int r32 = tid_a & 31, hi = (tid_a >> 5) & 1;
    for (int su = F.vcu; su < 256; su += F.G) {
        const int b = su >> 5, h = (su >> 2) & 7, r = su & 3;
        fill_tab_A(tab, h, r, F.tid);
        asm volatile("s_waitcnt lgkmcnt(0)\n\ts_barrier" ::: "memory");
        for (int Tb = 0; Tb < 4; ++Tb) { PolA pol; pol.init(b, r, Tb, F.wave, r32, hi, tab);
            attn_unit<PolA, false>(pol, F.QB + h * 64, F.KB + h * 64, F.VB + h * 64, F.OB + h * 64, F.ssq0, h, shm, nullptr); }
    }
    for (int su = F.vcu; su < 256; su += F.G) {
        const int b = su >> 5, h = (su >> 2) & 7, qt = su & 3;
        for (int idx = F.tid; idx < 1024; idx += NWAVES * 64) { const int n = idx >> 6, d = idx & 63; const float* kp = F.kpart + (size_t)((b * 16 + n) * 2) * 512 + h * 64 + d; tab[idx] = kp[0] + kp[512]; }
        asm volatile("s_waitcnt vmcnt(0) lgkmcnt(0)\n\ts_barrier" ::: "memory");
        for (int u4 = 0; u4 < 4; ++u4) { const int s = 2 * qt + (u4 >> 1); const int i = (u4 & 1) ? 15 - s : s;
            PolB pol; pol.b = b; pol.i = i; pol.NT = 4 * (i + 1); pol.hi = hi; pol.dq0 = 4 * hi - (256 * i + 32 * F.wave + r32); pol.sl2 = exp2f(-(float)(h + 1)) * LOG2E; pol.sel = 0u;
            attn_unit_moba(pol, F.QB + 512 + h * 64, F.KB + 512 + h * 64, F.VB + 512 + h * 64, F.OB + 512 + h * 64, F.ssq0, 8 + h, shm, tab); }
    }
}
#undef ATT_WAIT_BAR
#undef ATT_SBAR
}

__device__ __forceinline__ void final_norm(Frame& F) {
    int tid_f = threadIdx.x; asm volatile("" : "+v"(tid_f)); const int lane_f = tid_f & 63;
    const int gw = F.vcu * NWAVES + F.wave, NGW = F.G * NWAVES;
    f32x4 g[2][2];
#pragma unroll
    for (int j = 0; j < 2; ++j) { g[j][0] = *(const GAS f32x4*)(F.g_final + 512 * j + 8 * lane_f); g[j][1] = *(const GAS f32x4*)(F.g_final + 512 * j + 8 * lane_f + 4); }
    for (int m = gw; m < M; m += NGW) {
        const GAS f32x4* sp = (const GAS f32x4*)(F.ssq3 + (size_t)m * 16);
        const f32x4 a = sp[0], b = sp[1], c = sp[2], d = sp[3];
        const float s = ((a.x + a.y) + (a.z + a.w)) + ((b.x + b.y) + (b.z + b.w)) + ((c.x + c.y) + (c.z + c.w)) + ((d.x + d.y) + (d.z + d.w));
        const float rstd = 1.f / sqrtf(s * (1.f / D) + EPS);
#pragma unroll
        for (int j = 0; j < 2; ++j) { const v4u w = *(const GAS v4u*)(F.XN + (size_t)m * D + 512 * j + 8 * lane_f);
            f32x4 o0 = (f32x4){__uint_as_float(w.x << 16), __uint_as_float(w.x & 0xffff0000u), __uint_as_float(w.y << 16), __uint_as_float(w.y & 0xffff0000u)};
            f32x4 o1 = (f32x4){__uint_as_float(w.z << 16), __uint_as_float(w.z & 0xffff0000u), __uint_as_float(w.w << 16), __uint_as_float(w.w & 0xffff0000u)};
            GAS f32x4* op = (GAS f32x4*)(F.out + (size_t)m * D + 512 * j + 8 * lane_f);
            op[0] = o0 * rstd * g[j][0]; op[1] = o1 * rstd * g[j][1]; }
    }
}

struct Args { const float* in[15]; float* out; unsigned char* ws; int ph_lo, ph_hi, li, pad; };
__global__ void __launch_bounds__(NWAVES * 64, 2) mk_fwd(Args args) {
    extern __shared__ __attribute__((aligned(16))) unsigned char lds[];
    Frame F;
    F.lds = (LAS unsigned char*)lds;
    F.MISC = (volatile LAS unsigned*)(F.lds + MISC_OFF);
    F.tid = threadIdx.x; F.lane = F.tid & 63; F.wave = __builtin_amdgcn_readfirstlane(F.tid >> 6);
    F.G = gridDim.x; { const int bx = blockIdx.x; F.vcu = (F.G % 8 == 0) ? (bx % 8) * (F.G / 8) + bx / 8 : bx; }
    unsigned char* ws = args.ws;
    F.ctl = (gu32*)(ws + WS_CTL);
    F.x = args.in[0]; F.p = args.in[1]; F.g_attn = args.in[2]; F.w_in = args.in[3]; F.g_out_a = args.in[4]; F.g_out_b = args.in[5]; F.w_out = args.in[6]; F.g_mlp = args.in[7];
    F.w_up = args.in[8]; F.w_down = args.in[9]; F.g_ple = args.in[10]; F.w_gate = args.in[11]; F.b_gate = args.in[12]; F.w_proj = args.in[13]; F.g_final = args.in[14]; F.out = args.out;
    F.Wqkv_t = (bf16*)(ws + WS_WQKV); F.Wo_t = (bf16*)(ws + WS_WO); F.Wup_t = (bf16*)(ws + WS_WUP); F.Wdn_t = (bf16*)(ws + WS_WDN); F.Wg_t = (bf16*)(ws + WS_WG); F.Wp_t = (bf16*)(ws + WS_WP);
    F.XN = (bf16*)(ws + WS_XN); F.QB = (bf16*)(ws + WS_Q); F.KB = (bf16*)(ws + WS_K); F.VB = (bf16*)(ws + WS_V); F.OB = (bf16*)(ws + WS_O); F.UB = (bf16*)(ws + WS_U); F.PB = (bf16*)(ws + WS_PB); F.PP = (bf16*)(ws + WS_PP);
    F.ssq0 = (float*)(ws + WS_SSQ0); F.ssq1 = (float*)(ws + WS_SSQ1); F.ssq2 = (float*)(ws + WS_SSQ2); F.ssq3 = (float*)(ws + WS_SSQ3); F.kpart = (float*)(ws + WS_KPART);
    for (int u = F.tid; u < (LDS_BYTES - LDSCTL_OFF) / 4; u += NWAVES * 64) ((LAS unsigned*)(F.lds + LDSCTL_OFF))[u] = 0u;
    __syncthreads();
    XcdBarrier bar; bar.bar = (unsigned*)(F.ctl + CW_BAR); bar.x = 0; bar.st = nullptr;
    if (N_LAUNCHES == 1) bar = xcd_barrier_post((unsigned*)(F.ctl + CW_BAR), F.MISC + 8);
    PG8_LAS float* tab = (PG8_LAS float*)(F.lds + TAB_OFF);
    const int lo = args.ph_lo, hi = args.ph_hi;
#define IN(k) (lo <= (k) && (k) < hi)
#define SEAM(k) do { if (IN(k) && IN((k) + 1)) xcd_barrier(bar); } while (0)

    if (IN(0)) { p0_prologue(F); SEAM(0); }
    if (IN(1)) {
        { pg8::Gemm g{F.XN, F.Wqkv_t, M, NQKV, D}; pg8::StaticOrder S; S.init(M, NQKV, F.G, (int)blockIdx.x);
          pg8::EpiQKV E{F.QB, (size_t)(WS_K - WS_Q) / 2, F.kpart, C2};
          pg8::gemm_phase<pg8::EpiQKV, pg8::StaticOrder, true, true>(F.lds + RING_OFF, tab, g, S, E); }
        { pg8::Gemm g{F.PB, F.Wp_t, M, D, PLE}; pg8::StaticOrder S; S.init(M, D, F.G, (int)blockIdx.x);
          pg8::EpiBf16Plain E{F.PP, D};
          pg8::gemm_phase<pg8::EpiBf16Plain, pg8::StaticOrder, true, true>(F.lds + RING_OFF, tab, g, S, E); }
        SEAM(1);
    }
#if defined(ATT_NAIVE)
    if (IN(2)) { attn_naive(F); SEAM(2); }
#else
    if (IN(2)) { att::attn_phase(F); SEAM(2); }
#endif
    if (IN(3)) {
        pg8::Gemm g{F.OB, F.Wo_t, M, D, D}; pg8::StaticOrder S; S.init(M, D, F.G, (int)blockIdx.x);
        pg8::EpiRes<1> E{F.x, F.XN, F.ssq1, F.ssq0};
        pg8::gemm_phase<pg8::EpiRes<1>, pg8::StaticOrder, true, true>(F.lds + RING_OFF, tab, g, S, E);
        SEAM(3);
    }
    if (IN(4)) {
        pg8::Gemm g{F.XN, F.Wup_t, M, FF, D}; pg8::StaticOrder S; S.init(M, FF, F.G, (int)blockIdx.x);
        pg8::EpiUp E{F.UB, FF, F.ssq1};
        pg8::gemm_phase<pg8::EpiUp, pg8::StaticOrder, true, true>(F.lds + RING_OFF, tab, g, S, E);
        SEAM(4);
    }
    if (IN(5)) {
        pg8::Gemm g{F.UB, F.Wdn_t, M, D, FF}; pg8::StaticOrder S; S.init(M, D, F.G, (int)blockIdx.x);
        pg8::EpiRes<0> E{nullptr, F.XN, F.ssq2, nullptr};
        pg8::gemm_phase<pg8::EpiRes<0>, pg8::StaticOrder, true, true>(F.lds + RING_OFF, tab, g, S, E);
        SEAM(5);
    }
    if (IN(6)) {
        pg8::Gemm g{F.XN, F.Wg_t, M, D, D}; pg8::StaticOrder S; S.init(M, D, F.G, (int)blockIdx.x);
        pg8::EpiGate E{F.XN, F.PP, F.b_gate, F.ssq3, F.ssq2};
        pg8::gemm_phase<pg8::EpiGate, pg8::StaticOrder, true, true>(F.lds + RING_OFF, tab, g, S, E);
        SEAM(6);
    }
    if (IN(7)) { final_norm(F); }
#undef IN
#undef SEAM
}

extern "C" void kernel_launch(void* const* d_in, const int* in_sizes, int n_in, void* d_out, int out_size, void* d_ws, size_t ws_size, hipStream_t stream) {
    static int grid = 0;
    if (grid == 0) {
        if (n_in != 15 || in_sizes[0] != M * D || out_size != M * D || ws_size < WS_END) { fprintf(stderr, "kernel_launch: unexpected shapes (n_in %d, in0 %d, out %d, ws %zu); nothing launched\n", n_in, n_in > 0 ? in_sizes[0] : -1, out_size, ws_size); grid = -1; return; }
        int dev = 0, cus = 0, per_cu = 0;
        if (hipGetDevice(&dev) != hipSuccess || hipDeviceGetAttribute(&cus, hipDeviceAttributeMultiprocessorCount, dev) != hipSuccess) { grid = -1; return; }
        if (hipFuncSetAttribute((const void*)mk_fwd, hipFuncAttributeMaxDynamicSharedMemorySize, LDS_BYTES) != hipSuccess) { fprintf(stderr, "kernel_launch: hipFuncSetAttribute failed\n"); grid = -1; return; }
        if (hipOccupancyMaxActiveBlocksPerMultiprocessor(&per_cu, (const void*)mk_fwd, NWAVES * 64, LDS_BYTES) != hipSuccess || per_cu < 1) { fprintf(stderr, "kernel_launch: occupancy query reports %d blocks per CU\n", per_cu); }
        (void)hipGetLastError();
        grid = cus;
    }
    if (grid < 0) return;
    if (hipMemsetAsync((char*)d_ws + WS_CTL, 0, CTL_ZERO_BYTES, stream) != hipSuccess) { fprintf(stderr, "kernel_launch: hipMemsetAsync failed\n"); return; }
    Args a{};
    for (int i = 0; i < 15; ++i) a.in[i] = (const float*)d_in[i];
    a.out = (float*)d_out; a.ws = (unsigned char*)d_ws;
    for (int li = 0; li < N_LAUNCHES; ++li) {
        a.ph_lo = (N_LAUNCHES == 1) ? 0 : li; a.ph_hi = (N_LAUNCHES == 1) ? NPHASE : li + 1; a.li = li;
        hipLaunchKernelGGL(mk_fwd, dim3(grid), dim3(NWAVES * 64), LDS_BYTES, stream, a);
        const hipError_t le = hipPeekAtLastError();
        if (le != hipSuccess) { fprintf(stderr, "kernel_launch: launch %d failed: %s\n", li, hipGetErrorName(le)); break; }
    }
}
```

```cpp
#include <hip/hip_runtime.h>
#include <cstdio>
#include <cstdint>
namespace pg8 {
#define PG8_LAS __attribute__((address_space(3)))
typedef unsigned short bf16_t;
typedef short bf16x8 __attribute__((ext_vector_type(8)));
typedef float f32x4 __attribute__((ext_vector_type(4)));
typedef unsigned u32x4 __attribute__((ext_vector_type(4)));
constexpr int BM = 256, BK = 64, HALF = 128, HTB = HALF * BK * 2  , STAGE_BYTES = 8 * HTB, NXCD = 8, WGM = 8;

__host__ __device__ __forceinline__ int lds_byte(int r, int c) { const int st = (r >> 4) * 2 + (c >> 5), rr = r & 15, cc = c & 31, ob = rr * 64 + cc * 2; return st * 1024 + (ob ^ (((ob >> 9) & 1) << 5)); }
__host__ __device__ __forceinline__ void stage_rc(int b, int& R, int& C) { const int st = b / 1024, sb = b % 1024, swz = sb ^ (((sb >> 9) & 1) << 5); R = (st >> 1) * 16 + swz / 64; C = (st & 1) * 32 + (swz % 64) / 2; }
__host__ __device__ __forceinline__ int perm32(int rho) { const int n = rho >> 4, i = rho & 15; return 8 * (i >> 2) + 4 * n + (i & 3); }

struct Unit { int pm, pn; };
struct Gemm { const bf16_t* A; const bf16_t* Bt; int M, N, K; };

struct StaticOrder {
    int nM, nN, nwg, G, c;
    __host__ __device__ void init(int M, int N, int G_, int c_) { nM = M / BM; nN = N / BM; nwg = nM * nN; G = G_; c = c_; }
    __host__ __device__ bool next(int i, Unit& u) const {
        const long L = (long)i * G + c; if (L >= nwg) return false;
        int wgid = (int)L; { const int q = nwg / NXCD, r = nwg % NXCD, xcd = wgid % NXCD, off = wgid / NXCD; wgid = (xcd < r ? xcd * (q + 1) : r * (q + 1) + (xcd - r) * q) + off; }
        const int nig = WGM * nN, gid = wgid / nig, fm = gid * WGM, gsz = (nM - fm) < WGM ? (nM - fm) : WGM;
        u.pm = fm + ((wgid % nig) % gsz); u.pn = (wgid % nig) / gsz; return true;
    }
    __device__ __forceinline__ void a_ready(const Unit&) const {}
    __device__ __forceinline__ void done(const Unit&) const {}
};

__device__ __forceinline__ unsigned cvt_pk_bf16(float lo, float hi) { unsigned r; asm volatile("v_cvt_pk_bf16_f32 %0, %1, %2" : "=v"(r) : "v"(lo), "v"(hi)); return r; }
typedef unsigned u32x2 __attribute__((ext_vector_type(2)));
constexpr float RMS_EPS = 1e-6f;
__device__ __forceinline__ float sum4(f32x4 v) { return (v[0] + v[1]) + (v[2] + v[3]); }

struct EpiBf16Plain {
    static constexpr bool PERM = true, AFTER_DRAIN = false, MID = false, TABLE = false;
    bf16_t* O; int ldc;
    __device__ __forceinline__ void operator()(f32x4 (&acc)[2][2][4][2], const Unit& u, int wr, int wc, int fr, int fq, PG8_LAS float*, int) const {
        const int row0 = u.pm * BM + wr * 64 + fr, col0 = u.pn * BM + wc * 32 + 8 * fq;
#pragma unroll
        for (int ai = 0; ai < 2; ++ai)
#pragma unroll
            for (int m = 0; m < 4; ++m) { bf16_t* rowp = O + (size_t)(row0 + ai * HALF + m * 16) * ldc + col0;
#pragma unroll
                for (int bj = 0; bj < 2; ++bj) { const f32x4 v0 = acc[ai][bj][m][0], v1 = acc[ai][bj][m][1];
                    u32x4 w; w.x = cvt_pk_bf16(v0[0], v0[1]); w.y = cvt_pk_bf16(v0[2], v0[3]); w.z = cvt_pk_bf16(v1[0], v1[1]); w.w = cvt_pk_bf16(v1[2], v1[3]);
                    *(u32x4*)(rowp + bj * HALF) = w; } }
    }
};

struct EpiQKV {
    static constexpr bool PERM = true, AFTER_DRAIN = false, MID = false, TABLE = false;
    bf16_t* Q; size_t part_stride; float* kpart; float qscale;
    __device__ __forceinline__ void operator()(f32x4 (&acc)[2][2][4][2], const Unit& u, int wr, int wc, int fr, int fq, PG8_LAS float*, int) const {
        const int part = u.pn >> 2, pc = u.pn & 3; const bool ga = pc < 2;
        bf16_t* base = Q + (size_t)part * part_stride; const float sc = part == 0 ? qscale : 1.0f;
        const int row0 = u.pm * BM + wr * 64 + fr, col0 = pc * BM + wc * 32 + 8 * fq;
#pragma unroll
        for (int ai = 0; ai < 2; ++ai)
#pragma unroll
            for (int m = 0; m < 4; ++m) { const int row = row0 + ai * HALF + m * 16;
                const int rowd = ga ? ((row & ~4095) | ((row & 3) << 10) | ((row & 4095) >> 2)) : row;
                bf16_t* rowp = base + (size_t)rowd * 1024 + col0;
#pragma unroll
                for (int bj = 0; bj < 2; ++bj) { const f32x4 v0 = acc[ai][bj][m][0] * sc, v1 = acc[ai][bj][m][1] * sc;
                    u32x4 w; w.x = cvt_pk_bf16(v0[0], v0[1]); w.y = cvt_pk_bf16(v0[2], v0[3]); w.z = cvt_pk_bf16(v1[0], v1[1]); w.w = cvt_pk_bf16(v1[2], v1[3]);
                    *(u32x4*)(rowp + bj * HALF) = w; } }
        if (part == 1 && !ga) {
#pragma unroll
            for (int bj = 0; bj < 2; ++bj) {
                f32x4 s0 = acc[0][bj][0][0], s1 = acc[0][bj][0][1];
#pragma unroll
                for (int ai = 0; ai < 2; ++ai)
#pragma unroll
                    for (int m = 0; m < 4; ++m) if (ai + m) { s0 += acc[ai][bj][m][0]; s1 += acc[ai][bj][m][1]; }
#pragma unroll
                for (int e = 0; e < 4; ++e) {
#pragma unroll
                    for (int o = 1; o < 16; o <<= 1) { s0[e] += __shfl_xor(s0[e], o); s1[e] += __shfl_xor(s1[e], o); } }
                if (fr == 0) { float* kp = kpart + (size_t)(u.pm * 2 + wr) * 512 + (pc - 2) * BM + bj * HALF + wc * 32 + 8 * fq;
                    *(f32x4*)kp = s0; *(f32x4*)(kp + 4) = s1; }
            }
        }
    }
};

template <int KIND> __device__ __forceinline__ void fill_rowscale(const float* ssq, const Unit& u, int par, PG8_LAS float* tab, int tid) {
    if (tid < 256) {
        const f32x4* p = (const f32x4*)(ssq + (size_t)(u.pm * BM + tid) * 16);
        const f32x4 a0 = p[0], a1 = p[1], b0 = p[2], b1 = p[3];
        const float sa = sum4(a0) + sum4(a1), sb = sum4(b0) + sum4(b1);
        if (KIND == 1) { tab[par * 512 + 2 * tid] = 1.0f / sqrtf((sa + sb) * (1.0f / 1024.0f) + RMS_EPS); }
        else { const float ra = 1.0f / sqrtf(sa * (1.0f / 512.0f) + RMS_EPS), rb = 1.0f / sqrtf(sb * (1.0f / 512.0f) + RMS_EPS);
            tab[par * 512 + 2 * tid] = ra / rb; tab[par * 512 + 2 * tid + 1] = rb; }
    }
}

struct EpiUp {
    static constexpr bool PERM = true, AFTER_DRAIN = false, MID = false, TABLE = true;
    bf16_t* O; int ldc; const float* ssq;
    __device__ __forceinline__ void fill(const Unit& u, int par, PG8_LAS float* tab, int tid) const { fill_rowscale<1>(ssq, u, par, tab, tid); }
    __device__ __forceinline__ void operator()(f32x4 (&acc)[2][2][4][2], const Unit& u, int wr, int wc, int fr, int fq, PG8_LAS float* tab, int par) const {
        const int row0 = u.pm * BM + wr * 64 + fr, col0 = u.pn * BM + wc * 32 + 8 * fq;
#pragma unroll
        for (int ai = 0; ai < 2; ++ai)
#pragma unroll
            for (int m = 0; m < 4; ++m) { const int r = ai * HALF + wr * 64 + m * 16 + fr; const float rs = tab[par * 512 + 2 * r];
                bf16_t* rowp = O + (size_t)(row0 + ai * HALF + m * 16) * ldc + col0;
#pragma unroll
                for (int bj = 0; bj < 2; ++bj) { f32x4 v0 = acc[ai][bj][m][0] * rs, v1 = acc[ai][bj][m][1] * rs;
#pragma unroll
                    for (int e = 0; e < 4; ++e) { const float a = fmaxf(v0[e], 0.f), b = fmaxf(v1[e], 0.f); v0[e] = a * a; v1[e] = b * b; }
                    u32x4 w; w.x = cvt_pk_bf16(v0[0], v0[1]); w.y = cvt_pk_bf16(v0[2], v0[3]); w.z = cvt_pk_bf16(v1[0], v1[1]); w.w = cvt_pk_bf16(v1[2], v1[3]);
                    *(u32x4*)(rowp + bj * HALF) = w; } }
    }
};

template <int KIND> struct EpiRes {
    static constexpr bool PERM = true, AFTER_DRAIN = false, MID = (KIND == 1), TABLE = (KIND == 1);
    const float* res32; bf16_t* hb; float* ssq_out; const float* ssq_in;
    __device__ __forceinline__ void fill(const Unit& u, int par, PG8_LAS float* tab, int tid) const { fill_rowscale<2>(ssq_in, u, par, tab, tid); }
    __device__ __forceinline__ void mid(f32x4 (&acc)[2][2][4][2], int wr, int fr, PG8_LAS float* tab, int par) const {
#pragma unroll
        for (int ai = 0; ai < 2; ++ai)
#pragma unroll
            for (int m = 0; m < 4; ++m) { const float f = tab[par * 512 + 2 * (ai * HALF + wr * 64 + m * 16 + fr)];
#pragma unroll
                for (int bj = 0; bj < 2; ++bj)
#pragma unroll
                    for (int n = 0; n < 2; ++n) acc[ai][bj][m][n] *= f; }
    }
    __device__ __forceinline__ void operator()(f32x4 (&acc)[2][2][4][2], const Unit& u, int wr, int wc, int fr, int fq, PG8_LAS float* tab, int par) const {
        const int col0 = u.pn * BM + wc * 32 + 8 * fq;
#pragma unroll
        for (int ai = 0; ai < 2; ++ai) {
            f32x4 rv[4][2][2];
#pragma unroll
            for (int m = 0; m < 4; ++m) { const size_t off = (size_t)(u.pm * BM + ai * HALF + wr * 64 + m * 16 + fr) * 1024 + col0;
#pragma unroll
                for (int bj = 0; bj < 2; ++bj) {
                    if (KIND == 1) { rv[m][bj][0] = *(const f32x4*)(res32 + off + bj * HALF); rv[m][bj][1] = *(const f32x4*)(res32 + off + bj * HALF + 4); }
                    else { const u32x4 w = *(const u32x4*)(hb + off + bj * HALF);
                        rv[m][bj][0] = (f32x4){__uint_as_float(w.x << 16), __uint_as_float(w.x & 0xffff0000u), __uint_as_float(w.y << 16), __uint_as_float(w.y & 0xffff0000u)};
                        rv[m][bj][1] = (f32x4){__uint_as_float(w.z << 16), __uint_as_float(w.z & 0xffff0000u), __uint_as_float(w.w << 16), __uint_as_float(w.w & 0xffff0000u)}; } } }
#pragma unroll
            for (int m = 0; m < 4; ++m) { const int r = ai * HALF + wr * 64 + m * 16 + fr; const int rowg = u.pm * BM + r;
                const float rb = (KIND == 1) ? tab[par * 512 + 2 * r + 1] : 1.0f;
                const size_t off = (size_t)rowg * 1024 + col0; float ss = 0.f;
#pragma unroll
                for (int bj = 0; bj < 2; ++bj) { const f32x4 v0 = rv[m][bj][0] + acc[ai][bj][m][0] * rb, v1 = rv[m][bj][1] + acc[ai][bj][m][1] * rb;
                    u32x4 w; w.x = cvt_pk_bf16(v0[0], v0[1]); w.y = cvt_pk_bf16(v0[2], v0[3]); w.z = cvt_pk_bf16(v1[0], v1[1]); w.w = cvt_pk_bf16(v1[2], v1[3]);
                    *(u32x4*)(hb + off + bj * HALF) = w;
                    ss += ((v0[0] * v0[0] + v0[1] * v0[1]) + (v0[2] * v0[2] + v0[3] * v0[3])) + ((v1[0] * v1[0] + v1[1] * v1[1]) + (v1[2] * v1[2] + v1[3] * v1[3])); }
                ss += __shfl_xor(ss, 16); ss += __shfl_xor(ss, 32);
                if (fq == 0) ssq_out[(size_t)rowg * 16 + u.pn * 4 + wc] = ss; }
            asm volatile("" ::: "memory");
        }
    }
};

struct EpiGate {
    static constexpr bool PERM = true, AFTER_DRAIN = false, MID = false, TABLE = true;
    bf16_t* hb; const bf16_t* pp; const float* bias; float* ssq_out; const float* ssq_in;
    __device__ __forceinline__ void fill(const Unit& u, int par, PG8_LAS float* tab, int tid) const { fill_rowscale<1>(ssq_in, u, par, tab, tid); }
    __device__ __forceinline__ void operator()(f32x4 (&acc)[2][2][4][2], const Unit& u, int wr, int wc, int fr, int fq, PG8_LAS float* tab, int par) const {
        const int col0 = u.pn * BM + wc * 32 + 8 * fq;
        f32x4 bv[2][2];
#pragma unroll
        for (int bj = 0; bj < 2; ++bj)
#pragma unroll
            for (int n = 0; n < 2; ++n) bv[bj][n] = *(const f32x4*)(bias + col0 + bj * HALF + 4 * n);
#pragma unroll
        for (int ai = 0; ai < 2; ++ai) {
            u32x4 hv[4][2], pv[4][2];
#pragma unroll
            for (int m = 0; m < 4; ++m) { const size_t off = (size_t)(u.pm * BM + ai * HALF + wr * 64 + m * 16 + fr) * 1024 + col0;
#pragma unroll
                for (int bj = 0; bj < 2; ++bj) { hv[m][bj] = *(const u32x4*)(hb + off + bj * HALF); pv[m][bj] = *(const u32x4*)(pp + off + bj * HALF); } }
#pragma unroll
            for (int m = 0; m < 4; ++m) { const int r = ai * HALF + wr * 64 + m * 16 + fr; const int rowg = u.pm * BM + r;
                const float rs = tab[par * 512 + 2 * r];
                const size_t off = (size_t)rowg * 1024 + col0; float ss = 0.f;
#pragma unroll
                for (int bj = 0; bj < 2; ++bj) { float v[8];
#pragma unroll
                    for (int e = 0; e < 8; ++e) { const unsigned hw = hv[m][bj][e >> 1], pw = pv[m][bj][e >> 1];
                        const float h = __uint_as_float((e & 1) ? (hw & 0xffff0000u) : (hw << 16)), p = __uint_as_float((e & 1) ? (pw & 0xffff0000u) : (pw << 16));
                        const float z = acc[ai][bj][m][e >> 2][e & 3] * rs + bv[bj][e >> 2][e & 3];
                        v[e] = h + __builtin_amdgcn_rcpf(1.0f + __builtin_amdgcn_exp2f(-1.4426950408889634f * z)) * p; ss += v[e] * v[e]; }
                    u32x4 w; w.x = cvt_pk_bf16(v[0], v[1]); w.y = cvt_pk_bf16(v[2], v[3]); w.z = cvt_pk_bf16(v[4], v[5]); w.w = cvt_pk_bf16(v[6], v[7]);
                    *(u32x4*)(hb + off + bj * HALF) = w; }
                ss += __shfl_xor(ss, 16); ss += __shfl_xor(ss, 32);
                if (fq == 0) ssq_out[(size_t)rowg * 16 + u.pn * 4 + wc] = ss; }
            asm volatile("" ::: "memory");
        }
    }
};

template <class Epi, class Sched, bool ALIGN_EPI = false, bool SP2 = false>
__device__ __forceinline__ void gemm_phase(PG8_LAS unsigned char* lds, PG8_LAS float* tab, const Gemm g, const Sched& S, const Epi& E) {
    const int tid = threadIdx.x, wid = __builtin_amdgcn_readfirstlane(tid >> 6), lane = tid & 63, wr = wid >> 2, wc = wid & 3, fr = lane & 15, fq = lane >> 4;
    const int K = g.K, nt = K / BK;
    unsigned voffA[2], voffB[2];
#pragma unroll
    for (int i = 0; i < 2; ++i) { int R, C; stage_rc(tid * 16 + i * 8192, R, C); const int Rb = Epi::PERM ? ((R & ~31) + perm32(R & 31)) : R;
        voffA[i] = (unsigned)(R * K + C) * 2u; voffB[i] = (unsigned)(Rb * K + C) * 2u; }
    const size_t kstep = (size_t)(BK * 2);
    const size_t hstep = (size_t)HALF * K * 2;
    const size_t tstep = 2 * hstep;
    const unsigned ldsw = (unsigned)wid * 1024u;
    const int aoff = lds_byte(wr * 64 + fr, fq * 8), boff = lds_byte(wc * 32 + fr, fq * 8);
#define PG8_SA(b, h) (((b) * 2 + (h)) * HTB)
#define PG8_SB(b, h) ((4 + (b) * 2 + (h)) * HTB)
#define PG8_STAGE(bufoff, gbase, voff) do { _Pragma("unroll") for (int _i = 0; _i < 2; ++_i) \
        __builtin_amdgcn_global_load_lds((const unsigned*)((const char*)(gbase) + (voff)[_i]), (PG8_LAS unsigned*)(lds + (bufoff) + ldsw + _i * 8192), 16, 0, 0); } while (0)
#define PG8_LDA(dst, b, h) do { _Pragma("unroll") for (int m = 0; m < 4; ++m) _Pragma("unroll") for (int k = 0; k < 2; ++k) dst[m][k] = *(const PG8_LAS bf16x8*)(lds + PG8_SA(b, h) + aoff + m * 2048 + k * 1024); } while (0)
#define PG8_LDB(dst, b, h) do { _Pragma("unroll") for (int n = 0; n < 2; ++n) _Pragma("unroll") for (int k = 0; k < 2; ++k) dst[n][k] = *(const PG8_LAS bf16x8*)(lds + PG8_SB(b, h) + boff + n * 2048 + k * 1024); } while (0)
#define PG8_MMA(ai, bj, At, Bt) do { __builtin_amdgcn_s_setprio(1); _Pragma("unroll") for (int m = 0; m < 4; ++m) _Pragma("unroll") for (int n = 0; n < 2; ++n) _Pragma("unroll") for (int k = 0; k < 2; ++k) \
        acc[ai][bj][m][n] = __builtin_amdgcn_mfma_f32_16x16x32_bf16(Bt[n][k], At[m][k], acc[ai][bj][m][n], 0, 0, 0); __builtin_amdgcn_s_setprio(0); } while (0)
#define PG8_WAIT_V(n) asm volatile("s_waitcnt vmcnt(" #n ")" ::: "memory")
#define PG8_WAIT_L(n) asm volatile("s_waitcnt lgkmcnt(" #n ")" ::: "memory")
#define PG8_BAR __builtin_amdgcn_s_barrier()
#define PG8_SCHED __builtin_amdgcn_sched_barrier(0)
    Unit cur, nxt; int ui = 0;
    if (!S.next(0, cur)) return;
    if constexpr (Epi::TABLE) E.fill(cur, 0, tab, tid);
    f32x4 acc[2][2][4][2];
#pragma unroll
    for (int a = 0; a < 2; ++a)
#pragma unroll
        for (int b = 0; b < 2; ++b)
#pragma unroll
            for (int m = 0; m < 4; ++m)
#pragma unroll
                for (int n = 0; n < 2; ++n) acc[a][b][m][n] = (f32x4){0.f, 0.f, 0.f, 0.f};
    bf16x8 At[4][2], B0[2][2], B1[2][2];
    const char* cA = (const char*)g.A + (size_t)cur.pm * tstep; const char* cB = (const char*)g.Bt + (size_t)cur.pn * tstep;
    S.a_ready(cur);
    if constexpr (SP2) {
        PG8_STAGE(PG8_SB(0, 0), cB, voffB); PG8_STAGE(PG8_SB(0, 1), cB + hstep, voffB); PG8_STAGE(PG8_SA(0, 0), cA, voffA); PG8_STAGE(PG8_SA(0, 1), cA + hstep, voffA);
        if (wr == 1) PG8_BAR;
        PG8_WAIT_V(2); PG8_BAR;
        PG8_STAGE(PG8_SB(1, 0), cB + kstep, voffB); PG8_STAGE(PG8_SA(1, 0), cA + kstep, voffA); PG8_STAGE(PG8_SB(1, 1), cB + hstep + kstep, voffB);
        PG8_WAIT_V(6); PG8_BAR;
    } else {
        PG8_STAGE(PG8_SB(0, 0), cB, voffB); PG8_STAGE(PG8_SA(0, 0), cA, voffA); PG8_STAGE(PG8_SB(0, 1), cB + hstep, voffB); PG8_STAGE(PG8_SA(0, 1), cA + hstep, voffA);
        if (wr == 1) PG8_BAR;
        PG8_WAIT_V(4); PG8_BAR;
        PG8_STAGE(PG8_SB(1, 0), cB + kstep, voffB); PG8_STAGE(PG8_SA(1, 0), cA + kstep, voffA); PG8_STAGE(PG8_SB(1, 1), cB + hstep + kstep, voffB);
        PG8_WAIT_V(6); PG8_BAR;
    }
    for (;;) {
        const bool has_next = S.next(ui + 1, nxt);
        const char* nA = has_next ? (const char*)g.A + (size_t)nxt.pm * tstep : cA; const char* nB = has_next ? (const char*)g.Bt + (size_t)nxt.pn * tstep : cB;
        for (int t = 0; t < nt; t += 2) {
            const bool last = (t == nt - 2);
            if constexpr (Epi::MID) { if (t == (nt >> 1)) E.mid(acc, wr, fr, tab, ui & 1); }
            const char* a1 = cA + (size_t)(t + 1) * kstep;
            const char* a2 = last ? nA : cA + (size_t)(t + 2) * kstep; const char* b2 = last ? nB : cB + (size_t)(t + 2) * kstep;
            const char* a3 = a2 + kstep; const char* b3 = b2 + kstep;
            if (last && has_next) S.a_ready(nxt);
            if constexpr (SP2) {
            PG8_LDB(B0, 0, 0); PG8_LDB(B1, 0, 1); PG8_SCHED; PG8_LDA(At, 0, 0); PG8_STAGE(PG8_SA(1, 1), a1 + hstep, voffA);
            PG8_WAIT_V(8); PG8_WAIT_L(0); PG8_BAR; PG8_MMA(0, 0, At, B0); PG8_MMA(0, 1, At, B1); PG8_BAR; PG8_SCHED;
            PG8_LDA(At, 0, 1); PG8_STAGE(PG8_SB(0, 0), b2, voffB); PG8_STAGE(PG8_SB(0, 1), b2 + hstep, voffB); PG8_STAGE(PG8_SA(0, 0), a2, voffA);
            PG8_WAIT_V(8); PG8_WAIT_L(0); PG8_BAR; PG8_MMA(1, 0, At, B0); PG8_MMA(1, 1, At, B1); PG8_BAR; PG8_SCHED;
            PG8_LDB(B0, 1, 0); PG8_LDB(B1, 1, 1); PG8_SCHED; PG8_LDA(At, 1, 0); PG8_STAGE(PG8_SA(0, 1), a2 + hstep, voffA);
            PG8_WAIT_V(8); PG8_WAIT_L(0); PG8_BAR; PG8_MMA(0, 0, At, B0); PG8_MMA(0, 1, At, B1); PG8_BAR; PG8_SCHED;
            PG8_LDA(At, 1, 1); PG8_STAGE(PG8_SB(1, 0), b3, voffB); PG8_STAGE(PG8_SB(1, 1), b3 + hstep, voffB); PG8_STAGE(PG8_SA(1, 0), a3, voffA);
            PG8_WAIT_V(8); PG8_WAIT_L(0); PG8_BAR; PG8_MMA(1, 0, At, B0); PG8_MMA(1, 1, At, B1); PG8_BAR; PG8_SCHED;
            } else {
            PG8_LDB(B0, 0, 0); PG8_SCHED; PG8_LDA(At, 0, 0); PG8_STAGE(PG8_SA(1, 1), a1 + hstep, voffA);
            PG8_WAIT_L(8); PG8_BAR; PG8_WAIT_L(0); PG8_MMA(0, 0, At, B0); PG8_BAR; PG8_SCHED;
            PG8_LDB(B1, 0, 1); PG8_STAGE(PG8_SB(0, 0), b2, voffB);
            PG8_BAR; PG8_WAIT_L(0); PG8_MMA(0, 1, At, B1); PG8_BAR;
            PG8_LDA(At, 0, 1); PG8_STAGE(PG8_SA(0, 0), a2, voffA);
            PG8_BAR; PG8_WAIT_L(0); PG8_MMA(1, 0, At, B0); PG8_BAR; PG8_SCHED;
            PG8_STAGE(PG8_SB(0, 1), b2 + hstep, voffB);
            PG8_WAIT_V(6); PG8_BAR; PG8_MMA(1, 1, At, B1); PG8_BAR;
            PG8_LDB(B0, 1, 0); PG8_SCHED; PG8_LDA(At, 1, 0); PG8_STAGE(PG8_SA(0, 1), a2 + hstep, voffA);
            PG8_WAIT_L(8); PG8_BAR; PG8_WAIT_L(0); PG8_MMA(0, 0, At, B0); PG8_BAR; PG8_SCHED;
            PG8_LDB(B1, 1, 1); PG8_STAGE(PG8_SB(1, 0), b3, voffB);
            PG8_BAR; PG8_WAIT_L(0); PG8_MMA(0, 1, At, B1); PG8_BAR;
            PG8_LDA(At, 1, 1); PG8_STAGE(PG8_SA(1, 0), a3, voffA);
            PG8_BAR; PG8_WAIT_L(0); PG8_MMA(1, 0, At, B0); PG8_BAR; PG8_SCHED;
            PG8_STAGE(PG8_SB(1, 1), b3 + hstep, voffB);
            PG8_WAIT_V(6); PG8_BAR; PG8_MMA(1, 1, At, B1); PG8_BAR;
            }
        }
        if constexpr (ALIGN_EPI) { if (wr == 0) PG8_BAR; }
        if constexpr (!Epi::AFTER_DRAIN) { int tid_e = threadIdx.x; asm volatile("" : "+v"(tid_e)); const int lane_e = tid_e & 63;
            E(acc, cur, wr, wc, lane_e & 15, lane_e >> 4, tab, ui & 1); S.done(cur); }
        if (!has_next) break;
#pragma unroll
        for (int a = 0; a < 2; ++a)
#pragma unroll
            for (int b = 0; b < 2; ++b)
#pragma unroll
                for (int m = 0; m < 4; ++m)
#pragma unroll
                    for (int n = 0; n < 2; ++n) acc[a][b][m][n] = (f32x4){0.f, 0.f, 0.f, 0.f};
        cur = nxt; cA = nA; cB = nB; ++ui;
        if constexpr (Epi::TABLE) E.fill(cur, ui & 1, tab, tid);
        if constexpr (ALIGN_EPI) { if (wr == 1) PG8_BAR; }
    }
    PG8_WAIT_V(0);
    if constexpr (!ALIGN_EPI) { if (wr == 0) PG8_BAR; }
    PG8_BAR;
    if constexpr (Epi::AFTER_DRAIN) { E.fused(acc, cur, wr, wc, fr, fq, lds, wid, lane); S.done(cur); }
#undef PG8_SA
#undef PG8_SB
#undef PG8_STAGE
#undef PG8_LDA
#undef PG8_LDB
#undef PG8_MMA
#undef PG8_WAIT_V
#undef PG8_WAIT_L
#undef PG8_BAR
#undef PG8_SCHED
}
}
#define GAS __attribute__((address_space(1)))
#define LAS __attribute__((address_space(3)))
typedef unsigned short bf16;
typedef unsigned v4u __attribute__((ext_vector_type(4)));
typedef float f32x4 __attribute__((ext_vector_type(4)));
typedef short bf16x8 __attribute__((ext_vector_type(8)));
typedef GAS unsigned gu32;
typedef GAS unsigned long long gu64;
#define RLX_AGENT __ATOMIC_RELAXED, __HIP_MEMORY_SCOPE_AGENT
#define LDS_WAIT() asm volatile("s_waitcnt lgkmcnt(0)" ::: "memory")
#define VM_WAIT() asm volatile("s_waitcnt vmcnt(0)" ::: "memory")
__device__ __forceinline__ unsigned long long rt() { return __builtin_amdgcn_s_memrealtime(); }
__device__ __forceinline__ unsigned f2bf(float f) { unsigned u = __builtin_bit_cast(unsigned, f); return (u + 0x7fffu + ((u >> 16) & 1u)) >> 16; }
__device__ __forceinline__ unsigned pk2(float lo, float hi) { return f2bf(lo) | (f2bf(hi) << 16); }

#define XB_TMO      128
#define XB_XCNT(j)  (256  + 64 * (j))
#define XB_XSUB(j)  (1280 + 64 * (j))
#define XB_XGEN(j)  (2304 + 64 * (j))
#define XB_TOP      3328
#define XB_TOPGEN   3392
#define XCD_BAR_WORDS 3456
#define XB_SPIN_CAP (1u << 18)

__device__ __forceinline__ unsigned xb_ld(unsigned* p)              { return __hip_atomic_load(p, __ATOMIC_RELAXED, __HIP_MEMORY_SCOPE_AGENT); }
__device__ __forceinline__ unsigned xb_add(unsigned* p, unsigned v) { return __hip_atomic_fetch_add(p, v, __ATOMIC_RELAXED, __HIP_MEMORY_SCOPE_AGENT); }
__device__ __forceinline__ unsigned xb_xcc_id() { return (unsigned)__builtin_amdgcn_s_getreg((3 << 11) | 20) & 0xFu; }
#define XB_SPIN(cond, bar) do { unsigned _sp = 0; while (cond) { __builtin_amdgcn_s_sleep(1); \
    if ((++_sp & 255u) == 0u) { if (xb_ld(&(bar)[XB_TMO])) break; if (_sp > XB_SPIN_CAP) { atomicAdd(&(bar)[XB_TMO], 1u); break; } } } } while (0)

struct XcdBarrier {
    unsigned* bar; unsigned x;
    volatile LAS unsigned* st;
};

__device__ __forceinline__ XcdBarrier xcd_barrier_post(unsigned* bar, volatile LAS unsigned* st) {
    XcdBarrier b; b.bar = bar; b.x = xb_xcc_id(); b.st = st;
    if (threadIdx.x == 0) (void)xb_add(&bar[XB_XCNT(b.x)], 1u);
    return b;
}
__device__ __forceinline__ void xcd_barrier_complete(unsigned* bar, unsigned x, unsigned& nloc, unsigned& nx) {
    const unsigned G = gridDim.x * gridDim.y * gridDim.z;
    unsigned sum, cnt, mine, sp = 0u;
    for (;;) {
        sum = 0u; cnt = 0u; mine = 0u;
#pragma unroll
        for (unsigned j = 0; j < 16; ++j) { const unsigned c = xb_ld(&bar[XB_XCNT(j)]); sum += c; cnt += (c > 0u) ? 1u : 0u; mine = (j == x) ? c : mine; }
        if (sum == G) break;
        __builtin_amdgcn_s_sleep(1);
        if ((++sp & 255u) == 0u) { if (xb_ld(&bar[XB_TMO])) break; if (sp > XB_SPIN_CAP) { atomicAdd(&bar[XB_TMO], 1u); break; } }
    }
    nloc = mine > 0u ? mine : 1u; nx = cnt > 0u ? cnt : 1u;
}

__device__ __forceinline__ void xcd_barrier(const XcdBarrier& b) {
    asm volatile("s_waitcnt vmcnt(0)" ::: "memory");
    __syncthreads();
    if (threadIdx.x == 0) {
        unsigned* bar = b.bar;
        __builtin_amdgcn_s_waitcnt(0);
        unsigned nloc = b.st[0], nx = b.st[1];
        if (nloc == 0u) { xcd_barrier_complete(bar, b.x, nloc, nx); b.st[0] = nloc; b.st[1] = nx; }
        const unsigned old = xb_add(&bar[XB_XSUB(b.x)], 1u);
        const unsigned gen = old / nloc;
        if (old + 1u == (gen + 1u) * nloc) {
            __builtin_amdgcn_fence(__ATOMIC_RELEASE, "agent");
            asm volatile("s_waitcnt vmcnt(0)" ::: "memory");
            const unsigned og = xb_add(&bar[XB_TOP], 1u);
            const unsigned tg = og / nx;
            if (og + 1u == (tg + 1u) * nx) xb_add(&bar[XB_TOPGEN], 1u);
            else XB_SPIN(xb_ld(&bar[XB_TOPGEN]) == tg, bar);
            __builtin_amdgcn_fence(__ATOMIC_ACQUIRE, "agent");
            xb_add(&bar[XB_XGEN(b.x)], 1u);
            asm volatile("s_waitcnt vmcnt(0)" ::: "memory");
        } else {
            XB_SPIN(xb_ld(&bar[XB_XGEN(b.x)]) == gen, bar);
            __builtin_amdgcn_fence(__ATOMIC_ACQUIRE, "agent");
            asm volatile("s_waitcnt vmcnt(0)" ::: "memory");
        }
    }
    __syncthreads();
}

constexpr int NWAVES = 8;
#ifndef MK_N_LAUNCHES
#define MK_N_LAUNCHES 1
#endif
constexpr int N_LAUNCHES = MK_N_LAUNCHES;
constexpr int NPHASE = 8;
static_assert(N_LAUNCHES == 1 || N_LAUNCHES == NPHASE, "MK_N_LAUNCHES is 1 or NPHASE");

constexpr int BATCH = 8, SEQ = 4096, D = 1024, NH = 16, HD = 64, FF = 4096, PLE = 256;
constexpr int M = BATCH * SEQ;
constexpr int NQKV = 3 * D;
constexpr float EPS = 1e-6f;
constexpr float LOG2E = 1.4426950408889634f;
constexpr float C2 = 0.125f * LOG2E;

constexpr size_t MiB = 1u << 20;
constexpr size_t WS_CTL = 0, CTL_ZERO_BYTES = 64 * 1024;
constexpr size_t WS_WQKV = 1 * MiB, WS_WO = 7 * MiB, WS_WUP = 9 * MiB, WS_WDN = 17 * MiB, WS_WG = 25 * MiB, WS_WP = 27 * MiB;
constexpr size_t WS_SSQ0 = 28 * MiB, WS_SSQ1 = 30 * MiB, WS_SSQ2 = 32 * MiB, WS_SSQ3 = 34 * MiB;
constexpr size_t WS_KPART = 36 * MiB;
constexpr size_t WS_PB = 40 * MiB;
constexpr size_t WS_PP = 56 * MiB;
constexpr size_t WS_XN = 120 * MiB;
constexpr size_t WS_Q = 184 * MiB, WS_K = 248 * MiB, WS_V = 312 * MiB, WS_O = 376 * MiB;
constexpr size_t WS_U = 184 * MiB;
constexpr size_t WS_END = 440 * MiB;
constexpr int CW_BAR = 1024;

constexpr int RING_OFF = 0, RING_BYTES = 131072;
constexpr int LDSCTL_OFF = RING_BYTES, MISC_OFF = LDSCTL_OFF + 320;
constexpr int TAB_OFF = RING_BYTES + 1024;
constexpr int LDS_BYTES = 147456;
static_assert(TAB_OFF + 4096 <= LDS_BYTES, "LDS map");

struct Frame {
    LAS unsigned char* lds;
    volatile LAS unsigned* MISC;
    gu32* ctl;
    int tid, lane, wave;
    int vcu, G;
    const float *x, *p, *g_attn, *w_in, *g_out_a, *g_out_b, *w_out, *g_mlp, *w_up, *w_down, *g_ple, *w_gate, *b_gate, *w_proj, *g_final;
    float* out;
    bf16 *Wqkv_t, *Wo_t, *Wup_t, *Wdn_t, *Wg_t, *Wp_t;
    bf16 *XN, *QB, *KB, *VB, *OB, *UB, *PB, *PP;
    float *ssq0, *ssq1, *ssq2, *ssq3, *kpart;
};

__device__ __forceinline__ float wave_sum(float v) {
#pragma unroll
    for (int o = 1; o < 64; o <<= 1) v += __shfl_xor(v, o);
    return v;
}
__device__ __forceinline__ void p0_transpose_item(const float* W, int K, int N, bf16* dst, const float* g, LAS float* scr, int k0, int n0, int lane) {
    f32x4 wv[8];
#pragma unroll
    for (int i = 0; i < 8; ++i) wv[i] = *(const GAS f32x4*)(W + (size_t)(k0 + 8 * i + (lane >> 3)) * N + n0 + 4 * (lane & 7));
#pragma unroll
    for (int i = 0; i < 8; ++i) { const int kk = 8 * i + (lane >> 3); f32x4 v = wv[i]; if (g) v = v * g[k0 + kk]; LAS float* d = scr + kk * 33 + 4 * (lane & 7); d[0] = v.x; d[1] = v.y; d[2] = v.z; d[3] = v.w; }
    LDS_WAIT(); asm volatile("" ::: "memory");
    const int c = lane & 7;
#pragma unroll
    for (int j = 0; j < 4; ++j) { const int n = (lane >> 3) + 8 * j; const LAS float* s = scr + (8 * c) * 33 + n;
        v4u o; o.x = pk2(s[0 * 33], s[1 * 33]); o.y = pk2(s[2 * 33], s[3 * 33]); o.z = pk2(s[4 * 33], s[5 * 33]); o.w = pk2(s[6 * 33], s[7 * 33]);
        *(GAS v4u*)(dst + (size_t)n * K + k0 + 8 * c) = o; }
    LDS_WAIT(); asm volatile("" ::: "memory");
}
__device__ __forceinline__ int qkv_dst_row(int n0) {
    if (n0 < 1536) return (n0 / 512) * 1024 + (n0 % 512);
    const int n1 = n0 - 1536; return (n1 / 512) * 1024 + 512 + (n1 % 512);
}
__device__ __forceinline__ void p0_prologue(Frame& F) {
    LAS float* scr = (LAS float*)(F.lds + RING_OFF + F.wave * 16384);
    const int gw = F.vcu * NWAVES + F.wave, NGW = F.G * NWAVES;
    constexpr int I_IN = (D / 64) * (NQKV / 32), I_O = (D / 64) * (D / 32), I_UP = (D / 64) * (FF / 32), I_DN = (FF / 64) * (D / 32), I_G = I_O, I_P = (PLE / 64) * (D / 32);
    constexpr int NITEMS = I_IN + I_O + I_UP + I_DN + I_G + I_P;
    for (int it = gw; it < NITEMS; it += NGW) {
        int r = it;
        if (r < I_IN) { const int nb = r % (NQKV / 32), kb = r / (NQKV / 32); p0_transpose_item(F.w_in, D, NQKV, F.Wqkv_t + (size_t)qkv_dst_row(32 * nb) * D, F.g_attn, scr, 64 * kb, 32 * nb, F.lane); continue; } r -= I_IN;
        if (r < I_O) { const int nb = r % (D / 32), kb = r / (D / 32); const float* g = (64 * kb < 512) ? F.g_out_a : (F.g_out_b - 512);
            p0_transpose_item(F.w_out, D, D, F.Wo_t + (size_t)(32 * nb) * D, g, scr, 64 * kb, 32 * nb, F.lane); continue; } r -= I_O;
        if (r < I_UP) { const int nb = r % (FF / 32), kb = r / (FF / 32); p0_transpose_item(F.w_up, D, FF, F.Wup_t + (size_t)(32 * nb) * D, F.g_mlp, scr, 64 * kb, 32 * nb, F.lane); continue; } r -= I_UP;
        if (r < I_DN) { const int nb = r % (D / 32), kb = r / (D / 32); p0_transpose_item(F.w_down, FF, D, F.Wdn_t + (size_t)(32 * nb) * FF, nullptr, scr, 64 * kb, 32 * nb, F.lane); continue; } r -= I_DN;
        if (r < I_G) { const int nb = r % (D / 32), kb = r / (D / 32); p0_transpose_item(F.w_gate, D, D, F.Wg_t + (size_t)(32 * nb) * D, F.g_ple, scr, 64 * kb, 32 * nb, F.lane); continue; } r -= I_G;
        { const int nb = r % (D / 32), kb = r / (D / 32); p0_transpose_item(F.w_proj, PLE, D, F.Wp_t + (size_t)(32 * nb) * PLE, nullptr, scr, 64 * kb, 32 * nb, F.lane); }
    }
    for (int m0 = 2 * gw; m0 < M; m0 += 2 * NGW) {
        f32x4 v[2][4]; f32x4 pv[2]; float s[2] = {0.f, 0.f};
#pragma unroll
        for (int q = 0; q < 2; ++q) { const GAS f32x4* xr = (const GAS f32x4*)(F.x + (size_t)(m0 + q) * D) + F.lane;
#pragma unroll
            for (int j = 0; j < 4; ++j) v[q][j] = xr[64 * j];
            pv[q] = ((const GAS f32x4*)(F.p + (size_t)(m0 + q) * PLE))[F.lane]; }
#pragma unroll
        for (int q = 0; q < 2; ++q) {
#pragma unroll
            for (int j = 0; j < 4; ++j) s[q] += (v[q][j].x * v[q][j].x + v[q][j].y * v[q][j].y) + (v[q][j].z * v[q][j].z + v[q][j].w * v[q][j].w);
            const float rstd = 1.f / sqrtf(wave_sum(s[q]) * (1.f / D) + EPS);
            GAS unsigned long long* o8 = (GAS unsigned long long*)(F.XN + (size_t)(m0 + q) * D) + F.lane;
#pragma unroll
            for (int j = 0; j < 4; ++j) o8[64 * j] = (unsigned long long)pk2(v[q][j].x * rstd, v[q][j].y * rstd) | ((unsigned long long)pk2(v[q][j].z * rstd, v[q][j].w * rstd) << 32);
            ((GAS unsigned long long*)(F.PB + (size_t)(m0 + q) * PLE))[F.lane] = (unsigned long long)pk2(pv[q].x, pv[q].y) | ((unsigned long long)pk2(pv[q].z, pv[q].w) << 32); }
    }
}

__device__ __forceinline__ float bf2f(unsigned short h) { return __uint_as_float((unsigned)h << 16); }
__device__ __forceinline__ void naive_key(const bf16* kp, const bf16* vp, const float (&q)[64], float bias, float& mx, float& l, float (&acc)[64]) {
    float s = 0.f;
#pragma unroll
    for (int c = 0; c < 8; ++c) { const v4u kw = *(const v4u*)(kp + 8 * c);
        s += q[8 * c + 0] * __uint_as_float(kw.x << 16) + q[8 * c + 1] * __uint_as_float(kw.x & 0xffff0000u) + q[8 * c + 2] * __uint_as_float(kw.y << 16) + q[8 * c + 3] * __uint_as_float(kw.y & 0xffff0000u)
           + q[8 * c + 4] * __uint_as_float(kw.z << 16) + q[8 * c + 5] * __uint_as_float(kw.z & 0xffff0000u) + q[8 * c + 6] * __uint_as_float(kw.w << 16) + q[8 * c + 7] * __uint_as_float(kw.w & 0xffff0000u); }
    s += bias;
    const float mn = fmaxf(mx, s), sc = __builtin_amdgcn_exp2f(mx - mn), pe = __builtin_amdgcn_exp2f(s - mn);
    mx = mn; l = l * sc + pe;
#pragma unroll
    for (int c = 0; c < 8; ++c) { const v4u vw = *(const v4u*)(vp + 8 * c);
        acc[8 * c + 0] = acc[8 * c + 0] * sc + pe * __uint_as_float(vw.x << 16); acc[8 * c + 1] = acc[8 * c + 1] * sc + pe * __uint_as_float(vw.x & 0xffff0000u);
        acc[8 * c + 2] = acc[8 * c + 2] * sc + pe * __uint_as_float(vw.y << 16); acc[8 * c + 3] = acc[8 * c + 3] * sc + pe * __uint_as_float(vw.y & 0xffff0000u);
        acc[8 * c + 4] = acc[8 * c + 4] * sc + pe * __uint_as_float(vw.z << 16); acc[8 * c + 5] = acc[8 * c + 5] * sc + pe * __uint_as_float(vw.z & 0xffff0000u);
        acc[8 * c + 6] = acc[8 * c + 6] * sc + pe * __uint_as_float(vw.w << 16); acc[8 * c + 7] = acc[8 * c + 7] * sc + pe * __uint_as_float(vw.w & 0xffff0000u); }
}
__device__ __forceinline__ void attn_naive(Frame& F) {
    const long NT = (long)F.G * NWAVES * 64;
    for (long idx = (long)blockIdx.x * (NWAVES * 64) + F.tid; idx < (long)M * NH; idx += NT) {
        const int tok = (int)(idx % M), hh = (int)(idx / M); const int b = tok / SEQ, t = tok % SEQ; const int grp = hh >> 3, h = hh & 7;
        float q[64], acc[64]; float mx = -1e30f, l = 0.f;
#pragma unroll
        for (int d = 0; d < 64; ++d) acc[d] = 0.f;
        if (grp == 0) {
            const float sl2 = exp2f(-0.5f * (float)(2 * h + 1)) * LOG2E;
            const size_t qrow = (size_t)b * SEQ + (size_t)(t & 3) * 1024 + (t >> 2);
            const bf16* qp = F.QB + qrow * D + h * 64;
#pragma unroll
            for (int d = 0; d < 64; ++d) q[d] = bf2f(qp[d]);
            for (int br = 0; br < 3; ++br) { const int dil = br == 0 ? 1 : (br == 1 ? 4 : 16);
                for (int mm = 0; mm <= 128; ++mm) { const int key = t - dil * mm; if (key < 0) break;
                    const size_t krow = (size_t)b * SEQ + (size_t)(key & 3) * 1024 + (key >> 2);
                    naive_key(F.KB + krow * D + h * 64, F.VB + krow * D + h * 64, q, -sl2 * (float)(dil * mm), mx, l, acc); } }
        } else {
            const float sl2 = exp2f(-(float)(h + 1)) * LOG2E;
            const bf16* qp = F.QB + (size_t)tok * D + 512 + h * 64;
#pragma unroll
            for (int d = 0; d < 64; ++d) q[d] = bf2f(qp[d]);
            const int own = t >> 8; int i0 = -1, i1 = -1, i2 = -1; float g0 = -INFINITY, g1 = -INFINITY, g2 = -INFINITY;
            for (int n = 0; n < own; ++n) { const float* k0 = F.kpart + (size_t)((b * 16 + n) * 2) * 512 + h * 64; const float* k1 = k0 + 512; float g = 0.f;
#pragma unroll
                for (int d = 0; d < 64; ++d) g += q[d] * (k0[d] + k1[d]);
                if (g > g0) { g2 = g1; i2 = i1; g1 = g0; i1 = i0; g0 = g; i0 = n; } else if (g > g1) { g2 = g1; i2 = i1; g1 = g; i1 = n; } else if (g > g2) { g2 = g; i2 = n; } }
            for (int j = 0; j < 4; ++j) { const int n = j == 0 ? i0 : (j == 1 ? i1 : (j == 2 ? i2 : own)); if (n < 0) continue;
                const int kend = (j == 3) ? t : 256 * n + 255;
                for (int key = 256 * n; key <= kend; ++key) { const size_t krow = (size_t)b * SEQ + key;
                    naive_key(F.KB + krow * D + 512 + h * 64, F.VB + krow * D + 512 + h * 64, q, -sl2 * (float)(t - key), mx, l, acc); } }
        }
        const float rl = 1.0f / l; float ss = 0.f; bf16* op = F.OB + (size_t)tok * D + grp * 512 + h * 64;
#pragma unroll
        for (int d = 0; d < 64; d += 2) { const float a = acc[d] * rl, c = acc[d + 1] * rl; ss += a * a + c * c; *(unsigned*)(op + d) = pk2(a, c); }
        F.ssq0[(size_t)tok * 16 + hh] = ss;
    }
}


namespace att {
typedef short bf16x8 __attribute__((ext_vector_type(8)));
typedef short s16x4 __attribute__((ext_vector_type(4)));
typedef float f32x16 __attribute__((ext_vector_type(16)));
typedef unsigned u32x4 __attribute__((ext_vector_type(4)));
typedef LAS const char* lds_cptr;
constexpr int NSLOT = 4, SLOTB = 8192;
constexpr int L_K = 0, L_V = 5 * SLOTB, L_WS = 10 * SLOTB, L_OST = L_WS + 8 * 256, L_TAB = L_OST + 8 * 4096, L_END = L_TAB + 12288;
static_assert(L_END <= RING_BYTES, "attention LDS map");
typedef short v4i16_t __attribute__((ext_vector_type(4)));
#define ATT_NEG (-INFINITY)
__device__ __forceinline__ int crow(int r, int hi) { return (r & 3) + 8 * (r >> 2) + 4 * hi; }
__device__ __forceinline__ void glds16(const void* gsrc, unsigned lds_dst) { unsigned keep;
    asm volatile("s_mov_b32 %0, m0\n\ts_mov_b32 m0, %2\n\ts_nop 0\n\tglobal_load_lds_dwordx4 %1, off\n\ts_mov_b32 m0, %0" : "=&s"(keep) : "v"(gsrc), "s"(lds_dst) : "memory"); }
typedef float f32x2_t __attribute__((ext_vector_type(2))); typedef __bf16 bf16x2_t __attribute__((ext_vector_type(2)));
__device__ __forceinline__ unsigned cvtpk_s(float lo, float hi) { f32x2_t v = {lo, hi}; bf16x2_t b = __builtin_convertvector(v, bf16x2_t); return __builtin_bit_cast(unsigned, b); }
#define ATT_WAIT_BAR(N) asm volatile("s_waitcnt vmcnt(" #N ") lgkmcnt(0)\n\ts_barrier" ::: "memory")
#define ATT_SBAR() __builtin_amdgcn_sched_barrier(0)

__device__ __forceinline__ void qkt(f32x16& p0, f32x16& p1, lds_cptr kb, const bf16x8 (&qr)[4]) {
#pragma unroll
    for (int d0 = 0; d0 < 4; ++d0) {
        const bf16x8 b0 = *(LAS const bf16x8*)(kb + d0 * 2048);
        const bf16x8 b1 = *(LAS const bf16x8*)(kb + d0 * 2048 + 512);
        p0 = __builtin_amdgcn_mfma_f32_32x32x16_bf16(b0, qr[d0], p0, 0, 0, 0);
        p1 = __builtin_amdgcn_mfma_f32_32x32x16_bf16(b1, qr[d0], p1, 0, 0, 0); }
}
__device__ __forceinline__ void pv(f32x16 (&o)[2], int vb, bf16x8 pa0, bf16x8 pa1, bf16x8 pa2, bf16x8 pa3) {
#pragma unroll
    for (int d0 = 0; d0 < 2; ++d0) { s16x4 lo[4], hi[4];
#pragma unroll
        for (int ks = 0; ks < 4; ++ks) {
            asm volatile("ds_read_b64_tr_b16 %0,%1 offset:%c2" : "=&v"(lo[ks]) : "v"(vb), "i"(d0 * 4096 + ks * 1024) : "memory");
            asm volatile("ds_read_b64_tr_b16 %0,%1 offset:%c2" : "=&v"(hi[ks]) : "v"(vb), "i"(d0 * 4096 + ks * 1024 + 512) : "memory"); }
        asm volatile("s_waitcnt lgkmcnt(0)" ::: "memory"); ATT_SBAR();
#define ATT_PK(k) (bf16x8){lo[k][0], lo[k][1], lo[k][2], lo[k][3], hi[k][0], hi[k][1], hi[k][2], hi[k][3]}
        o[d0] = __builtin_amdgcn_mfma_f32_32x32x16_bf16(pa0, ATT_PK(0), o[d0], 0, 0, 0);
        o[d0] = __builtin_amdgcn_mfma_f32_32x32x16_bf16(pa1, ATT_PK(1), o[d0], 0, 0, 0);
        o[d0] = __builtin_amdgcn_mfma_f32_32x32x16_bf16(pa2, ATT_PK(2), o[d0], 0, 0, 0);
        o[d0] = __builtin_amdgcn_mfma_f32_32x32x16_bf16(pa3, ATT_PK(3), o[d0], 0, 0, 0);
#undef ATT_PK
    }
}

__device__ __forceinline__ void qkt2(f32x16& p0, f32x16& p1, lds_cptr kpA, lds_cptr kpB, const bf16x8 (&qr)[4]) {
#pragma unroll
    for (int d0 = 0; d0 < 4; ++d0) {
        const bf16x8 b0 = *(LAS const bf16x8*)(kpA + d0 * 2048);
        const bf16x8 b1 = *(LAS const bf16x8*)(kpB + d0 * 2048);
        p0 = __builtin_amdgcn_mfma_f32_32x32x16_bf16(b0, qr[d0], p0, 0, 0, 0);
        p1 = __builtin_amdgcn_mfma_f32_32x32x16_bf16(b1, qr[d0], p1, 0, 0, 0); }
}
__device__ __forceinline__ void pv2(f32x16 (&o)[2], int vbA, int vbB, bf16x8 pa0, bf16x8 pa1, bf16x8 pa2, bf16x8 pa3) {
#pragma unroll
    for (int d0 = 0; d0 < 2; ++d0) { s16x4 lo[4], hi[4];
#pragma unroll
        for (int ks = 0; ks < 4; ++ks) {
            asm volatile("ds_read_b64_tr_b16 %0,%1 offset:%c2" : "=&v"(lo[ks]) : "v"(ks < 2 ? vbA : vbB), "i"(d0 * 4096 + ks * 1024) : "memory");
            asm volatile("ds_read_b64_tr_b16 %0,%1 offset:%c2" : "=&v"(hi[ks]) : "v"(ks < 2 ? vbA : vbB), "i"(d0 * 4096 + ks * 1024 + 512) : "memory"); }
        asm volatile("s_waitcnt lgkmcnt(0)" ::: "memory"); ATT_SBAR();
#define ATT_PK(k) (bf16x8){lo[k][0], lo[k][1], lo[k][2], lo[k][3], hi[k][0], hi[k][1], hi[k][2], hi[k][3]}
        o[d0] = __builtin_amdgcn_mfma_f32_32x32x16_bf16(pa0, ATT_PK(0), o[d0], 0, 0, 0);
        o[d0] = __builtin_amdgcn_mfma_f32_32x32x16_bf16(pa1, ATT_PK(1), o[d0], 0, 0, 0);
        o[d0] = __builtin_amdgcn_mfma_f32_32x32x16_bf16(pa2, ATT_PK(2), o[d0], 0, 0, 0);
        o[d0] = __builtin_amdgcn_mfma_f32_32x32x16_bf16(pa3, ATT_PK(3), o[d0], 0, 0, 0);
#undef ATT_PK
    }
}

struct PolA {
    int b, r, T0, NT, NT_own, jmin, jpmin, per, iq;
    LAS const float* tab; int hi;
    __device__ __forceinline__ void init(int b_, int r_, int Tblk, int wid, int r32, int hi_, LAS const float* tab_) {
        b = b_; r = r_; T0 = 256 * Tblk; jmin = T0 >= 512 ? 0 : (512 - T0) / 64; NT_own = 12 - jmin; jpmin = T0 == 0 ? 1 : 0; per = 5 - jpmin; NT = NT_own;
        iq = T0 + 32 * wid + r32; tab = tab_; hi = hi_; }
    __device__ __forceinline__ void tile(int t, int& rho, int& ik0, int& k) const {
        if (t < NT_own) { k = 0; rho = r; ik0 = T0 - 512 + 64 * (jmin + t); }
        else { const int tp = t - NT_own; k = 1 + tp / per; rho = (r + k) & 3; ik0 = T0 - 64 + 64 * (jpmin + tp % per); } }
    __device__ __forceinline__ long row0(int t) const { int rho, ik0, k; tile(t, rho, ik0, k); return (long)b * SEQ + rho * 1024 + ik0; }
    __device__ __forceinline__ long qrow(int wid, int r32) const { return (long)b * SEQ + r * 1024 + T0 + 32 * wid + r32; }
    __device__ __forceinline__ long orow(int wid, int row) const { return (long)b * SEQ + 4 * (T0 + 32 * wid + row) + r; }
    __device__ __forceinline__ bool active(int t, int wid) const {
        int rho, ik0, k; tile(t, rho, ik0, k); const int dmax = T0 + 32 * wid + 31 - ik0, dmin = T0 + 32 * wid - ik0 - 63; return dmax >= 0 && dmin <= (k == 0 ? 512 : 32); }
    __device__ __forceinline__ void cinit(int t, f32x16& p0, f32x16& p1) const {
        int rho, ik0, k; tile(t, rho, ik0, k);
        LAS const float* tb = tab + (k == 0 ? 0 : 1024 + (k - 1) * 576) + (iq - ik0 - 4 * hi + 256 - 63);
#pragma unroll
        for (int rr = 0; rr < 16; ++rr) { const int c = (rr & 3) + 8 * (rr >> 2); p0[rr] = tb[63 - c]; p1[rr] = tb[31 - c]; }
    }
};
__device__ __forceinline__ void fill_tab_A(LAS float* tab, int h, int r, int tid) {
    const float sl2 = exp2f(-0.5f * (float)(2 * h + 1)) * LOG2E;
    for (int idx = tid; idx < 1024; idx += NWAVES * 64) { const int dl = idx - 256; float v = ATT_NEG;
        if (dl >= 0 && dl <= 512) { const int w = (dl <= 32 ? 1 : 0) + (dl <= 128 ? 1 : 0) + ((dl & 3) == 0 ? 1 : 0);
            if (w > 0) v = (w == 1 ? 0.f : (w == 2 ? 1.f : 1.5849625007211562f)) - sl2 * (float)(4 * dl); }
        tab[idx] = v; }
    for (int idx = tid; idx < 3 * 576; idx += NWAVES * 64) { const int k = 1 + idx / 576, dl = idx % 576 - 256; const int rho = (r + k) & 3; const int dist = 4 * dl + (r - rho);
        tab[1024 + idx] = (dist >= 0 && dist <= 128) ? -sl2 * (float)dist : ATT_NEG; }
}

struct PolB {
    int b, i, NT, dq0, hi; unsigned sel; float sl2;
    __device__ __forceinline__ long row0(int t) const { return (long)b * SEQ + 64 * t; }
    __device__ __forceinline__ long qrow(int wid, int r32) const { return (long)b * SEQ + 256 * i + 32 * wid + r32; }
    __device__ __forceinline__ long orow(int wid, int row) const { return (long)b * SEQ + 256 * i + 32 * wid + row; }
    __device__ __forceinline__ bool active(int t, int) const { return __any((int)((sel >> (t >> 2)) & 1u)) != 0; }
    __device__ __forceinline__ void cinit(int t, f32x16& p0, f32x16& p1) const {
        const int dqi = 64 * t + dq0;
        float base = sl2 * (float)dqi; if (!((sel >> (t >> 2)) & 1u)) base = ATT_NEG;
        const float base1 = base + 32.0f * sl2;
#pragma unroll
        for (int rr = 0; rr < 16; ++rr) { const int c = (rr & 3) + 8 * (rr >> 2); p0[rr] = base + sl2 * (float)c; p1[rr] = base1 + sl2 * (float)c; }
        if (t >= 4 * i) {
            asm volatile("; causal band tile" ::: "memory");
#pragma unroll
            for (int rr = 0; rr < 16; ++rr) { const int c = (rr & 3) + 8 * (rr >> 2); if (dqi + c > 0) p0[rr] = ATT_NEG; if (dqi + c + 32 > 0) p1[rr] = ATT_NEG; }
        }
    }
    __device__ __forceinline__ void select(const bf16x8 (&qr)[4], LAS const float* km) {
        float qf[32];
#pragma unroll
        for (int d0 = 0; d0 < 4; ++d0)
#pragma unroll
            for (int j = 0; j < 8; ++j) qf[8 * d0 + j] = __uint_as_float((unsigned)(unsigned short)qr[d0][j] << 16);
        int i0 = -1, i1 = -1, i2 = -1; float g0 = ATT_NEG, g1 = ATT_NEG, g2 = ATT_NEG;
        for (int n = 0; n < i; ++n) { float g = 0.f;
#pragma unroll
            for (int d0 = 0; d0 < 4; ++d0) { const f32x4 ka = *(LAS const f32x4*)(km + n * 64 + 16 * d0 + 8 * hi), kb = *(LAS const f32x4*)(km + n * 64 + 16 * d0 + 8 * hi + 4);
                g += (qf[8 * d0 + 0] * ka.x + qf[8 * d0 + 1] * ka.y) + (qf[8 * d0 + 2] * ka.z + qf[8 * d0 + 3] * ka.w) + (qf[8 * d0 + 4] * kb.x + qf[8 * d0 + 5] * kb.y) + (qf[8 * d0 + 6] * kb.z + qf[8 * d0 + 7] * kb.w); }
            g += __shfl_xor(g, 32);
            if (g > g0) { g2 = g1; i2 = i1; g1 = g0; i1 = i0; g0 = g; i0 = n; } else if (g > g1) { g2 = g1; i2 = i1; g1 = g; i1 = n; } else if (g > g2) { g2 = g; i2 = n; } }
        sel = 1u << i; if (i0 >= 0) sel |= 1u << i0; if (i1 >= 0) sel |= 1u << i1; if (i2 >= 0) sel |= 1u << i2;
    }
};

template <class P, bool SELECT>
__device__ __forceinline__ void attn_unit(P& pol, const bf16* Qc, const bf16* Kc, const bf16* Vc, bf16* Oc, float* ssq, int hh, LAS unsigned char* shm, LAS const float* km) {
    int tid = threadIdx.x; asm volatile("" : "+v"(tid)); const int lane = tid & 63, r32 = lane & 31, hi = lane >> 5; const int wid = __builtin_amdgcn_readfirstlane(tid >> 6);
    const unsigned lds0 = (unsigned)(uintptr_t)shm;
    LAS float* wsf = (LAS float*)(shm + L_WS) + wid * 64;
    const int NT = pol.NT;
    const bf16* ksrc = Kc + (long)lane * D + wid * 8;
    const bf16* vsrc = Vc + (long)(16 * (wid & 3) + (lane >> 2)) * D + (wid >> 2) * 32 + (lane & 3) * 8;
    const unsigned kdst = lds0 + L_K + wid * 1024, vdst = lds0 + L_V + wid * 1024;
#define ATT_DMA(t, slot) do { const long r0_ = pol.row0(t); glds16(ksrc + r0_ * D, (unsigned)__builtin_amdgcn_readfirstlane(kdst + (slot))); glds16(vsrc + r0_ * D, (unsigned)__builtin_amdgcn_readfirstlane(vdst + (slot))); } while (0)
    bf16x8 qr[4];
    { const bf16* qp = Qc + pol.qrow(wid, r32) * D + hi * 8;
#pragma unroll
      for (int d0 = 0; d0 < 4; ++d0) qr[d0] = *(const bf16x8*)(qp + d0 * 16); }
    ATT_DMA(0, 0); ATT_DMA(1, SLOTB); ATT_DMA(2, 2 * SLOTB);
    if constexpr (SELECT) pol.select(qr, km);
    f32x16 o[2]; o[0] = f32x16{}; o[1] = f32x16{}; float l_reg = 0.f;
    const lds_cptr kp0 = (lds_cptr)shm + L_K + hi * 1024 + r32 * 16;
    const int vb0 = (int)(lds0 + L_V) + ((lane >> 4) & 1) * 32 + (lane & 3) * 8 + (4 * hi + ((lane & 15) >> 2)) * 64;
#define ATT_EXP(P0, P1) do { _Pragma("unroll") for (int rr = 0; rr < 16; ++rr) { P0[rr] = __builtin_amdgcn_exp2f(P0[rr]); P1[rr] = __builtin_amdgcn_exp2f(P1[rr]); } } while (0)
#define ATT_SOFTMAX_PV(P0, P1, slotoff) do { float sacc = 0.f; \
        _Pragma("unroll") for (int rr = 0; rr < 16; ++rr) { sacc += P0[rr] + P1[rr]; } \
        l_reg += sacc; \
        const u32x4 pw0 = (u32x4){cvtpk_s(P0[0], P0[1]), cvtpk_s(P0[2], P0[3]), cvtpk_s(P0[4], P0[5]), cvtpk_s(P0[6], P0[7])}; \
        const u32x4 pw1 = (u32x4){cvtpk_s(P0[8], P0[9]), cvtpk_s(P0[10], P0[11]), cvtpk_s(P0[12], P0[13]), cvtpk_s(P0[14], P0[15])}; \
        const u32x4 pw2 = (u32x4){cvtpk_s(P1[0], P1[1]), cvtpk_s(P1[2], P1[3]), cvtpk_s(P1[4], P1[5]), cvtpk_s(P1[6], P1[7])}; \
        const u32x4 pw3 = (u32x4){cvtpk_s(P1[8], P1[9]), cvtpk_s(P1[10], P1[11]), cvtpk_s(P1[12], P1[13]), cvtpk_s(P1[14], P1[15])}; \
        ATT_SBAR(); pv(o, vb0 + (slotoff), __builtin_bit_cast(bf16x8, pw0), __builtin_bit_cast(bf16x8, pw1), __builtin_bit_cast(bf16x8, pw2), __builtin_bit_cast(bf16x8, pw3)); ATT_SBAR(); } while (0)
#define ATT_BODY(PC0, PC1, PN0, PN1, t) do { \
        if ((t) + 2 < NT) { ATT_WAIT_BAR(2); } else { ATT_WAIT_BAR(0); } \
        if ((t) + 3 < NT) ATT_DMA((t) + 3, (((t) + 3) & 3) * SLOTB); \
        const bool an_ = ((t) + 1 < NT) && pol.active((t) + 1, wid); const int tn_ = ((t) + 1 < NT) ? (t) + 1 : (t); \
        if (acur || an_) { pol.cinit(tn_, PN0, PN1); ATT_SBAR(); qkt(PN0, PN1, kp0 + (tn_ & 3) * SLOTB, qr); ATT_EXP(PC0, PC1); ATT_SBAR(); ATT_SOFTMAX_PV(PC0, PC1, ((t) & 3) * SLOTB); } \
        else { _Pragma("unroll") for (int rr = 0; rr < 16; ++rr) { PN0[rr] = ATT_NEG; PN1[rr] = ATT_NEG; } } \
        acur = an_; } while (0)
    f32x16 pA0, pA1, pB0, pB1;
    asm volatile("s_waitcnt vmcnt(4) lgkmcnt(0)\n\ts_barrier" ::: "memory");
    bool acur = pol.active(0, wid);
    { pol.cinit(0, pA0, pA1); qkt(pA0, pA1, kp0, qr); }
    for (int t = 0; t < NT; t += 2) {
        ATT_BODY(pA0, pA1, pB0, pB1, t);
        if (t + 1 < NT) ATT_BODY(pB0, pB1, pA0, pA1, t + 1);
    }
    if constexpr (!SELECT) {
        const bool even = !(wid & 1); const int sA = even ? (wid >> 1) : ((wid + 1) >> 1), sB = even ? sA + 1 : sA;
        const lds_cptr kpA = kp0 + sA * SLOTB + (even ? 512 : 0), kpB = kp0 + sB * SLOTB + (even ? 0 : 512);
        const int vbA = vb0 + sA * SLOTB + (even ? 2048 : 0), vbB = vb0 + sB * SLOTB - (even ? 2048 : 0);
        for (int k = 1; k <= 3; ++k) {
            const long rowk = (long)pol.b * SEQ + ((pol.r + k) & 3) * 1024 + pol.T0 - 64;
            asm volatile("s_waitcnt lgkmcnt(0)\n\ts_barrier" ::: "memory");
            for (int j = pol.jpmin; j < 5; ++j) { glds16(ksrc + (rowk + 64 * j) * D, (unsigned)__builtin_amdgcn_readfirstlane(kdst + j * SLOTB)); glds16(vsrc + (rowk + 64 * j) * D, (unsigned)__builtin_amdgcn_readfirstlane(vdst + j * SLOTB)); }
            f32x16 p0, p1;
            { LAS const float* tb = pol.tab + 1024 + (k - 1) * 576 + (r32 + 32 - 4 * hi + 256 - 63);
#pragma unroll
              for (int rr = 0; rr < 16; ++rr) { const int c = (rr & 3) + 8 * (rr >> 2); p0[rr] = tb[63 - c]; p1[rr] = tb[31 - c]; }
              if (pol.T0 == 0 && wid == 0) {
#pragma unroll
                  for (int rr = 0; rr < 16; ++rr) p0[rr] = ATT_NEG; } }
            asm volatile("s_waitcnt vmcnt(0) lgkmcnt(0)\n\ts_barrier" ::: "memory");
            qkt2(p0, p1, kpA, kpB, qr);
            float sacc = 0.f;
#pragma unroll
            for (int rr = 0; rr < 16; ++rr) { p0[rr] = __builtin_amdgcn_exp2f(p0[rr]); p1[rr] = __builtin_amdgcn_exp2f(p1[rr]); sacc += p0[rr] + p1[rr]; }
            l_reg += sacc;
            const u32x4 pw0 = (u32x4){cvtpk_s(p0[0], p0[1]), cvtpk_s(p0[2], p0[3]), cvtpk_s(p0[4], p0[5]), cvtpk_s(p0[6], p0[7])};
            const u32x4 pw1 = (u32x4){cvtpk_s(p0[8], p0[9]), cvtpk_s(p0[10], p0[11]), cvtpk_s(p0[12], p0[13]), cvtpk_s(p0[14], p0[15])};
            const u32x4 pw2 = (u32x4){cvtpk_s(p1[0], p1[1]), cvtpk_s(p1[2], p1[3]), cvtpk_s(p1[4], p1[5]), cvtpk_s(p1[6], p1[7])};
            const u32x4 pw3 = (u32x4){cvtpk_s(p1[8], p1[9]), cvtpk_s(p1[10], p1[11]), cvtpk_s(p1[12], p1[13]), cvtpk_s(p1[14], p1[15])};
            ATT_SBAR();
            pv2(o, vbA, vbB, __builtin_bit_cast(bf16x8, pw0), __builtin_bit_cast(bf16x8, pw1), __builtin_bit_cast(bf16x8, pw2), __builtin_bit_cast(bf16x8, pw3));
        }
    }
#undef ATT_BODY
#undef ATT_SOFTMAX_PV
#undef ATT_EXP
#undef ATT_DMA
    l_reg += __shfl_xor(l_reg, 32);
    if (hi == 0) wsf[32 + r32] = l_reg;
    asm volatile("s_waitcnt lgkmcnt(0)" ::: "memory");
    float rli[16];
#pragma unroll
    for (int rr = 0; rr < 16; ++rr) rli[rr] = 1.0f / wsf[32 + crow(rr, hi)];
    { LAS unsigned short* stg = (LAS unsigned short*)(shm + L_OST) + wid * 2048;
#pragma unroll
      for (int rr = 0; rr < 16; ++rr) { const int orow = crow(rr, hi);
#pragma unroll
          for (int d0 = 0; d0 < 2; ++d0) stg[orow * 64 + d0 * 32 + r32] = (unsigned short)f2bf(o[d0][rr] * rli[rr]); }
      asm volatile("s_waitcnt lgkmcnt(0)" ::: "memory");
#pragma unroll
      for (int i4 = 0; i4 < 4; ++i4) { const int row = i4 * 8 + (lane >> 3), ch = lane & 7; const u32x4 v = *(LAS const u32x4*)(stg + row * 64 + ch * 8);
          const long grow = pol.orow(wid, row);
          *(u32x4*)(Oc + grow * D + ch * 8) = v;
          float ss = 0.f;
#pragma unroll
          for (int e = 0; e < 4; ++e) { const float a = __uint_as_float(v[e] << 16), c = __uint_as_float(v[e] & 0xffff0000u); ss += a * a + c * c; }
          ss += __shfl_xor(ss, 1); ss += __shfl_xor(ss, 2); ss += __shfl_xor(ss, 4);
          if (ch == 0) ssq[grow * 16 + hh] = ss; } }
    asm volatile("s_waitcnt vmcnt(0) lgkmcnt(0)\n\ts_barrier" ::: "memory");
}


constexpr int M_NSLOT = 3;
constexpr int M_K = 0, M_V = M_NSLOT * SLOTB;
static_assert(2 * M_NSLOT * SLOTB <= L_WS, "MoBA rings fit in front of the per-wave scratch");
__device__ __forceinline__ void kload8(bf16x8* kf, lds_cptr kp) {
    kf[0] = *(LAS const bf16x8*)(kp);        kf[1] = *(LAS const bf16x8*)(kp + 512);
    kf[2] = *(LAS const bf16x8*)(kp + 2048); kf[3] = *(LAS const bf16x8*)(kp + 2560);
    kf[4] = *(LAS const bf16x8*)(kp + 4096); kf[5] = *(LAS const bf16x8*)(kp + 4608);
    kf[6] = *(LAS const bf16x8*)(kp + 6144); kf[7] = *(LAS const bf16x8*)(kp + 6656);
}
__device__ __forceinline__ void kload2(bf16x8* kf, lds_cptr kp, int j) { kf[2 * j] = *(LAS const bf16x8*)(kp + j * 2048); kf[2 * j + 1] = *(LAS const bf16x8*)(kp + j * 2048 + 512); }
__device__ __forceinline__ s16x4 vtr(lds_cptr p) { return __builtin_bit_cast(s16x4, __builtin_amdgcn_ds_read_tr16_b64_v4i16((LAS v4i16_t*)p)); }

__device__ __forceinline__ void attn_unit_moba(PolB& pol, const bf16* Qc, const bf16* Kc, const bf16* Vc, bf16* Oc, float* ssq, int hh, LAS unsigned char* shm, LAS const float* km) {
    int tid = threadIdx.x; asm volatile("" : "+v"(tid)); const int lane = tid & 63, r32 = lane & 31, hi = lane >> 5; const int wid = __builtin_amdgcn_readfirstlane(tid >> 6);
    const unsigned lds0 = (unsigned)(uintptr_t)shm;
    LAS float* wsf = (LAS float*)(shm + L_WS) + wid * 64;
    const int NT = pol.NT;
    const bf16* ksrc = Kc + ((long)pol.b * SEQ + lane) * D + wid * 8;
    const bf16* vsrc = Vc + ((long)pol.b * SEQ + 16 * (wid & 3) + (lane >> 2)) * D + (wid >> 2) * 32 + (lane & 3) * 8;
    const unsigned kdst = lds0 + M_K + wid * 1024, vdst = lds0 + M_V + wid * 1024;
#define DMA_K(t, slot) glds16(ksrc + (long)(t) * 64 * D, (unsigned)__builtin_amdgcn_readfirstlane(kdst + (slot)))
#define DMA_V(t, slot) glds16(vsrc + (long)(t) * 64 * D, (unsigned)__builtin_amdgcn_readfirstlane(vdst + (slot)))
    bf16x8 qr[4];
    { const bf16* qp = Qc + pol.qrow(wid, r32) * D + hi * 8;
#pragma unroll
      for (int d0 = 0; d0 < 4; ++d0) qr[d0] = *(const bf16x8*)(qp + d0 * 16); }
    DMA_K(0, 0); DMA_V(0, 0); DMA_K(1, SLOTB); DMA_K(2, 2 * SLOTB);
    pol.select(qr, km);
    const lds_cptr shm3 = (lds_cptr)shm; const lds_cptr kp0 = shm3 + M_K + hi * 1024 + r32 * 16; const lds_cptr vp0 = shm3 + M_V + ((lane >> 4) & 1) * 32 + (lane & 3) * 8 + (4 * hi + ((lane & 15) >> 2)) * 64;
    f32x16 o[2]; o[0] = f32x16{}; o[1] = f32x16{}; float l_reg = 0.f;
    bf16x8 kf[8];
    f32x16 pA0, pA1, pB0, pB1;
    int sl_prev = 0, sl_cur = 0, sl_next = SLOTB;
#define ROT() do { sl_prev = sl_cur; sl_cur = sl_next; sl_next = (sl_next == (M_NSLOT - 1) * SLOTB) ? 0 : sl_next + SLOTB; } while (0)
    const float sl2 = pol.sl2, s8 = 8.0f * pol.sl2; const int dq0 = pol.dq0; const unsigned sel = pol.sel; const int i4 = 4 * pol.i;
#define CBASE(tt) const int dqi_ = 64 * (tt) + dq0; float cb0_ = sl2 * (float)dqi_; if (!((sel >> ((tt) >> 2)) & 1u)) cb0_ = ATT_NEG; float cb1_ = cb0_ + 32.0f * sl2
#define CEL(X, B, cb, off, BAND) do { float v0_ = (cb), v1_ = v0_ + sl2, v2_ = v1_ + sl2, v3_ = v2_ + sl2; (cb) = v0_ + s8; \
        if (BAND) { const int c_ = 8 * ((B) >> 2) + (off); if (dqi_ + c_ > 0) v0_ = ATT_NEG; if (dqi_ + c_ + 1 > 0) v1_ = ATT_NEG; if (dqi_ + c_ + 2 > 0) v2_ = ATT_NEG; if (dqi_ + c_ + 3 > 0) v3_ = ATT_NEG; } \
        X[(B)] = v0_; X[(B) + 1] = v1_; X[(B) + 2] = v2_; X[(B) + 3] = v3_; } while (0)
    asm volatile("s_waitcnt vmcnt(3) lgkmcnt(0)\n\ts_barrier" ::: "memory");
    { CBASE(0); const bool band0 = (i4 == 0);
#pragma unroll
      for (int b4 = 0; b4 < 16; b4 += 4) { if (band0) { CEL(pA0, b4, cb0_, 0, true); CEL(pA1, b4, cb1_, 32, true); } else { CEL(pA0, b4, cb0_, 0, false); CEL(pA1, b4, cb1_, 32, false); } }
      qkt(pA0, pA1, kp0, qr);
#pragma unroll
      for (int rr = 0; rr < 16; ++rr) { pA0[rr] = __builtin_amdgcn_exp2f(pA0[rr]); pA1[rr] = __builtin_amdgcn_exp2f(pA1[rr]); } }
    { CBASE(1); const bool band1 = (1 >= i4);
#pragma unroll
      for (int b4 = 0; b4 < 16; b4 += 4) { if (band1) { CEL(pB0, b4, cb0_, 0, true); CEL(pB1, b4, cb1_, 32, true); } else { CEL(pB0, b4, cb0_, 0, false); CEL(pB1, b4, cb1_, 32, false); } } }
    asm volatile("s_waitcnt vmcnt(0) lgkmcnt(0)\n\ts_barrier" ::: "memory");
    DMA_K(3, 0); DMA_V(1, SLOTB);
    ROT();
    kload8(kf, kp0 + sl_cur);
    asm volatile("s_waitcnt vmcnt(2) lgkmcnt(0)\n\ts_barrier" ::: "memory");
    s16x4 vlo[8], vhi[8]; u32x4 pw0, pw1, pw2, pw3;
#define PKW(P, B) cvtpk_s(P[B], P[B + 1])
#define PAF(k) __builtin_bit_cast(bf16x8, pw##k)
#define VFR(i) (bf16x8){vlo[i][0], vlo[i][1], vlo[i][2], vlo[i][3], vhi[i][0], vhi[i][1], vhi[i][2], vhi[i][3]}
#define PIN(x) asm volatile("" : "+v"(x))
#define GAPA(MF, A0, A1, A2, A3, W0, W1, PW) do { MF; sacc += A0; sacc += A1; sacc += A2; sacc += A3; PIN(sacc); W0; W1; PIN(PW); ATT_SBAR(); } while (0)
#define EX(v) __builtin_amdgcn_exp2f(v)
#define GAPB(MF, X, B, Y, CB_, OFF_, CI, BAND) do { MF; X[B] = EX(X[B]); X[B + 1] = EX(X[B + 1]); X[B + 2] = EX(X[B + 2]); X[B + 3] = EX(X[B + 3]); PIN(X); if (CI) { CEL(Y, B, CB_, OFF_, BAND); PIN(Y); } ATT_SBAR(); } while (0)
#define VRD(i) do { vlo[i] = vtr(vp_ + (((i) >> 2) * 4096 + ((i) & 3) * 1024)); vhi[i] = vtr(vp_ + (((i) >> 2) * 4096 + ((i) & 3) * 1024 + 512)); } while (0)
#define KRD(G, j) do { if (G) { kload2(kf, kp0 + sl_next, j); ATT_SBAR(); } } while (0)
#define STEP(C0, C1, P0, P1, t, GK, GV, GL, CI, BAND) do { ATT_SBAR(); \
    const lds_cptr vp_ = vp0 + sl_prev; CBASE((t) + 1); \
    VRD(0); ATT_SBAR(); float sacc = (P0[0] + P0[1]); \
    GAPA(C0 = __builtin_amdgcn_mfma_f32_32x32x16_bf16(kf[0], qr[0], C0, 0, 0, 0), P0[2], P0[3], P0[4], P0[5],     pw0[0] = PKW(P0, 0), pw0[1] = PKW(P0, 2), pw0); \
    VRD(4); ATT_SBAR(); GAPA(C1 = __builtin_amdgcn_mfma_f32_32x32x16_bf16(kf[1], qr[0], C1, 0, 0, 0), P0[6], P0[7], P0[8], P0[9],     pw0[2] = PKW(P0, 4), pw0[3] = PKW(P0, 6), pw0); \
    VRD(1); ATT_SBAR(); GAPA(C0 = __builtin_amdgcn_mfma_f32_32x32x16_bf16(kf[2], qr[1], C0, 0, 0, 0), P0[10], P0[11], P0[12], P0[13], pw1[0] = PKW(P0, 8), pw1[1] = PKW(P0, 10), pw1); \
    VRD(5); ATT_SBAR(); GAPA(C1 = __builtin_amdgcn_mfma_f32_32x32x16_bf16(kf[3], qr[1], C1, 0, 0, 0), P0[14], P0[15], P1[0], P1[1],   pw1[2] = PKW(P0, 12), pw1[3] = PKW(P0, 14), pw1); \
    VRD(2); ATT_SBAR(); GAPA(C0 = __builtin_amdgcn_mfma_f32_32x32x16_bf16(kf[4], qr[2], C0, 0, 0, 0), P1[2], P1[3], P1[4], P1[5],     pw2[0] = PKW(P1, 0), pw2[1] = PKW(P1, 2), pw2); \
    VRD(6); ATT_SBAR(); GAPA(C1 = __builtin_amdgcn_mfma_f32_32x32x16_bf16(kf[5], qr[2], C1, 0, 0, 0), P1[6], P1[7], P1[8], P1[9],     pw2[2] = PKW(P1, 4), pw2[3] = PKW(P1, 6), pw2); \
    VRD(3); ATT_SBAR(); GAPA(C0 = __builtin_amdgcn_mfma_f32_32x32x16_bf16(kf[6], qr[3], C0, 0, 0, 0), P1[10], P1[11], P1[12], P1[13], pw3[0] = PKW(P1, 8), pw3[1] = PKW(P1, 10), pw3); \
    VRD(7); ATT_SBAR(); GAPA(C1 = __builtin_amdgcn_mfma_f32_32x32x16_bf16(kf[7], qr[3], C1, 0, 0, 0), P1[14], P1[15], 0.f, 0.f,       pw3[2] = PKW(P1, 12), pw3[3] = PKW(P1, 14), pw3); \
    l_reg += sacc; \
    if (GK) { DMA_K((t) + 3, sl_cur); } if (GV) { DMA_V((t) + 1, sl_next); } \
    ATT_SBAR(); \
    GAPB(o[0] = __builtin_amdgcn_mfma_f32_32x32x16_bf16(PAF(0), VFR(0), o[0], 0, 0, 0), C0, 0, P0, cb0_, 0, CI, BAND); \
    GAPB(o[1] = __builtin_amdgcn_mfma_f32_32x32x16_bf16(PAF(0), VFR(4), o[1], 0, 0, 0), C0, 4, P0, cb0_, 0, CI, BAND); \
    KRD(GL, 0); GAPB(o[0] = __builtin_amdgcn_mfma_f32_32x32x16_bf16(PAF(1), VFR(1), o[0], 0, 0, 0), C0, 8, P0, cb0_, 0, CI, BAND); \
    KRD(GL, 1); GAPB(o[1] = __builtin_amdgcn_mfma_f32_32x32x16_bf16(PAF(1), VFR(5), o[1], 0, 0, 0), C0, 12, P0, cb0_, 0, CI, BAND); \
    KRD(GL, 2); GAPB(o[0] = __builtin_amdgcn_mfma_f32_32x32x16_bf16(PAF(2), VFR(2), o[0], 0, 0, 0), C1, 0, P1, cb1_, 32, CI, BAND); \
    KRD(GL, 3); GAPB(o[1] = __builtin_amdgcn_mfma_f32_32x32x16_bf16(PAF(2), VFR(6), o[1], 0, 0, 0), C1, 4, P1, cb1_, 32, CI, BAND); \
    GAPB(o[0] = __builtin_amdgcn_mfma_f32_32x32x16_bf16(PAF(3), VFR(3), o[0], 0, 0, 0), C1, 8, P1, cb1_, 32, CI, BAND); \
    GAPB(o[1] = __builtin_amdgcn_mfma_f32_32x32x16_bf16(PAF(3), VFR(7), o[1], 0, 0, 0), C1, 12, P1, cb1_, 32, CI, BAND); \
    } while (0)
#define M_WAIT_BAR(N) asm volatile("s_waitcnt vmcnt(" #N ") lgkmcnt(0)\n\ts_barrier" ::: "memory")
    int t = 1;
    for (; t + 5 < NT; t += 2) {
        STEP(pB0, pB1, pA0, pA1, t, true, true, true, true, false);     M_WAIT_BAR(2); ROT();
        STEP(pA0, pA1, pB0, pB1, t + 1, true, true, true, true, false); M_WAIT_BAR(2); ROT();
    }
#define ENDW(tt) do { if ((tt) + 3 < NT) { M_WAIT_BAR(2); } else if ((tt) + 2 < NT) { M_WAIT_BAR(1); } else { M_WAIT_BAR(0); } } while (0)
    for (; t + 1 < NT; t += 2) {
        STEP(pB0, pB1, pA0, pA1, t, (t + 3 < NT), (t + 1 < NT), (t + 1 < NT), true, true);       ENDW(t);     ROT();
        STEP(pA0, pA1, pB0, pB1, t + 1, (t + 4 < NT), (t + 2 < NT), (t + 2 < NT), (t + 2 < NT), true); ENDW(t + 1); ROT();
    }
    STEP(pB0, pB1, pA0, pA1, NT - 1, false, false, false, false, false);
    { float sacc = pB0[0] + pB0[1];
#pragma unroll
      for (int rr = 2; rr < 16; ++rr) sacc += pB0[rr];
#pragma unroll
      for (int rr = 0; rr < 16; ++rr) sacc += pB1[rr];
      l_reg += sacc;
      pw0 = (u32x4){PKW(pB0, 0), PKW(pB0, 2), PKW(pB0, 4), PKW(pB0, 6)}; pw1 = (u32x4){PKW(pB0, 8), PKW(pB0, 10), PKW(pB0, 12), PKW(pB0, 14)};
      pw2 = (u32x4){PKW(pB1, 0), PKW(pB1, 2), PKW(pB1, 4), PKW(pB1, 6)}; pw3 = (u32x4){PKW(pB1, 8), PKW(pB1, 10), PKW(pB1, 12), PKW(pB1, 14)};
      ATT_SBAR(); pv(o, (int)(lds0 + M_V) + ((lane >> 4) & 1) * 32 + (lane & 3) * 8 + (4 * hi + ((lane & 15) >> 2)) * 64 + sl_cur, PAF(0), PAF(1), PAF(2), PAF(3)); }
#undef PKW
#undef PAF
#undef VFR
#undef PIN
#undef GAPA
#undef GAPB
#undef EX
#undef VRD
#undef KRD
#undef STEP
#undef ENDW
#undef M_WAIT_BAR
#undef CBASE
#undef CEL
#undef ROT
#undef DMA_K
#undef DMA_V
    l_reg += __shfl_xor(l_reg, 32);
    if (hi == 0) wsf[32 + r32] = l_reg;
    asm volatile("s_waitcnt lgkmcnt(0)" ::: "memory");
    float rli[16];
#pragma unroll
    for (int rr = 0; rr < 16; ++rr) rli[rr] = 1.0f / wsf[32 + crow(rr, hi)];
    { LAS unsigned short* stg = (LAS unsigned short*)(shm + L_OST) + wid * 2048;
#pragma unroll
      for (int rr = 0; rr < 16; ++rr) { const int orow = crow(rr, hi);
#pragma unroll
          for (int d0 = 0; d0 < 2; ++d0) stg[orow * 64 + d0 * 32 + r32] = (unsigned short)f2bf(o[d0][rr] * rli[rr]); }
      asm volatile("s_waitcnt lgkmcnt(0)" ::: "memory");
#pragma unroll
      for (int i4_ = 0; i4_ < 4; ++i4_) { const int row = i4_ * 8 + (lane >> 3), ch = lane & 7; const u32x4 v = *(LAS const u32x4*)(stg + row * 64 + ch * 8);
          const long grow = pol.orow(wid, row);
          *(u32x4*)(Oc + grow * D + ch * 8) = v;
          float ss = 0.f;
#pragma unroll
          for (int e = 0; e < 4; ++e) { const float a = __uint_as_float(v[e] << 16), c = __uint_as_float(v[e] & 0xffff0000u); ss += a * a + c * c; }
          ss += __shfl_xor(ss, 1); ss += __shfl_xor(ss, 2); ss += __shfl_xor(ss, 4);
          if (ch == 0) ssq[grow * 16 + hh] = ss; } }
    asm volatile("s_waitcnt vmcnt(0) lgkmcnt(0)\n\ts_barrier" ::: "memory");
}

__device__ __forceinline__ void attn_phase(Frame& F) {
    LAS unsigned char* shm = F.lds + RING_OFF;
    LAS float* tab = (LAS float*)(shm + L_TAB);
    int tid_a = threadIdx.x; asm volatile("" : "+v"(tid_a)); const int r32 = tid_a & 31, hi = (tid_a >> 5) & 1;
    for (int su = F.vcu; su < 256; su += F.G) {
        const int b = su >> 5, h = (su >> 2) & 7, r = su & 3;
        fill_tab_A(tab, h, r, F.tid);
        asm volatile("s_waitcnt lgkmcnt(0)\n\ts_barrier" ::: "memory");
        for (int Tb = 0; Tb < 4; ++Tb) { PolA pol; pol.init(b, r, Tb, F.wave, r32, hi, tab);
            attn_unit<PolA, false>(pol, F.QB + h * 64, F.KB + h * 64, F.VB + h * 64, F.OB + h * 64, F.ssq0, h, shm, nullptr); }
    }
    for (int su = F.vcu; su < 256; su += F.G) {
        const int b = su >> 5, h = (su >> 2) & 7, qt = su & 3;
        for (int idx = F.tid; idx < 1024; idx += NWAVES * 64) { const int n = idx >> 6, d = idx & 63; const float* kp = F.kpart + (size_t)((b * 16 + n) * 2) * 512 + h * 64 + d; tab[idx] = kp[0] + kp[512]; }
        asm volatile("s_waitcnt vmcnt(0) lgkmcnt(0)\n\ts_barrier" ::: "memory");
        for (int u4 = 0; u4 < 4; ++u4) { const int s = 2 * qt + (u4 >> 1); const int i = (u4 & 1) ? 15 - s : s;
            PolB pol; pol.b = b; pol.i = i; pol.NT = 4 * (i + 1); pol.hi = hi; pol.dq0 = 4 * hi - (256 * i + 32 * F.wave + r32); pol.sl2 = exp2f(-(float)(h + 1)) * LOG2E; pol.sel = 0u;
            attn_unit_moba(pol, F.QB + 512 + h * 64, F.KB + 512 + h * 64, F.VB + 512 + h * 64, F.OB + 512 + h * 64, F.ssq0, 8 + h, shm, tab); }
    }
}
#undef ATT_WAIT_BAR
#undef ATT_SBAR
}

__device__ __forceinline__ void final_norm(Frame& F) {
    int tid_f = threadIdx.x; asm volatile("" : "+v"(tid_f)); const int lane_f = tid_f & 63;
    const int gw = F.vcu * NWAVES + F.wave, NGW = F.G * NWAVES;
    f32x4 g[2][2];
#pragma unroll
    for (int j = 0; j < 2; ++j) { g[j][0] = *(const GAS f32x4*)(F.g_final + 512 * j + 8 * lane_f); g[j][1] = *(const GAS f32x4*)(F.g_final + 512 * j + 8 * lane_f + 4); }
    for (int m = gw; m < M; m += NGW) {
        const GAS f32x4* sp = (const GAS f32x4*)(F.ssq3 + (size_t)m * 16);
        const f32x4 a = sp[0], b = sp[1], c = sp[2], d = sp[3];
        const float s = ((a.x + a.y) + (a.z + a.w)) + ((b.x + b.y) + (b.z + b.w)) + ((c.x + c.y) + (c.z + c.w)) + ((d.x + d.y) + (d.z + d.w));
        const float rstd = 1.f / sqrtf(s * (1.f / D) + EPS);
#pragma unroll
        for (int j = 0; j < 2; ++j) { const v4u w = *(const GAS v4u*)(F.XN + (size_t)m * D + 512 * j + 8 * lane_f);
            f32x4 o0 = (f32x4){__uint_as_float(w.x << 16), __uint_as_float(w.x & 0xffff0000u), __uint_as_float(w.y << 16), __uint_as_float(w.y & 0xffff0000u)};
            f32x4 o1 = (f32x4){__uint_as_float(w.z << 16), __uint_as_float(w.z & 0xffff0000u), __uint_as_float(w.w << 16), __uint_as_float(w.w & 0xffff0000u)};
            GAS f32x4* op = (GAS f32x4*)(F.out + (size_t)m * D + 512 * j + 8 * lane_f);
            op[0] = o0 * rstd * g[j][0]; op[1] = o1 * rstd * g[j][1]; }
    }
}

struct Args { const float* in[15]; float* out; unsigned char* ws; int ph_lo, ph_hi, li, pad; };
__global__ void __launch_bounds__(NWAVES * 64, 2) mk_fwd(Args args) {
    extern __shared__ __attribute__((aligned(16))) unsigned char lds[];
    Frame F;
    F.lds = (LAS unsigned char*)lds;
    F.MISC = (volatile LAS unsigned*)(F.lds + MISC_OFF);
    F.tid = threadIdx.x; F.lane = F.tid & 63; F.wave = __builtin_amdgcn_readfirstlane(F.tid >> 6);
    F.G = gridDim.x; { const int bx = blockIdx.x; F.vcu = (F.G % 8 == 0) ? (bx % 8) * (F.G / 8) + bx / 8 : bx; }
    unsigned char* ws = args.ws;
    F.ctl = (gu32*)(ws + WS_CTL);
    F.x = args.in[0]; F.p = args.in[1]; F.g_attn = args.in[2]; F.w_in = args.in[3]; F.g_out_a = args.in[4]; F.g_out_b = args.in[5]; F.w_out = args.in[6]; F.g_mlp = args.in[7];
    F.w_up = args.in[8]; F.w_down = args.in[9]; F.g_ple = args.in[10]; F.w_gate = args.in[11]; F.b_gate = args.in[12]; F.w_proj = args.in[13]; F.g_final = args.in[14]; F.out = args.out;
    F.Wqkv_t = (bf16*)(ws + WS_WQKV); F.Wo_t = (bf16*)(ws + WS_WO); F.Wup_t = (bf16*)(ws + WS_WUP); F.Wdn_t = (bf16*)(ws + WS_WDN); F.Wg_t = (bf16*)(ws + WS_WG); F.Wp_t = (bf16*)(ws + WS_WP);
    F.XN = (bf16*)(ws + WS_XN); F.QB = (bf16*)(ws + WS_Q); F.KB = (bf16*)(ws + WS_K); F.VB = (bf16*)(ws + WS_V); F.OB = (bf16*)(ws + WS_O); F.UB = (bf16*)(ws + WS_U); F.PB = (bf16*)(ws + WS_PB); F.PP = (bf16*)(ws + WS_PP);
    F.ssq0 = (float*)(ws + WS_SSQ0); F.ssq1 = (float*)(ws + WS_SSQ1); F.ssq2 = (float*)(ws + WS_SSQ2); F.ssq3 = (float*)(ws + WS_SSQ3); F.kpart = (float*)(ws + WS_KPART);
    for (int u = F.tid; u < (LDS_BYTES - LDSCTL_OFF) / 4; u += NWAVES * 64) ((LAS unsigned*)(F.lds + LDSCTL_OFF))[u] = 0u;
    __syncthreads();
    XcdBarrier bar; bar.bar = (unsigned*)(F.ctl + CW_BAR); bar.x = 0; bar.st = nullptr;
    if (N_LAUNCHES == 1) bar = xcd_barrier_post((unsigned*)(F.ctl + CW_BAR), F.MISC + 8);
    PG8_LAS float* tab = (PG8_LAS float*)(F.lds + TAB_OFF);
    const int lo = args.ph_lo, hi = args.ph_hi;
#define IN(k) (lo <= (k) && (k) < hi)
#define SEAM(k) do { if (IN(k) && IN((k) + 1)) xcd_barrier(bar); } while (0)

    if (IN(0)) { p0_prologue(F); SEAM(0); }
    if (IN(1)) {
        { pg8::Gemm g{F.XN, F.Wqkv_t, M, NQKV, D}; pg8::StaticOrder S; S.init(M, NQKV, F.G, (int)blockIdx.x);
          pg8::EpiQKV E{F.QB, (size_t)(WS_K - WS_Q) / 2, F.kpart, C2};
          pg8::gemm_phase<pg8::EpiQKV, pg8::StaticOrder, true, true>(F.lds + RING_OFF, tab, g, S, E); }
        { pg8::Gemm g{F.PB, F.Wp_t, M, D, PLE}; pg8::StaticOrder S; S.init(M, D, F.G, (int)blockIdx.x);
          pg8::EpiBf16Plain E{F.PP, D};
          pg8::gemm_phase<pg8::EpiBf16Plain, pg8::StaticOrder, true, true>(F.lds + RING_OFF, tab, g, S, E); }
        SEAM(1);
    }
#if defined(ATT_NAIVE)
    if (IN(2)) { attn_naive(F); SEAM(2); }
#else
    if (IN(2)) { att::attn_phase(F); SEAM(2); }
#endif
    if (IN(3)) {
        pg8::Gemm g{F.OB, F.Wo_t, M, D, D}; pg8::StaticOrder S; S.init(M, D, F.G, (int)blockIdx.x);
        pg8::EpiRes<1> E{F.x, F.XN, F.ssq1, F.ssq0};
        pg8::gemm_phase<pg8::EpiRes<1>, pg8::StaticOrder, true, true>(F.lds + RING_OFF, tab, g, S, E);
        SEAM(3);
    }
    if (IN(4)) {
        pg8::Gemm g{F.XN, F.Wup_t, M, FF, D}; pg8::StaticOrder S; S.init(M, FF, F.G, (int)blockIdx.x);
        pg8::EpiUp E{F.UB, FF, F.ssq1};
        pg8::gemm_phase<pg8::EpiUp, pg8::StaticOrder, true, true>(F.lds + RING_OFF, tab, g, S, E);
        SEAM(4);
    }
    if (IN(5)) {
        pg8::Gemm g{F.UB, F.Wdn_t, M, D, FF}; pg8::StaticOrder S; S.init(M, D, F.G, (int)blockIdx.x);
        pg8::EpiRes<0> E{nullptr, F.XN, F.ssq2, nullptr};
        pg8::gemm_phase<pg8::EpiRes<0>, pg8::StaticOrder, true, true>(F.lds + RING_OFF, tab, g, S, E);
        SEAM(5);
    }
    if (IN(6)) {
        pg8::Gemm g{F.XN, F.Wg_t, M, D, D}; pg8::StaticOrder S; S.init(M, D, F.G, (int)blockIdx.x);
        pg8::EpiGate E{F.XN, F.PP, F.b_gate, F.ssq3, F.ssq2};
        pg8::gemm_phase<pg8::EpiGate, pg8::StaticOrder, true, true>(F.lds + RING_OFF, tab, g, S, E);
        SEAM(6);
    }
    if (IN(7)) { final_norm(F); }
#undef IN
#undef SEAM
}

extern "C" void kernel_launch(void* const* d_in, const int* in_sizes, int n_in, void* d_out, int out_size, void* d_ws, size_t ws_size, hipStream_t stream) {
    static int grid = 0;
    if (grid == 0) {
        if (n_in != 15 || in_sizes[0] != M * D || out_size != M * D || ws_size < WS_END) { fprintf(stderr, "kernel_launch: unexpected shapes (n_in %d, in0 %d, out %d, ws %zu); nothing launched\n", n_in, n_in > 0 ? in_sizes[0] : -1, out_size, ws_size); grid = -1; return; }
        int dev = 0, cus = 0, per_cu = 0;
        if (hipGetDevice(&dev) != hipSuccess || hipDeviceGetAttribute(&cus, hipDeviceAttributeMultiprocessorCount, dev) != hipSuccess) { grid = -1; return; }
        if (hipFuncSetAttribute((const void*)mk_fwd, hipFuncAttributeMaxDynamicSharedMemorySize, LDS_BYTES) != hipSuccess) { fprintf(stderr, "kernel_launch: hipFuncSetAttribute failed\n"); grid = -1; return; }
        if (hipOccupancyMaxActiveBlocksPerMultiprocessor(&per_cu, (const void*)mk_fwd, NWAVES * 64, LDS_BYTES) != hipSuccess || per_cu < 1) { fprintf(stderr, "kernel_launch: occupancy query reports %d blocks per CU\n", per_cu); }
        (void)hipGetLastError();
        grid = cus;
    }
    if (grid < 0) return;
    if (hipMemsetAsync((char*)d_ws + WS_CTL, 0, CTL_ZERO_BYTES, stream) != hipSuccess) { fprintf(stderr, "kernel_launch: hipMemsetAsync failed\n"); return; }
    Args a{};
    for (int i = 0; i < 15; ++i) a.in[i] = (const float*)d_in[i];
    a.out = (float*)d_out; a.ws = (unsigned char*)d_ws;
    for (int li = 0; li < N_LAUNCHES; ++li) {
        a.ph_lo = (N_LAUNCHES == 1) ? 0 : li; a.ph_hi = (N_LAUNCHES == 1) ? NPHASE : li + 1; a.li = li;
        hipLaunchKernelGGL(mk_fwd, dim3(grid), dim3(NWAVES * 64), LDS_BYTES, stream, a);
        const hipError_t le = hipPeekAtLastError();
        if (le != hipSuccess) { fprintf(stderr, "kernel_launch: launch %d failed: %s\n", li, hipGetErrorName(le)); break; }
    }
}
```

```cpp
#include <hip/hip_runtime.h>
#include <cstdio>
#include <cstdint>
namespace pg8 {
#define PG8_LAS __attribute__((address_space(3)))
typedef unsigned short bf16_t;
typedef short bf16x8 __attribute__((ext_vector_type(8)));
typedef float f32x4 __attribute__((ext_vector_type(4)));
typedef unsigned u32x4 __attribute__((ext_vector_type(4)));
constexpr int BM = 256, BK = 64, HALF = 128, HTB = HALF * BK * 2  , STAGE_BYTES = 8 * HTB, NXCD = 8, WGM = 8;

__host__ __device__ __forceinline__ int lds_byte(int r, int c) { const int st = (r >> 4) * 2 + (c >> 5), rr = r & 15, cc = c & 31, ob = rr * 64 + cc * 2; return st * 1024 + (ob ^ (((ob >> 9) & 1) << 5)); }
__host__ __device__ __forceinline__ void stage_rc(int b, int& R, int& C) { const int st = b / 1024, sb = b % 1024, swz = sb ^ (((sb >> 9) & 1) << 5); R = (st >> 1) * 16 + swz / 64; C = (st & 1) * 32 + (swz % 64) / 2; }
__host__ __device__ __forceinline__ int perm32(int rho) { const int n = rho >> 4, i = rho & 15; return 8 * (i >> 2) + 4 * n + (i & 3); }

struct Unit { int pm, pn; };
struct Gemm { const bf16_t* A; const bf16_t* Bt; int M, N, K; };

struct StaticOrder {
    int nM, nN, nwg, G, c;
    __host__ __device__ void init(int M, int N, int G_, int c_) { nM = M / BM; nN = N / BM; nwg = nM * nN; G = G_; c = c_; }
    __host__ __device__ bool next(int i, Unit& u) const {
        const long L = (long)i * G + c; if (L >= nwg) return false;
        int wgid = (int)L; { const int q = nwg / NXCD, r = nwg % NXCD, xcd = wgid % NXCD, off = wgid / NXCD; wgid = (xcd < r ? xcd * (q + 1) : r * (q + 1) + (xcd - r) * q) + off; }
        const int nig = WGM * nN, gid = wgid / nig, fm = gid * WGM, gsz = (nM - fm) < WGM ? (nM - fm) : WGM;
        u.pm = fm + ((wgid % nig) % gsz); u.pn = (wgid % nig) / gsz; return true;
    }
    __device__ __forceinline__ void a_ready(const Unit&) const {}
    __device__ __forceinline__ void done(const Unit&) const {}
};

__device__ __forceinline__ unsigned cvt_pk_bf16(float lo, float hi) { unsigned r; asm volatile("v_cvt_pk_bf16_f32 %0, %1, %2" : "=v"(r) : "v"(lo), "v"(hi)); return r; }
typedef unsigned u32x2 __attribute__((ext_vector_type(2)));
constexpr float RMS_EPS = 1e-6f;
__device__ __forceinline__ float sum4(f32x4 v) { return (v[0] + v[1]) + (v[2] + v[3]); }

struct EpiBf16Plain {
    static constexpr bool PERM = true, AFTER_DRAIN = false, MID = false, TABLE = false;
    bf16_t* O; int ldc;
    __device__ __forceinline__ void operator()(f32x4 (&acc)[2][2][4][2], const Unit& u, int wr, int wc, int fr, int fq, PG8_LAS float*, int) const {
        const int row0 = u.pm * BM + wr * 64 + fr, col0 = u.pn * BM + wc * 32 + 8 * fq;
#pragma unroll
        for (int ai = 0; ai < 2; ++ai)
#pragma unroll
            for (int m = 0; m < 4; ++m) { bf16_t* rowp = O + (size_t)(row0 + ai * HALF + m * 16) * ldc + col0;
#pragma unroll
                for (int bj = 0; bj < 2; ++bj) { const f32x4 v0 = acc[ai][bj][m][0], v1 = acc[ai][bj][m][1];
                    u32x4 w; w.x = cvt_pk_bf16(v0[0], v0[1]); w.y = cvt_pk_bf16(v0[2], v0[3]); w.z = cvt_pk_bf16(v1[0], v1[1]); w.w = cvt_pk_bf16(v1[2], v1[3]);
                    *(u32x4*)(rowp + bj * HALF) = w; } }
    }
};

struct EpiQKV {
    static constexpr bool PERM = true, AFTER_DRAIN = false, MID = false, TABLE = false;
    bf16_t* Q; size_t part_stride; float* kpart; float qscale;
    __device__ __forceinline__ void operator()(f32x4 (&acc)[2][2][4][2], const Unit& u, int wr, int wc, int fr, int fq, PG8_LAS float*, int) const {
        const int part = u.pn >> 2, pc = u.pn & 3; const bool ga = pc < 2;
        bf16_t* base = Q + (size_t)part * part_stride; const float sc = part == 0 ? qscale : 1.0f;
        const int row0 = u.pm * BM + wr * 64 + fr, col0 = pc * BM + wc * 32 + 8 * fq;
#pragma unroll
        for (int ai = 0; ai < 2; ++ai)
#pragma unroll
            for (int m = 0; m < 4; ++m) { const int row = row0 + ai * HALF + m * 16;
                const int rowd = ga ? ((row & ~4095) | ((row & 3) << 10) | ((row & 4095) >> 2)) : row;
                bf16_t* rowp = base + (size_t)rowd * 1024 + col0;
#pragma unroll
                for (int bj = 0; bj < 2; ++bj) { const f32x4 v0 = acc[ai][bj][m][0] * sc, v1 = acc[ai][bj][m][1] * sc;
                    u32x4 w; w.x = cvt_pk_bf16(v0[0], v0[1]); w.y = cvt_pk_bf16(v0[2], v0[3]); w.z = cvt_pk_bf16(v1[0], v1[1]); w.w = cvt_pk_bf16(v1[2], v1[3]);
                    *(u32x4*)(rowp + bj * HALF) = w; } }
        if (part == 1 && !ga) {
#pragma unroll
            for (int bj = 0; bj < 2; ++bj) {
                f32x4 s0 = acc[0][bj][0][0], s1 = acc[0][bj][0][1];
#pragma unroll
                for (int ai = 0; ai < 2; ++ai)
#pragma unroll
                    for (int m = 0; m < 4; ++m) if (ai + m) { s0 += acc[ai][bj][m][0]; s1 += acc[ai][bj][m][1]; }
#pragma unroll
                for (int e = 0; e < 4; ++e) {
#pragma unroll
                    for (int o = 1; o < 16; o <<= 1) { s0[e] += __shfl_xor(s0[e], o); s1[e] += __shfl_xor(s1[e], o); } }
                if (fr == 0) { float* kp = kpart + (size_t)(u.pm * 2 + wr) * 512 + (pc - 2) * BM + bj * HALF + wc * 32 + 8 * fq;
                    *(f32x4*)kp = s0; *(f32x4*)(kp + 4) = s1; }
            }
        }
    }
};

template <int KIND> __device__ __forceinline__ void fill_rowscale(const float* ssq, const Unit& u, int par, PG8_LAS float* tab, int tid) {
    if (tid < 256) {
        const f32x4* p = (const f32x4*)(ssq + (size_t)(u.pm * BM + tid) * 16);
        const f32x4 a0 = p[0], a1 = p[1], b0 = p[2], b1 = p[3];
        const float sa = sum4(a0) + sum4(a1), sb = sum4(b0) + sum4(b1);
        if (KIND == 1) { tab[par * 512 + 2 * tid] = 1.0f / sqrtf((sa + sb) * (1.0f / 1024.0f) + RMS_EPS); }
        else { const float ra = 1.0f / sqrtf(sa * (1.0f / 512.0f) + RMS_EPS), rb = 1.0f / sqrtf(sb * (1.0f / 512.0f) + RMS_EPS);
            tab[par * 512 + 2 * tid] = ra / rb; tab[par * 512 + 2 * tid + 1] = rb; }
    }
}

struct EpiUp {
    static constexpr bool PERM = true, AFTER_DRAIN = false, MID = false, TABLE = true;
    bf16_t* O; int ldc; const float* ssq;
    __device__ __forceinline__ void fill(const Unit& u, int par, PG8_LAS float* tab, int tid) const { fill_rowscale<1>(ssq, u, par, tab, tid); }
    __device__ __forceinline__ void operator()(f32x4 (&acc)[2][2][4][2], const Unit& u, int wr, int wc, int fr, int fq, PG8_LAS float* tab, int par) const {
        const int row0 = u.pm * BM + wr * 64 + fr, col0 = u.pn * BM + wc * 32 + 8 * fq;
#pragma unroll
        for (int ai = 0; ai < 2; ++ai)
#pragma unroll
            for (int m = 0; m < 4; ++m) { const int r = ai * HALF + wr * 64 + m * 16 + fr; const float rs = tab[par * 512 + 2 * r];
                bf16_t* rowp = O + (size_t)(row0 + ai * HALF + m * 16) * ldc + col0;
#pragma unroll
                for (int bj = 0; bj < 2; ++bj) { f32x4 v0 = acc[ai][bj][m][0] * rs, v1 = acc[ai][bj][m][1] * rs;
#pragma unroll
                    for (int e = 0; e < 4; ++e) { const float a = fmaxf(v0[e], 0.f), b = fmaxf(v1[e], 0.f); v0[e] = a * a; v1[e] = b * b; }
                    u32x4 w; w.x = cvt_pk_bf16(v0[0], v0[1]); w.y = cvt_pk_bf16(v0[2], v0[3]); w.z = cvt_pk_bf16(v1[0], v1[1]); w.w = cvt_pk_bf16(v1[2], v1[3]);
                    *(u32x4*)(rowp + bj * HALF) = w; } }
    }
};

template <int KIND> struct EpiRes {
    static constexpr bool PERM = true, AFTER_DRAIN = false, MID = (KIND == 1), TABLE = (KIND == 1);
    const float* invr; bf16_t* hb; float* ssq_out; const float* ssq_in;
    __device__ __forceinline__ void fill(const Unit& u, int par, PG8_LAS float* tab, int tid) const { fill_rowscale<2>(ssq_in, u, par, tab, tid); }
    __device__ __forceinline__ void mid(f32x4 (&acc)[2][2][4][2], int wr, int fr, PG8_LAS float* tab, int par) const {
#pragma unroll
        for (int ai = 0; ai < 2; ++ai)
#pragma unroll
            for (int m = 0; m < 4; ++m) { const float f = tab[par * 512 + 2 * (ai * HALF + wr * 64 + m * 16 + fr)];
#pragma unroll
                for (int bj = 0; bj < 2; ++bj)
#pragma unroll
                    for (int n = 0; n < 2; ++n) acc[ai][bj][m][n] *= f; }
    }
    __device__ __forceinline__ void operator()(f32x4 (&acc)[2][2][4][2], const Unit& u, int wr, int wc, int fr, int fq, PG8_LAS float* tab, int par) const {
        const int col0 = u.pn * BM + wc * 32 + 8 * fq;
#pragma unroll
        for (int ai = 0; ai < 2; ++ai) {
            f32x4 rv[4][2][2];
#pragma unroll
            for (int m = 0; m < 4; ++m) { const size_t off = (size_t)(u.pm * BM + ai * HALF + wr * 64 + m * 16 + fr) * 1024 + col0;
#pragma unroll
                for (int bj = 0; bj < 2; ++bj) {
                    { const u32x4 w = *(const u32x4*)(hb + off + bj * HALF);
                        rv[m][bj][0] = (f32x4){__uint_as_float(w.x << 16), __uint_as_float(w.x & 0xffff0000u), __uint_as_float(w.y << 16), __uint_as_float(w.y & 0xffff0000u)};
                        rv[m][bj][1] = (f32x4){__uint_as_float(w.z << 16), __uint_as_float(w.z & 0xffff0000u), __uint_as_float(w.w << 16), __uint_as_float(w.w & 0xffff0000u)}; } } }
#pragma unroll
            for (int m = 0; m < 4; ++m) { const int r = ai * HALF + wr * 64 + m * 16 + fr; const int rowg = u.pm * BM + r;
                const float rb = (KIND == 1) ? tab[par * 512 + 2 * r + 1] : 1.0f; const float ir = (KIND == 1) ? invr[rowg] : 1.0f;
                const size_t off = (size_t)rowg * 1024 + col0; float ss = 0.f;
#pragma unroll
                for (int bj = 0; bj < 2; ++bj) { const f32x4 v0 = rv[m][bj][0] * ir + acc[ai][bj][m][0] * rb, v1 = rv[m][bj][1] * ir + acc[ai][bj][m][1] * rb;
                    u32x4 w; w.x = cvt_pk_bf16(v0[0], v0[1]); w.y = cvt_pk_bf16(v0[2], v0[3]); w.z = cvt_pk_bf16(v1[0], v1[1]); w.w = cvt_pk_bf16(v1[2], v1[3]);
                    *(u32x4*)(hb + off + bj * HALF) = w;
                    ss += ((v0[0] * v0[0] + v0[1] * v0[1]) + (v0[2] * v0[2] + v0[3] * v0[3])) + ((v1[0] * v1[0] + v1[1] * v1[1]) + (v1[2] * v1[2] + v1[3] * v1[3])); }
                ss += __shfl_xor(ss, 16); ss += __shfl_xor(ss, 32);
                if (fq == 0) ssq_out[(size_t)rowg * 16 + u.pn * 4 + wc] = ss; }
            asm volatile("" ::: "memory");
        }
    }
};

struct EpiGate {
    static constexpr bool PERM = true, AFTER_DRAIN = false, MID = false, TABLE = true;
    bf16_t* hb; const bf16_t* pp; const float* bias; float* ssq_out; const float* ssq_in;
    __device__ __forceinline__ void fill(const Unit& u, int par, PG8_LAS float* tab, int tid) const { fill_rowscale<1>(ssq_in, u, par, tab, tid); }
    __device__ __forceinline__ void operator()(f32x4 (&acc)[2][2][4][2], const Unit& u, int wr, int wc, int fr, int fq, PG8_LAS float* tab, int par) const {
        const int col0 = u.pn * BM + wc * 32 + 8 * fq;
        f32x4 bv[2][2];
#pragma unroll
        for (int bj = 0; bj < 2; ++bj)
#pragma unroll
            for (int n = 0; n < 2; ++n) bv[bj][n] = *(const f32x4*)(bias + col0 + bj * HALF + 4 * n);
#pragma unroll
        for (int ai = 0; ai < 2; ++ai) {
            u32x4 hv[4][2], pv[4][2];
#pragma unroll
            for (int m = 0; m < 4; ++m) { const size_t off = (size_t)(u.pm * BM + ai * HALF + wr * 64 + m * 16 + fr) * 1024 + col0;
#pragma unroll
                for (int bj = 0; bj < 2; ++bj) { hv[m][bj] = *(const u32x4*)(hb + off + bj * HALF); pv[m][bj] = *(const u32x4*)(pp + off + bj * HALF); } }
#pragma unroll
            for (int m = 0; m < 4; ++m) { const int r = ai * HALF + wr * 64 + m * 16 + fr; const int rowg = u.pm * BM + r;
                const float rs = tab[par * 512 + 2 * r];
                const size_t off = (size_t)rowg * 1024 + col0; float ss = 0.f;
#pragma unroll
                for (int bj = 0; bj < 2; ++bj) { float v[8];
#pragma unroll
                    for (int e = 0; e < 8; ++e) { const unsigned hw = hv[m][bj][e >> 1], pw = pv[m][bj][e >> 1];
                        const float h = __uint_as_float((e & 1) ? (hw & 0xffff0000u) : (hw << 16)), p = __uint_as_float((e & 1) ? (pw & 0xffff0000u) : (pw << 16));
                        const float z = acc[ai][bj][m][e >> 2][e & 3] * rs + bv[bj][e >> 2][e & 3];
                        v[e] = h + __builtin_amdgcn_rcpf(1.0f + __builtin_amdgcn_exp2f(-1.4426950408889634f * z)) * p; ss += v[e] * v[e]; }
                    u32x4 w; w.x = cvt_pk_bf16(v[0], v[1]); w.y = cvt_pk_bf16(v[2], v[3]); w.z = cvt_pk_bf16(v[4], v[5]); w.w = cvt_pk_bf16(v[6], v[7]);
                    *(u32x4*)(hb + off + bj * HALF) = w; }
                ss += __shfl_xor(ss, 16); ss += __shfl_xor(ss, 32);
                if (fq == 0) ssq_out[(size_t)rowg * 16 + u.pn * 4 + wc] = ss; }
            asm volatile("" ::: "memory");
        }
    }
};

template <class Epi, class Sched, bool ALIGN_EPI = false, bool SP2 = false>
__device__ __forceinline__ void gemm_phase(PG8_LAS unsigned char* lds, PG8_LAS float* tab, const Gemm g, const Sched& S, const Epi& E) {
    const int tid = threadIdx.x, wid = __builtin_amdgcn_readfirstlane(tid >> 6), lane = tid & 63, wr = wid >> 2, wc = wid & 3, fr = lane & 15, fq = lane >> 4;
    const int K = g.K, nt = K / BK;
    unsigned voffA[2], voffB[2];
#pragma unroll
    for (int i = 0; i < 2; ++i) { int R, C; stage_rc(tid * 16 + i * 8192, R, C); const int Rb = Epi::PERM ? ((R & ~31) + perm32(R & 31)) : R;
        voffA[i] = (unsigned)(R * K + C) * 2u; voffB[i] = (unsigned)(Rb * K + C) * 2u; }
    const size_t kstep = (size_t)(BK * 2);
    const size_t hstep = (size_t)HALF * K * 2;
    const size_t tstep = 2 * hstep;
    const unsigned ldsw = (unsigned)wid * 1024u;
    const int aoff = lds_byte(wr * 64 + fr, fq * 8), boff = lds_byte(wc * 32 + fr, fq * 8);
#define PG8_SA(b, h) (((b) * 2 + (h)) * HTB)
#define PG8_SB(b, h) ((4 + (b) * 2 + (h)) * HTB)
#define PG8_STAGE(bufoff, gbase, voff) do { _Pragma("unroll") for (int _i = 0; _i < 2; ++_i) \
        __builtin_amdgcn_global_load_lds((const unsigned*)((const char*)(gbase) + (voff)[_i]), (PG8_LAS unsigned*)(lds + (bufoff) + ldsw + _i * 8192), 16, 0, 0); } while (0)
#define PG8_LDA(dst, b, h) do { _Pragma("unroll") for (int m = 0; m < 4; ++m) _Pragma("unroll") for (int k = 0; k < 2; ++k) dst[m][k] = *(const PG8_LAS bf16x8*)(lds + PG8_SA(b, h) + aoff + m * 2048 + k * 1024); } while (0)
#define PG8_LDB(dst, b, h) do { _Pragma("unroll") for (int n = 0; n < 2; ++n) _Pragma("unroll") for (int k = 0; k < 2; ++k) dst[n][k] = *(const PG8_LAS bf16x8*)(lds + PG8_SB(b, h) + boff + n * 2048 + k * 1024); } while (0)
#define PG8_MMA(ai, bj, At, Bt) do { __builtin_amdgcn_s_setprio(1); _Pragma("unroll") for (int m = 0; m < 4; ++m) _Pragma("unroll") for (int n = 0; n < 2; ++n) _Pragma("unroll") for (int k = 0; k < 2; ++k) \
        acc[ai][bj][m][n] = __builtin_amdgcn_mfma_f32_16x16x32_bf16(Bt[n][k], At[m][k], acc[ai][bj][m][n], 0, 0, 0); __builtin_amdgcn_s_setprio(0); } while (0)
#define PG8_WAIT_V(n) asm volatile("s_waitcnt vmcnt(" #n ")" ::: "memory")
#define PG8_WAIT_L(n) asm volatile("s_waitcnt lgkmcnt(" #n ")" ::: "memory")
#define PG8_BAR __builtin_amdgcn_s_barrier()
#define PG8_SCHED __builtin_amdgcn_sched_barrier(0)
    Unit cur, nxt; int ui = 0;
    if (!S.next(0, cur)) return;
    if constexpr (Epi::TABLE) E.fill(cur, 0, tab, tid);
    f32x4 acc[2][2][4][2];
#pragma unroll
    for (int a = 0; a < 2; ++a)
#pragma unroll
        for (int b = 0; b < 2; ++b)
#pragma unroll
            for (int m = 0; m < 4; ++m)
#pragma unroll
                for (int n = 0; n < 2; ++n) acc[a][b][m][n] = (f32x4){0.f, 0.f, 0.f, 0.f};
    bf16x8 At[4][2], B0[2][2], B1[2][2];
    const char* cA = (const char*)g.A + (size_t)cur.pm * tstep; const char* cB = (const char*)g.Bt + (size_t)cur.pn * tstep;
    S.a_ready(cur);
    if constexpr (SP2) {
        PG8_STAGE(PG8_SB(0, 0), cB, voffB); PG8_STAGE(PG8_SB(0, 1), cB + hstep, voffB); PG8_STAGE(PG8_SA(0, 0), cA, voffA); PG8_STAGE(PG8_SA(0, 1), cA + hstep, voffA);
        if (wr == 1) PG8_BAR;
        PG8_WAIT_V(2); PG8_BAR;
        PG8_STAGE(PG8_SB(1, 0), cB + kstep, voffB); PG8_STAGE(PG8_SA(1, 0), cA + kstep, voffA); PG8_STAGE(PG8_SB(1, 1), cB + hstep + kstep, voffB);
        PG8_WAIT_V(6); PG8_BAR;
    } else {
        PG8_STAGE(PG8_SB(0, 0), cB, voffB); PG8_STAGE(PG8_SA(0, 0), cA, voffA); PG8_STAGE(PG8_SB(0, 1), cB + hstep, voffB); PG8_STAGE(PG8_SA(0, 1), cA + hstep, voffA);
        if (wr == 1) PG8_BAR;
        PG8_WAIT_V(4); PG8_BAR;
        PG8_STAGE(PG8_SB(1, 0), cB + kstep, voffB); PG8_STAGE(PG8_SA(1, 0), cA + kstep, voffA); PG8_STAGE(PG8_SB(1, 1), cB + hstep + kstep, voffB);
        PG8_WAIT_V(6); PG8_BAR;
    }
    for (;;) {
        const bool has_next = S.next(ui + 1, nxt);
        const char* nA = has_next ? (const char*)g.A + (size_t)nxt.pm * tstep : cA; const char* nB = has_next ? (const char*)g.Bt + (size_t)nxt.pn * tstep : cB;
        for (int t = 0; t < nt; t += 2) {
            const bool last = (t == nt - 2);
            if constexpr (Epi::MID) { if (t == (nt >> 1)) E.mid(acc, wr, fr, tab, ui & 1); }
            const char* a1 = cA + (size_t)(t + 1) * kstep;
            const char* a2 = last ? nA : cA + (size_t)(t + 2) * kstep; const char* b2 = last ? nB : cB + (size_t)(t + 2) * kstep;
            const char* a3 = a2 + kstep; const char* b3 = b2 + kstep;
            if (last && has_next) S.a_ready(nxt);
            if constexpr (SP2) {
            PG8_LDB(B0, 0, 0); PG8_LDB(B1, 0, 1); PG8_SCHED; PG8_LDA(At, 0, 0); PG8_STAGE(PG8_SA(1, 1), a1 + hstep, voffA);
            PG8_WAIT_V(8); PG8_WAIT_L(0); PG8_BAR; PG8_MMA(0, 0, At, B0); PG8_MMA(0, 1, At, B1); PG8_BAR; PG8_SCHED;
            PG8_LDA(At, 0, 1); PG8_STAGE(PG8_SB(0, 0), b2, voffB); PG8_STAGE(PG8_SB(0, 1), b2 + hstep, voffB); PG8_STAGE(PG8_SA(0, 0), a2, voffA);
            PG8_WAIT_V(8); PG8_WAIT_L(0); PG8_BAR; PG8_MMA(1, 0, At, B0); PG8_MMA(1, 1, At, B1); PG8_BAR; PG8_SCHED;
            PG8_LDB(B0, 1, 0); PG8_LDB(B1, 1, 1); PG8_SCHED; PG8_LDA(At, 1, 0); PG8_STAGE(PG8_SA(0, 1), a2 + hstep, voffA);
            PG8_WAIT_V(8); PG8_WAIT_L(0); PG8_BAR; PG8_MMA(0, 0, At, B0); PG8_MMA(0, 1, At, B1); PG8_BAR; PG8_SCHED;
            PG8_LDA(At, 1, 1); PG8_STAGE(PG8_SB(1, 0), b3, voffB); PG8_STAGE(PG8_SB(1, 1), b3 + hstep, voffB); PG8_STAGE(PG8_SA(1, 0), a3, voffA);
            PG8_WAIT_V(8); PG8_WAIT_L(0); PG8_BAR; PG8_MMA(1, 0, At, B0); PG8_MMA(1, 1, At, B1); PG8_BAR; PG8_SCHED;
            } else {
            PG8_LDB(B0, 0, 0); PG8_SCHED; PG8_LDA(At, 0, 0); PG8_STAGE(PG8_SA(1, 1), a1 + hstep, voffA);
            PG8_WAIT_L(8); PG8_BAR; PG8_WAIT_L(0); PG8_MMA(0, 0, At, B0); PG8_BAR; PG8_SCHED;
            PG8_LDB(B1, 0, 1); PG8_STAGE(PG8_SB(0, 0), b2, voffB);
            PG8_BAR; PG8_WAIT_L(0); PG8_MMA(0, 1, At, B1); PG8_BAR;
            PG8_LDA(At, 0, 1); PG8_STAGE(PG8_SA(0, 0), a2, voffA);
            PG8_BAR; PG8_WAIT_L(0); PG8_MMA(1, 0, At, B0); PG8_BAR; PG8_SCHED;
            PG8_STAGE(PG8_SB(0, 1), b2 + hstep, voffB);
            PG8_WAIT_V(6); PG8_BAR; PG8_MMA(1, 1, At, B1); PG8_BAR;
            PG8_LDB(B0, 1, 0); PG8_SCHED; PG8_LDA(At, 1, 0); PG8_STAGE(PG8_SA(0, 1), a2 + hstep, voffA);
            PG8_WAIT_L(8); PG8_BAR; PG8_WAIT_L(0); PG8_MMA(0, 0, At, B0); PG8_BAR; PG8_SCHED;
            PG8_LDB(B1, 1, 1); PG8_STAGE(PG8_SB(1, 0), b3, voffB);
            PG8_BAR; PG8_WAIT_L(0); PG8_MMA(0, 1, At, B1); PG8_BAR;
            PG8_LDA(At, 1, 1); PG8_STAGE(PG8_SA(1, 0), a3, voffA);
            PG8_BAR; PG8_WAIT_L(0); PG8_MMA(1, 0, At, B0); PG8_BAR; PG8_SCHED;
            PG8_STAGE(PG8_SB(1, 1), b3 + hstep, voffB);
            PG8_WAIT_V(6); PG8_BAR; PG8_MMA(1, 1, At, B1); PG8_BAR;
            }
        }
        if constexpr (ALIGN_EPI) { if (wr == 0) PG8_BAR; }
        if constexpr (!Epi::AFTER_DRAIN) { int tid_e = threadIdx.x; asm volatile("" : "+v"(tid_e)); const int lane_e = tid_e & 63;
            E(acc, cur, wr, wc, lane_e & 15, lane_e >> 4, tab, ui & 1); S.done(cur); }
        if (!has_next) break;
#pragma unroll
        for (int a = 0; a < 2; ++a)
#pragma unroll
            for (int b = 0; b < 2; ++b)
#pragma unroll
                for (int m = 0; m < 4; ++m)
#pragma unroll
                    for (int n = 0; n < 2; ++n) acc[a][b][m][n] = (f32x4){0.f, 0.f, 0.f, 0.f};
        cur = nxt; cA = nA; cB = nB; ++ui;
        if constexpr (Epi::TABLE) E.fill(cur, ui & 1, tab, tid);
        if constexpr (ALIGN_EPI) { if (wr == 1) PG8_BAR; }
    }
    PG8_WAIT_V(0);
    if constexpr (!ALIGN_EPI) { if (wr == 0) PG8_BAR; }
    PG8_BAR;
    if constexpr (Epi::AFTER_DRAIN) { E.fused(acc, cur, wr, wc, fr, fq, lds, wid, lane); S.done(cur); }
#undef PG8_SA
#undef PG8_SB
#undef PG8_STAGE
#undef PG8_LDA
#undef PG8_LDB
#undef PG8_MMA
#undef PG8_WAIT_V
#undef PG8_WAIT_L
#undef PG8_BAR
#undef PG8_SCHED
}
}
#define GAS __attribute__((address_space(1)))
#define LAS __attribute__((address_space(3)))
typedef unsigned short bf16;
typedef unsigned v4u __attribute__((ext_vector_type(4)));
typedef float f32x4 __attribute__((ext_vector_type(4)));
typedef short bf16x8 __attribute__((ext_vector_type(8)));
typedef GAS unsigned gu32;
typedef GAS unsigned long long gu64;
#define RLX_AGENT __ATOMIC_RELAXED, __HIP_MEMORY_SCOPE_AGENT
#define LDS_WAIT() asm volatile("s_waitcnt lgkmcnt(0)" ::: "memory")
#define VM_WAIT() asm volatile("s_waitcnt vmcnt(0)" ::: "memory")
__device__ __forceinline__ unsigned long long rt() { return __builtin_amdgcn_s_memrealtime(); }
__device__ __forceinline__ unsigned f2bf(float f) { unsigned u = __builtin_bit_cast(unsigned, f); return (u + 0x7fffu + ((u >> 16) & 1u)) >> 16; }
__device__ __forceinline__ unsigned pk2(float lo, float hi) { return f2bf(lo) | (f2bf(hi) << 16); }

#define XB_TMO      128
#define XB_XCNT(j)  (256  + 64 * (j))
#define XB_XSUB(j)  (1280 + 64 * (j))
#define XB_XGEN(j)  (2304 + 64 * (j))
#define XB_TOP      3328
#define XB_TOPGEN   3392
#define XCD_BAR_WORDS 3456
#define XB_SPIN_CAP (1u << 18)

__device__ __forceinline__ unsigned xb_ld(unsigned* p)              { return __hip_atomic_load(p, __ATOMIC_RELAXED, __HIP_MEMORY_SCOPE_AGENT); }
__device__ __forceinline__ unsigned xb_add(unsigned* p, unsigned v) { return __hip_atomic_fetch_add(p, v, __ATOMIC_RELAXED, __HIP_MEMORY_SCOPE_AGENT); }
__device__ __forceinline__ unsigned xb_xcc_id() { return (unsigned)__builtin_amdgcn_s_getreg((3 << 11) | 20) & 0xFu; }
#define XB_SPIN(cond, bar) do { unsigned _sp = 0; while (cond) { __builtin_amdgcn_s_sleep(1); \
    if ((++_sp & 255u) == 0u) { if (xb_ld(&(bar)[XB_TMO])) break; if (_sp > XB_SPIN_CAP) { atomicAdd(&(bar)[XB_TMO], 1u); break; } } } } while (0)

struct XcdBarrier {
    unsigned* bar; unsigned x;
    volatile LAS unsigned* st;
};

__device__ __forceinline__ XcdBarrier xcd_barrier_post(unsigned* bar, volatile LAS unsigned* st) {
    XcdBarrier b; b.bar = bar; b.x = xb_xcc_id(); b.st = st;
    if (threadIdx.x == 0) (void)xb_add(&bar[XB_XCNT(b.x)], 1u);
    return b;
}
__device__ __forceinline__ void xcd_barrier_complete(unsigned* bar, unsigned x, unsigned& nloc, unsigned& nx) {
    const unsigned G = gridDim.x * gridDim.y * gridDim.z;
    unsigned sum, cnt, mine, sp = 0u;
    for (;;) {
        sum = 0u; cnt = 0u; mine = 0u;
#pragma unroll
        for (unsigned j = 0; j < 16; ++j) { const unsigned c = xb_ld(&bar[XB_XCNT(j)]); sum += c; cnt += (c > 0u) ? 1u : 0u; mine = (j == x) ? c : mine; }
        if (sum == G) break;
        __builtin_amdgcn_s_sleep(1);
        if ((++sp & 255u) == 0u) { if (xb_ld(&bar[XB_TMO])) break; if (sp > XB_SPIN_CAP) { atomicAdd(&bar[XB_TMO], 1u); break; } }
    }
    nloc = mine > 0u ? mine : 1u; nx = cnt > 0u ? cnt : 1u;
}

__device__ __forceinline__ void xcd_barrier(const XcdBarrier& b) {
    asm volatile("s_waitcnt vmcnt(0)" ::: "memory");
    __syncthreads();
    if (threadIdx.x == 0) {
        unsigned* bar = b.bar;
        __builtin_amdgcn_s_waitcnt(0);
        unsigned nloc = b.st[0], nx = b.st[1];
        if (nloc == 0u) { xcd_barrier_complete(bar, b.x, nloc, nx); b.st[0] = nloc; b.st[1] = nx; }
        const unsigned old = xb_add(&bar[XB_XSUB(b.x)], 1u);
        const unsigned gen = old / nloc;
        if (old + 1u == (gen + 1u) * nloc) {
            __builtin_amdgcn_fence(__ATOMIC_RELEASE, "agent");
            asm volatile("s_waitcnt vmcnt(0)" ::: "memory");
            const unsigned og = xb_add(&bar[XB_TOP], 1u);
            const unsigned tg = og / nx;
            if (og + 1u == (tg + 1u) * nx) xb_add(&bar[XB_TOPGEN], 1u);
            else XB_SPIN(xb_ld(&bar[XB_TOPGEN]) == tg, bar);
            __builtin_amdgcn_fence(__ATOMIC_ACQUIRE, "agent");
            xb_add(&bar[XB_XGEN(b.x)], 1u);
            asm volatile("s_waitcnt vmcnt(0)" ::: "memory");
        } else {
            XB_SPIN(xb_ld(&bar[XB_XGEN(b.x)]) == gen, bar);
            __builtin_amdgcn_fence(__ATOMIC_ACQUIRE, "agent");
            asm volatile("s_waitcnt vmcnt(0)" ::: "memory");
        }
    }
    __syncthreads();
}

constexpr int NWAVES = 8;
#ifndef MK_N_LAUNCHES
#define MK_N_LAUNCHES 1
#endif
constexpr int N_LAUNCHES = MK_N_LAUNCHES;
constexpr int NPHASE = 8;
static_assert(N_LAUNCHES == 1 || N_LAUNCHES == NPHASE, "MK_N_LAUNCHES is 1 or NPHASE");

constexpr int BATCH = 8, SEQ = 4096, D = 1024, NH = 16, HD = 64, FF = 4096, PLE = 256;
constexpr int M = BATCH * SEQ;
constexpr int NQKV = 3 * D;
constexpr float EPS = 1e-6f;
constexpr float LOG2E = 1.4426950408889634f;
constexpr float C2 = 0.125f * LOG2E;

constexpr size_t MiB = 1u << 20;
constexpr size_t WS_CTL = 0, CTL_ZERO_BYTES = 64 * 1024;
constexpr size_t WS_WQKV = 1 * MiB, WS_WO = 7 * MiB, WS_WUP = 9 * MiB, WS_WDN = 17 * MiB, WS_WG = 25 * MiB, WS_WP = 27 * MiB;
constexpr size_t WS_SSQ0 = 28 * MiB, WS_SSQ1 = 30 * MiB, WS_SSQ2 = 32 * MiB, WS_SSQ3 = 34 * MiB;
constexpr size_t WS_KPART = 36 * MiB;
constexpr size_t WS_INVR = 37 * MiB;
constexpr size_t WS_PB = 40 * MiB;
constexpr size_t WS_PP = 56 * MiB;
constexpr size_t WS_XN = 120 * MiB;
constexpr size_t WS_Q = 184 * MiB, WS_K = 248 * MiB, WS_V = 312 * MiB, WS_O = 376 * MiB;
constexpr size_t WS_U = 184 * MiB;
constexpr size_t WS_END = 440 * MiB;
constexpr int CW_BAR = 1024;

constexpr int RING_OFF = 0, RING_BYTES = 131072;
constexpr int LDSCTL_OFF = RING_BYTES, MISC_OFF = LDSCTL_OFF + 320;
constexpr int TAB_OFF = RING_BYTES + 1024;
constexpr int LDS_BYTES = 147456;
static_assert(TAB_OFF + 4096 <= LDS_BYTES, "LDS map");

struct Frame {
    LAS unsigned char* lds;
    volatile LAS unsigned* MISC;
    gu32* ctl;
    int tid, lane, wave;
    int vcu, G;
    const float *x, *p, *g_attn, *w_in, *g_out_a, *g_out_b, *w_out, *g_mlp, *w_up, *w_down, *g_ple, *w_gate, *b_gate, *w_proj, *g_final;
    float* out;
    bf16 *Wqkv_t, *Wo_t, *Wup_t, *Wdn_t, *Wg_t, *Wp_t;
    bf16 *XN, *QB, *KB, *VB, *OB, *UB, *PB, *PP;
    float *ssq0, *ssq1, *ssq2, *ssq3, *kpart, *invr0;
};

__device__ __forceinline__ float wave_sum(float v) {
#pragma unroll
    for (int o = 1; o < 64; o <<= 1) v += __shfl_xor(v, o);
    return v;
}
__device__ __forceinline__ void p0_transpose_item(const float* W, int K, int N, bf16* dst, const float* g, LAS float* scr, int k0, int n0, int lane) {
    f32x4 wv[8];
#pragma unroll
    for (int i = 0; i < 8; ++i) wv[i] = *(const GAS f32x4*)(W + (size_t)(k0 + 8 * i + (lane >> 3)) * N + n0 + 4 * (lane & 7));
#pragma unroll
    for (int i = 0; i < 8; ++i) { const int kk = 8 * i + (lane >> 3); f32x4 v = wv[i]; if (g) v = v * g[k0 + kk]; LAS float* d = scr + kk * 33 + 4 * (lane & 7); d[0] = v.x; d[1] = v.y; d[2] = v.z; d[3] = v.w; }
    LDS_WAIT(); asm volatile("" ::: "memory");
    const int c = lane & 7;
#pragma unroll
    for (int j = 0; j < 4; ++j) { const int n = (lane >> 3) + 8 * j; const LAS float* s = scr + (8 * c) * 33 + n;
        v4u o; o.x = pk2(s[0 * 33], s[1 * 33]); o.y = pk2(s[2 * 33], s[3 * 33]); o.z = pk2(s[4 * 33], s[5 * 33]); o.w = pk2(s[6 * 33], s[7 * 33]);
        *(GAS v4u*)(dst + (size_t)n * K + k0 + 8 * c) = o; }
    LDS_WAIT(); asm volatile("" ::: "memory");
}
__device__ __forceinline__ int qkv_dst_row(int n0) {
    if (n0 < 1536) return (n0 / 512) * 1024 + (n0 % 512);
    const int n1 = n0 - 1536; return (n1 / 512) * 1024 + 512 + (n1 % 512);
}
__device__ __forceinline__ void p0_prologue(Frame& F) {
    LAS float* scr = (LAS float*)(F.lds + RING_OFF + F.wave * 16384);
    const int gw = F.vcu * NWAVES + F.wave, NGW = F.G * NWAVES;
    constexpr int I_IN = (D / 64) * (NQKV / 32), I_O = (D / 64) * (D / 32), I_UP = (D / 64) * (FF / 32), I_DN = (FF / 64) * (D / 32), I_G = I_O, I_P = (PLE / 64) * (D / 32);
    constexpr int NITEMS = I_IN + I_O + I_UP + I_DN + I_G + I_P;
    for (int it = gw; it < NITEMS; it += NGW) {
        int r = it;
        if (r < I_IN) { const int nb = r % (NQKV / 32), kb = r / (NQKV / 32); p0_transpose_item(F.w_in, D, NQKV, F.Wqkv_t + (size_t)qkv_dst_row(32 * nb) * D, F.g_attn, scr, 64 * kb, 32 * nb, F.lane); continue; } r -= I_IN;
        if (r < I_O) { const int nb = r % (D / 32), kb = r / (D / 32); const float* g = (64 * kb < 512) ? F.g_out_a : (F.g_out_b - 512);
            p0_transpose_item(F.w_out, D, D, F.Wo_t + (size_t)(32 * nb) * D, g, scr, 64 * kb, 32 * nb, F.lane); continue; } r -= I_O;
        if (r < I_UP) { const int nb = r % (FF / 32), kb = r / (FF / 32); p0_transpose_item(F.w_up, D, FF, F.Wup_t + (size_t)(32 * nb) * D, F.g_mlp, scr, 64 * kb, 32 * nb, F.lane); continue; } r -= I_UP;
        if (r < I_DN) { const int nb = r % (D / 32), kb = r / (D / 32); p0_transpose_item(F.w_down, FF, D, F.Wdn_t + (size_t)(32 * nb) * FF, nullptr, scr, 64 * kb, 32 * nb, F.lane); continue; } r -= I_DN;
        if (r < I_G) { const int nb = r % (D / 32), kb = r / (D / 32); p0_transpose_item(F.w_gate, D, D, F.Wg_t + (size_t)(32 * nb) * D, F.g_ple, scr, 64 * kb, 32 * nb, F.lane); continue; } r -= I_G;
        { const int nb = r % (D / 32), kb = r / (D / 32); p0_transpose_item(F.w_proj, PLE, D, F.Wp_t + (size_t)(32 * nb) * PLE, nullptr, scr, 64 * kb, 32 * nb, F.lane); }
    }
    for (int m0 = 2 * gw; m0 < M; m0 += 2 * NGW) {
        f32x4 v[2][4]; f32x4 pv[2]; float s[2] = {0.f, 0.f};
#pragma unroll
        for (int q = 0; q < 2; ++q) { const GAS f32x4* xr = (const GAS f32x4*)(F.x + (size_t)(m0 + q) * D) + F.lane;
#pragma unroll
            for (int j = 0; j < 4; ++j) v[q][j] = xr[64 * j];
            pv[q] = ((const GAS f32x4*)(F.p + (size_t)(m0 + q) * PLE))[F.lane]; }
#pragma unroll
        for (int q = 0; q < 2; ++q) {
#pragma unroll
            for (int j = 0; j < 4; ++j) s[q] += (v[q][j].x * v[q][j].x + v[q][j].y * v[q][j].y) + (v[q][j].z * v[q][j].z + v[q][j].w * v[q][j].w);
            const float ms_ = wave_sum(s[q]) * (1.f / D) + EPS; const float rstd = 1.f / sqrtf(ms_);
            if (F.lane == 0) F.invr0[m0 + q] = sqrtf(ms_);
            GAS unsigned long long* o8 = (GAS unsigned long long*)(F.XN + (size_t)(m0 + q) * D) + F.lane;
#pragma unroll
            for (int j = 0; j < 4; ++j) o8[64 * j] = (unsigned long long)pk2(v[q][j].x * rstd, v[q][j].y * rstd) | ((unsigned long long)pk2(v[q][j].z * rstd, v[q][j].w * rstd) << 32);
            ((GAS unsigned long long*)(F.PB + (size_t)(m0 + q) * PLE))[F.lane] = (unsigned long long)pk2(pv[q].x, pv[q].y) | ((unsigned long long)pk2(pv[q].z, pv[q].w) << 32); }
    }
}

__device__ __forceinline__ float bf2f(unsigned short h) { return __uint_as_float((unsigned)h << 16); }
__device__ __forceinline__ void naive_key(const bf16* kp, const bf16* vp, const float (&q)[64], float bias, float& mx, float& l, float (&acc)[64]) {
    float s = 0.f;
#pragma unroll
    for (int c = 0; c < 8; ++c) { const v4u kw = *(const v4u*)(kp + 8 * c);
        s += q[8 * c + 0] * __uint_as_float(kw.x << 16) + q[8 * c + 1] * __uint_as_float(kw.x & 0xffff0000u) + q[8 * c + 2] * __uint_as_float(kw.y << 16) + q[8 * c + 3] * __uint_as_float(kw.y & 0xffff0000u)
           + q[8 * c + 4] * __uint_as_float(kw.z << 16) + q[8 * c + 5] * __uint_as_float(kw.z & 0xffff0000u) + q[8 * c + 6] * __uint_as_float(kw.w << 16) + q[8 * c + 7] * __uint_as_float(kw.w & 0xffff0000u); }
    s += bias;
    const float mn = fmaxf(mx, s), sc = __builtin_amdgcn_exp2f(mx - mn), pe = __builtin_amdgcn_exp2f(s - mn);
    mx = mn; l = l * sc + pe;
#pragma unroll
    for (int c = 0; c < 8; ++c) { const v4u vw = *(const v4u*)(vp + 8 * c);
        acc[8 * c + 0] = acc[8 * c + 0] * sc + pe * __uint_as_float(vw.x << 16); acc[8 * c + 1] = acc[8 * c + 1] * sc + pe * __uint_as_float(vw.x & 0xffff0000u);
        acc[8 * c + 2] = acc[8 * c + 2] * sc + pe * __uint_as_float(vw.y << 16); acc[8 * c + 3] = acc[8 * c + 3] * sc + pe * __uint_as_float(vw.y & 0xffff0000u);
        acc[8 * c + 4] = acc[8 * c + 4] * sc + pe * __uint_as_float(vw.z << 16); acc[8 * c + 5] = acc[8 * c + 5] * sc + pe * __uint_as_float(vw.z & 0xffff0000u);
        acc[8 * c + 6] = acc[8 * c + 6] * sc + pe * __uint_as_float(vw.w << 16); acc[8 * c + 7] = acc[8 * c + 7] * sc + pe * __uint_as_float(vw.w & 0xffff0000u); }
}
__device__ __forceinline__ void attn_naive(Frame& F) {
    const long NT = (long)F.G * NWAVES * 64;
    for (long idx = (long)blockIdx.x * (NWAVES * 64) + F.tid; idx < (long)M * NH; idx += NT) {
        const int tok = (int)(idx % M), hh = (int)(idx / M); const int b = tok / SEQ, t = tok % SEQ; const int grp = hh >> 3, h = hh & 7;
        float q[64], acc[64]; float mx = -1e30f, l = 0.f;
#pragma unroll
        for (int d = 0; d < 64; ++d) acc[d] = 0.f;
        if (grp == 0) {
            const float sl2 = exp2f(-0.5f * (float)(2 * h + 1)) * LOG2E;
            const size_t qrow = (size_t)b * SEQ + (size_t)(t & 3) * 1024 + (t >> 2);
            const bf16* qp = F.QB + qrow * D + h * 64;
#pragma unroll
            for (int d = 0; d < 64; ++d) q[d] = bf2f(qp[d]);
            for (int br = 0; br < 3; ++br) { const int dil = br == 0 ? 1 : (br == 1 ? 4 : 16);
                for (int mm = 0; mm <= 128; ++mm) { const int key = t - dil * mm; if (key < 0) break;
                    const size_t krow = (size_t)b * SEQ + (size_t)(key & 3) * 1024 + (key >> 2);
                    naive_key(F.KB + krow * D + h * 64, F.VB + krow * D + h * 64, q, -sl2 * (float)(dil * mm), mx, l, acc); } }
        } else {
            const float sl2 = exp2f(-(float)(h + 1)) * LOG2E;
            const bf16* qp = F.QB + (size_t)tok * D + 512 + h * 64;
#pragma unroll
            for (int d = 0; d < 64; ++d) q[d] = bf2f(qp[d]);
            const int own = t >> 8; int i0 = -1, i1 = -1, i2 = -1; float g0 = -INFINITY, g1 = -INFINITY, g2 = -INFINITY;
            for (int n = 0; n < own; ++n) { const float* k0 = F.kpart + (size_t)((b * 16 + n) * 2) * 512 + h * 64; const float* k1 = k0 + 512; float g = 0.f;
#pragma unroll
                for (int d = 0; d < 64; ++d) g += q[d] * (k0[d] + k1[d]);
                if (g > g0) { g2 = g1; i2 = i1; g1 = g0; i1 = i0; g0 = g; i0 = n; } else if (g > g1) { g2 = g1; i2 = i1; g1 = g; i1 = n; } else if (g > g2) { g2 = g; i2 = n; } }
            for (int j = 0; j < 4; ++j) { const int n = j == 0 ? i0 : (j == 1 ? i1 : (j == 2 ? i2 : own)); if (n < 0) continue;
                const int kend = (j == 3) ? t : 256 * n + 255;
                for (int key = 256 * n; key <= kend; ++key) { const size_t krow = (size_t)b * SEQ + key;
                    naive_key(F.KB + krow * D + 512 + h * 64, F.VB + krow * D + 512 + h * 64, q, -sl2 * (float)(t - key), mx, l, acc); } }
        }
        const float rl = 1.0f / l; float ss = 0.f; bf16* op = F.OB + (size_t)tok * D + grp * 512 + h * 64;
#pragma unroll
        for (int d = 0; d < 64; d += 2) { const float a = acc[d] * rl, c = acc[d + 1] * rl; ss += a * a + c * c; *(unsigned*)(op + d) = pk2(a, c); }
        F.ssq0[(size_t)tok * 16 + hh] = ss;
    }
}


namespace att {
typedef short bf16x8 __attribute__((ext_vector_type(8)));
typedef short s16x4 __attribute__((ext_vector_type(4)));
typedef float f32x16 __attribute__((ext_vector_type(16)));
typedef unsigned u32x4 __attribute__((ext_vector_type(4)));
typedef LAS const char* lds_cptr;
constexpr int NSLOT = 4, SLOTB = 8192;
constexpr int L_K = 0, L_V = 5 * SLOTB, L_WS = 10 * SLOTB, L_OST = L_WS + 8 * 256, L_TAB = L_OST + 8 * 4096, L_END = L_TAB + 12288;
static_assert(L_END <= RING_BYTES, "attention LDS map");
typedef short v4i16_t __attribute__((ext_vector_type(4)));
#define ATT_NEG (-INFINITY)
__device__ __forceinline__ int crow(int r, int hi) { return (r & 3) + 8 * (r >> 2) + 4 * hi; }
__device__ __forceinline__ void glds16(const void* gsrc, unsigned lds_dst) { unsigned keep;
    asm volatile("s_mov_b32 %0, m0\n\ts_mov_b32 m0, %2\n\ts_nop 0\n\tglobal_load_lds_dwordx4 %1, off\n\ts_mov_b32 m0, %0" : "=&s"(keep) : "v"(gsrc), "s"(lds_dst) : "memory"); }
typedef float f32x2_t __attribute__((ext_vector_type(2))); typedef __bf16 bf16x2_t __attribute__((ext_vector_type(2)));
__device__ __forceinline__ unsigned cvtpk_s(float lo, float hi) { f32x2_t v = {lo, hi}; bf16x2_t b = __builtin_convertvector(v, bf16x2_t); return __builtin_bit_cast(unsigned, b); }
#define ATT_WAIT_BAR(N) asm volatile("s_waitcnt vmcnt(" #N ") lgkmcnt(0)\n\ts_barrier" ::: "memory")
#define ATT_SBAR() __builtin_amdgcn_sched_barrier(0)

__device__ __forceinline__ void qkt(f32x16& p0, f32x16& p1, lds_cptr kb, const bf16x8 (&qr)[4]) {
#pragma unroll
    for (int d0 = 0; d0 < 4; ++d0) {
        const bf16x8 b0 = *(LAS const bf16x8*)(kb + d0 * 2048);
        const bf16x8 b1 = *(LAS const bf16x8*)(kb + d0 * 2048 + 512);
        p0 = __builtin_amdgcn_mfma_f32_32x32x16_bf16(b0, qr[d0], p0, 0, 0, 0);
        p1 = __builtin_amdgcn_mfma_f32_32x32x16_bf16(b1, qr[d0], p1, 0, 0, 0); }
}
__device__ __forceinline__ void pv(f32x16 (&o)[2], int vb, bf16x8 pa0, bf16x8 pa1, bf16x8 pa2, bf16x8 pa3) {
#pragma unroll
    for (int d0 = 0; d0 < 2; ++d0) { s16x4 lo[4], hi[4];
#pragma unroll
        for (int ks = 0; ks < 4; ++ks) {
            asm volatile("ds_read_b64_tr_b16 %0,%1 offset:%c2" : "=&v"(lo[ks]) : "v"(vb), "i"(d0 * 4096 + ks * 1024) : "memory");
            asm volatile("ds_read_b64_tr_b16 %0,%1 offset:%c2" : "=&v"(hi[ks]) : "v"(vb), "i"(d0 * 4096 + ks * 1024 + 512) : "memory"); }
        asm volatile("s_waitcnt lgkmcnt(0)" ::: "memory"); ATT_SBAR();
#define ATT_PK(k) (bf16x8){lo[k][0], lo[k][1], lo[k][2], lo[k][3], hi[k][0], hi[k][1], hi[k][2], hi[k][3]}
        o[d0] = __builtin_amdgcn_mfma_f32_32x32x16_bf16(pa0, ATT_PK(0), o[d0], 0, 0, 0);
        o[d0] = __builtin_amdgcn_mfma_f32_32x32x16_bf16(pa1, ATT_PK(1), o[d0], 0, 0, 0);
        o[d0] = __builtin_amdgcn_mfma_f32_32x32x16_bf16(pa2, ATT_PK(2), o[d0], 0, 0, 0);
        o[d0] = __builtin_amdgcn_mfma_f32_32x32x16_bf16(pa3, ATT_PK(3), o[d0], 0, 0, 0);
#undef ATT_PK
    }
}

__device__ __forceinline__ void qkt2(f32x16& p0, f32x16& p1, lds_cptr kpA, lds_cptr kpB, const bf16x8 (&qr)[4]) {
#pragma unroll
    for (int d0 = 0; d0 < 4; ++d0) {
        const bf16x8 b0 = *(LAS const bf16x8*)(kpA + d0 * 2048);
        const bf16x8 b1 = *(LAS const bf16x8*)(kpB + d0 * 2048);
        p0 = __builtin_amdgcn_mfma_f32_32x32x16_bf16(b0, qr[d0], p0, 0, 0, 0);
        p1 = __builtin_amdgcn_mfma_f32_32x32x16_bf16(b1, qr[d0], p1, 0, 0, 0); }
}
__device__ __forceinline__ void pv2(f32x16 (&o)[2], int vbA, int vbB, bf16x8 pa0, bf16x8 pa1, bf16x8 pa2, bf16x8 pa3) {
#pragma unroll
    for (int d0 = 0; d0 < 2; ++d0) { s16x4 lo[4], hi[4];
#pragma unroll
        for (int ks = 0; ks < 4; ++ks) {
            asm volatile("ds_read_b64_tr_b16 %0,%1 offset:%c2" : "=&v"(lo[ks]) : "v"(ks < 2 ? vbA : vbB), "i"(d0 * 4096 + ks * 1024) : "memory");
            asm volatile("ds_read_b64_tr_b16 %0,%1 offset:%c2" : "=&v"(hi[ks]) : "v"(ks < 2 ? vbA : vbB), "i"(d0 * 4096 + ks * 1024 + 512) : "memory"); }
        asm volatile("s_waitcnt lgkmcnt(0)" ::: "memory"); ATT_SBAR();
#define ATT_PK(k) (bf16x8){lo[k][0], lo[k][1], lo[k][2], lo[k][3], hi[k][0], hi[k][1], hi[k][2], hi[k][3]}
        o[d0] = __builtin_amdgcn_mfma_f32_32x32x16_bf16(pa0, ATT_PK(0), o[d0], 0, 0, 0);
        o[d0] = __builtin_amdgcn_mfma_f32_32x32x16_bf16(pa1, ATT_PK(1), o[d0], 0, 0, 0);
        o[d0] = __builtin_amdgcn_mfma_f32_32x32x16_bf16(pa2, ATT_PK(2), o[d0], 0, 0, 0);
        o[d0] = __builtin_amdgcn_mfma_f32_32x32x16_bf16(pa3, ATT_PK(3), o[d0], 0, 0, 0);
#undef ATT_PK
    }
}

struct PolA {
    int b, r, T0, NT, NT_own, jmin, jpmin, per, iq;
    LAS const float* tab; int hi;
    __device__ __forceinline__ void init(int b_, int r_, int Tblk, int wid, int r32, int hi_, LAS const float* tab_) {
        b = b_; r = r_; T0 = 256 * Tblk; jmin = T0 >= 512 ? 0 : (512 - T0) / 64; NT_own = 12 - jmin; jpmin = T0 == 0 ? 1 : 0; per = 5 - jpmin; NT = NT_own;
        iq = T0 + 32 * wid + r32; tab = tab_; hi = hi_; }
    __device__ __forceinline__ void tile(int t, int& rho, int& ik0, int& k) const {
        if (t < NT_own) { k = 0; rho = r; ik0 = T0 - 512 + 64 * (jmin + t); }
        else { const int tp = t - NT_own; k = 1 + tp / per; rho = (r + k) & 3; ik0 = T0 - 64 + 64 * (jpmin + tp % per); } }
    __device__ __forceinline__ long row0(int t) const { int rho, ik0, k; tile(t, rho, ik0, k); return (long)b * SEQ + rho * 1024 + ik0; }
    __device__ __forceinline__ long qrow(int wid, int r32) const { return (long)b * SEQ + r * 1024 + T0 + 32 * wid + r32; }
    __device__ __forceinline__ long orow(int wid, int row) const { return (long)b * SEQ + 4 * (T0 + 32 * wid + row) + r; }
    __device__ __forceinline__ bool active(int t, int wid) const {
        int rho, ik0, k; tile(t, rho, ik0, k); const int dmax = T0 + 32 * wid + 31 - ik0, dmin = T0 + 32 * wid - ik0 - 63; return dmax >= 0 && dmin <= (k == 0 ? 512 : 32); }
    __device__ __forceinline__ void cinit(int t, f32x16& p0, f32x16& p1) const {
        int rho, ik0, k; tile(t, rho, ik0, k);
        LAS const float* tb = tab + (k == 0 ? 0 : 1024 + (k - 1) * 576) + (iq - ik0 - 4 * hi + 256 - 63);
#pragma unroll
        for (int rr = 0; rr < 16; ++rr) { const int c = (rr & 3) + 8 * (rr >> 2); p0[rr] = tb[63 - c]; p1[rr] = tb[31 - c]; }
    }
};
__device__ __forceinline__ void fill_tab_A(LAS float* tab, int h, int r, int tid) {
    const float sl2 = exp2f(-0.5f * (float)(2 * h + 1)) * LOG2E;
    for (int idx = tid; idx < 1024; idx += NWAVES * 64) { const int dl = idx - 256; float v = ATT_NEG;
        if (dl >= 0 && dl <= 512) { const int w = (dl <= 32 ? 1 : 0) + (dl <= 128 ? 1 : 0) + ((dl & 3) == 0 ? 1 : 0);
            if (w > 0) v = (w == 1 ? 0.f : (w == 2 ? 1.f : 1.5849625007211562f)) - sl2 * (float)(4 * dl); }
        tab[idx] = v; }
    for (int idx = tid; idx < 3 * 576; idx += NWAVES * 64) { const int k = 1 + idx / 576, dl = idx % 576 - 256; const int rho = (r + k) & 3; const int dist = 4 * dl + (r - rho);
        tab[1024 + idx] = (dist >= 0 && dist <= 128) ? -sl2 * (float)dist : ATT_NEG; }
}

struct PolB {
    int b, i, NT, dq0, hi; unsigned sel; float sl2;
    __device__ __forceinline__ long row0(int t) const { return (long)b * SEQ + 64 * t; }
    __device__ __forceinline__ long qrow(int wid, int r32) const { return (long)b * SEQ + 256 * i + 32 * wid + r32; }
    __device__ __forceinline__ long orow(int wid, int row) const { return (long)b * SEQ + 256 * i + 32 * wid + row; }
    __device__ __forceinline__ bool active(int t, int) const { return __any((int)((sel >> (t >> 2)) & 1u)) != 0; }
    __device__ __forceinline__ void cinit(int t, f32x16& p0, f32x16& p1) const {
        const int dqi = 64 * t + dq0;
        float base = sl2 * (float)dqi; if (!((sel >> (t >> 2)) & 1u)) base = ATT_NEG;
        const float base1 = base + 32.0f * sl2;
#pragma unroll
        for (int rr = 0; rr < 16; ++rr) { const int c = (rr & 3) + 8 * (rr >> 2); p0[rr] = base + sl2 * (float)c; p1[rr] = base1 + sl2 * (float)c; }
        if (t >= 4 * i) {
            asm volatile("; causal band tile" ::: "memory");
#pragma unroll
            for (int rr = 0; rr < 16; ++rr) { const int c = (rr & 3) + 8 * (rr >> 2); if (dqi + c > 0) p0[rr] = ATT_NEG; if (dqi + c + 32 > 0) p1[rr] = ATT_NEG; }
        }
    }
    __device__ __forceinline__ void select(const bf16x8 (&qr)[4], LAS const float* km) {
        float qf[32];
#pragma unroll
        for (int d0 = 0; d0 < 4; ++d0)
#pragma unroll
            for (int j = 0; j < 8; ++j) qf[8 * d0 + j] = __uint_as_float((unsigned)(unsigned short)qr[d0][j] << 16);
        int i0 = -1, i1 = -1, i2 = -1; float g0 = ATT_NEG, g1 = ATT_NEG, g2 = ATT_NEG;
        for (int n = 0; n < i; ++n) { float g = 0.f;
#pragma unroll
            for (int d0 = 0; d0 < 4; ++d0) { const f32x4 ka = *(LAS const f32x4*)(km + n * 64 + 16 * d0 + 8 * hi), kb = *(LAS const f32x4*)(km + n * 64 + 16 * d0 + 8 * hi + 4);
                g += (qf[8 * d0 + 0] * ka.x + qf[8 * d0 + 1] * ka.y) + (qf[8 * d0 + 2] * ka.z + qf[8 * d0 + 3] * ka.w) + (qf[8 * d0 + 4] * kb.x + qf[8 * d0 + 5] * kb.y) + (qf[8 * d0 + 6] * kb.z + qf[8 * d0 + 7] * kb.w); }
            g += __shfl_xor(g, 32);
            if (g > g0) { g2 = g1; i2 = i1; g1 = g0; i1 = i0; g0 = g; i0 = n; } else if (g > g1) { g2 = g1; i2 = i1; g1 = g; i1 = n; } else if (g > g2) { g2 = g; i2 = n; } }
        sel = 1u << i; if (i0 >= 0) sel |= 1u << i0; if (i1 >= 0) sel |= 1u << i1; if (i2 >= 0) sel |= 1u << i2;
    }
};

template <class P, bool SELECT>
__device__ __forceinline__ void attn_unit(P& pol, const bf16* Qc, const bf16* Kc, const bf16* Vc, bf16* Oc, float* ssq, int hh, LAS unsigned char* shm, LAS const float* km) {
    int tid = threadIdx.x; asm volatile("" : "+v"(tid)); const int lane = tid & 63, r32 = lane & 31, hi = lane >> 5; const int wid = __builtin_amdgcn_readfirstlane(tid >> 6);
    const unsigned lds0 = (unsigned)(uintptr_t)shm;
    LAS float* wsf = (LAS float*)(shm + L_WS) + wid * 64;
    const int NT = pol.NT;
    const bf16* ksrc = Kc + (long)lane * D + wid * 8;
    const bf16* vsrc = Vc + (long)(16 * (wid & 3) + (lane >> 2)) * D + (wid >> 2) * 32 + (lane & 3) * 8;
    const unsigned kdst = lds0 + L_K + wid * 1024, vdst = lds0 + L_V + wid * 1024;
#define ATT_DMA(t, slot) do { const long r0_ = pol.row0(t); glds16(ksrc + r0_ * D, (unsigned)__builtin_amdgcn_readfirstlane(kdst + (slot))); glds16(vsrc + r0_ * D, (unsigned)__builtin_amdgcn_readfirstlane(vdst + (slot))); } while (0)
    bf16x8 qr[4];
    { const bf16* qp = Qc + pol.qrow(wid, r32) * D + hi * 8;
#pragma unroll
      for (int d0 = 0; d0 < 4; ++d0) qr[d0] = *(const bf16x8*)(qp + d0 * 16); }
    ATT_DMA(0, 0); ATT_DMA(1, SLOTB); ATT_DMA(2, 2 * SLOTB);
    if constexpr (SELECT) pol.select(qr, km);
    f32x16 o[2]; o[0] = f32x16{}; o[1] = f32x16{}; float l_reg = 0.f;
    const lds_cptr kp0 = (lds_cptr)shm + L_K + hi * 1024 + r32 * 16;
    const int vb0 = (int)(lds0 + L_V) + ((lane >> 4) & 1) * 32 + (lane & 3) * 8 + (4 * hi + ((lane & 15) >> 2)) * 64;
#define ATT_EXP(P0, P1) do { _Pragma("unroll") for (int rr = 0; rr < 16; ++rr) { P0[rr] = __builtin_amdgcn_exp2f(P0[rr]); P1[rr] = __builtin_amdgcn_exp2f(P1[rr]); } } while (0)
#define ATT_SOFTMAX_PV(P0, P1, slotoff) do { float sacc = 0.f; \
        _Pragma("unroll") for (int rr = 0; rr < 16; ++rr) { sacc += P0[rr] + P1[rr]; } \
        l_reg += sacc; \
        const u32x4 pw0 = (u32x4){cvtpk_s(P0[0], P0[1]), cvtpk_s(P0[2], P0[3]), cvtpk_s(P0[4], P0[5]), cvtpk_s(P0[6], P0[7])}; \
        const u32x4 pw1 = (u32x4){cvtpk_s(P0[8], P0[9]), cvtpk_s(P0[10], P0[11]), cvtpk_s(P0[12], P0[13]), cvtpk_s(P0[14], P0[15])}; \
        const u32x4 pw2 = (u32x4){cvtpk_s(P1[0], P1[1]), cvtpk_s(P1[2], P1[3]), cvtpk_s(P1[4], P1[5]), cvtpk_s(P1[6], P1[7])}; \
        const u32x4 pw3 = (u32x4){cvtpk_s(P1[8], P1[9]), cvtpk_s(P1[10], P1[11]), cvtpk_s(P1[12], P1[13]), cvtpk_s(P1[14], P1[15])}; \
        ATT_SBAR(); pv(o, vb0 + (slotoff), __builtin_bit_cast(bf16x8, pw0), __builtin_bit_cast(bf16x8, pw1), __builtin_bit_cast(bf16x8, pw2), __builtin_bit_cast(bf16x8, pw3)); ATT_SBAR(); } while (0)
#define ATT_BODY(PC0, PC1, PN0, PN1, t) do { \
        if ((t) + 2 < NT) { ATT_WAIT_BAR(2); } else { ATT_WAIT_BAR(0); } \
        if ((t) + 3 < NT) ATT_DMA((t) + 3, (((t) + 3) & 3) * SLOTB); \
        const bool an_ = ((t) + 1 < NT) && pol.active((t) + 1, wid); const int tn_ = ((t) + 1 < NT) ? (t) + 1 : (t); \
        if (acur || an_) { pol.cinit(tn_, PN0, PN1); ATT_SBAR(); qkt(PN0, PN1, kp0 + (tn_ & 3) * SLOTB, qr); ATT_EXP(PC0, PC1); ATT_SBAR(); ATT_SOFTMAX_PV(PC0, PC1, ((t) & 3) * SLOTB); } \
        else { _Pragma("unroll") for (int rr = 0; rr < 16; ++rr) { PN0[rr] = ATT_NEG; PN1[rr] = ATT_NEG; } } \
        acur = an_; } while (0)
    f32x16 pA0, pA1, pB0, pB1;
    asm volatile("s_waitcnt vmcnt(4) lgkmcnt(0)\n\ts_barrier" ::: "memory");
    bool acur = pol.active(0, wid);
    { pol.cinit(0, pA0, pA1); qkt(pA0, pA1, kp0, qr); }
    for (int t = 0; t < NT; t += 2) {
        ATT_BODY(pA0, pA1, pB0, pB1, t);
        if (t + 1 < NT) ATT_BODY(pB0, pB1, pA0, pA1, t + 1);
    }
    if constexpr (!SELECT) {
        const bool even = !(wid & 1); const int sA = even ? (wid >> 1) : ((wid + 1) >> 1), sB = even ? sA + 1 : sA;
        const lds_cptr kpA = kp0 + sA * SLOTB + (even ? 512 : 0), kpB = kp0 + sB * SLOTB + (even ? 0 : 512);
        const int vbA = vb0 + sA * SLOTB + (even ? 2048 : 0), vbB = vb0 + sB * SLOTB - (even ? 2048 : 0);
        for (int k = 1; k <= 3; ++k) {
            const long rowk = (long)pol.b * SEQ + ((pol.r + k) & 3) * 1024 + pol.T0 - 64;
            asm volatile("s_waitcnt lgkmcnt(0)\n\ts_barrier" ::: "memory");
            for (int j = pol.jpmin; j < 5; ++j) { glds16(ksrc + (rowk + 64 * j) * D, (unsigned)__builtin_amdgcn_readfirstlane(kdst + j * SLOTB)); glds16(vsrc + (rowk + 64 * j) * D, (unsigned)__builtin_amdgcn_readfirstlane(vdst + j * SLOTB)); }
            f32x16 p0, p1;
            { LAS const float* tb = pol.tab + 1024 + (k - 1) * 576 + (r32 + 32 - 4 * hi + 256 - 63);
#pragma unroll
              for (int rr = 0; rr < 16; ++rr) { const int c = (rr & 3) + 8 * (rr >> 2); p0[rr] = tb[63 - c]; p1[rr] = tb[31 - c]; }
              if (pol.T0 == 0 && wid == 0) {
#pragma unroll
                  for (int rr = 0; rr < 16; ++rr) p0[rr] = ATT_NEG; } }
            asm volatile("s_waitcnt vmcnt(0) lgkmcnt(0)\n\ts_barrier" ::: "memory");
            qkt2(p0, p1, kpA, kpB, qr);
            float sacc = 0.f;
#pragma unroll
            for (int rr = 0; rr < 16; ++rr) { p0[rr] = __builtin_amdgcn_exp2f(p0[rr]); p1[rr] = __builtin_amdgcn_exp2f(p1[rr]); sacc += p0[rr] + p1[rr]; }
            l_reg += sacc;
            const u32x4 pw0 = (u32x4){cvtpk_s(p0[0], p0[1]), cvtpk_s(p0[2], p0[3]), cvtpk_s(p0[4], p0[5]), cvtpk_s(p0[6], p0[7])};
            const u32x4 pw1 = (u32x4){cvtpk_s(p0[8], p0[9]), cvtpk_s(p0[10], p0[11]), cvtpk_s(p0[12], p0[13]), cvtpk_s(p0[14], p0[15])};
            const u32x4 pw2 = (u32x4){cvtpk_s(p1[0], p1[1]), cvtpk_s(p1[2], p1[3]), cvtpk_s(p1[4], p1[5]), cvtpk_s(p1[6], p1[7])};
            const u32x4 pw3 = (u32x4){cvtpk_s(p1[8], p1[9]), cvtpk_s(p1[10], p1[11]), cvtpk_s(p1[12], p1[13]), cvtpk_s(p1[14], p1[15])};
            ATT_SBAR();
            pv2(o, vbA, vbB, __builtin_bit_cast(bf16x8, pw0), __builtin_bit_cast(bf16x8, pw1), __builtin_bit_cast(bf16x8, pw2), __builtin_bit_cast(bf16x8, pw3));
        }
    }
#undef ATT_BODY
#undef ATT_SOFTMAX_PV
#undef ATT_EXP
#undef ATT_DMA
    l_reg += __shfl_xor(l_reg, 32);
    if (hi == 0) wsf[32 + r32] = l_reg;
    asm volatile("s_waitcnt lgkmcnt(0)" ::: "memory");
    float rli[16];
#pragma unroll
    for (int rr = 0; rr < 16; ++rr) rli[rr] = 1.0f / wsf[32 + crow(rr, hi)];
    { LAS unsigned short* stg = (LAS unsigned short*)(shm + L_OST) + wid * 2048;
#pragma unroll
      for (int rr = 0; rr < 16; ++rr) { const int orow = crow(rr, hi);
#pragma unroll
          for (int d0 = 0; d0 < 2; ++d0) stg[orow * 64 + d0 * 32 + r32] = (unsigned short)f2bf(o[d0][rr] * rli[rr]); }
      asm volatile("s_waitcnt lgkmcnt(0)" ::: "memory");
#pragma unroll
      for (int i4 = 0; i4 < 4; ++i4) { const int row = i4 * 8 + (lane >> 3), ch = lane & 7; const u32x4 v = *(LAS const u32x4*)(stg + row * 64 + ch * 8);
          const long grow = pol.orow(wid, row);
          *(u32x4*)(Oc + grow * D + ch * 8) = v;
          float ss = 0.f;
#pragma unroll
          for (int e = 0; e < 4; ++e) { const float a = __uint_as_float(v[e] << 16), c = __uint_as_float(v[e] & 0xffff0000u); ss += a * a + c * c; }
          ss += __shfl_xor(ss, 1); ss += __shfl_xor(ss, 2); ss += __shfl_xor(ss, 4);
          if (ch == 0) ssq[grow * 16 + hh] = ss; } }
    asm volatile("s_waitcnt vmcnt(0) lgkmcnt(0)\n\ts_barrier" ::: "memory");
}


constexpr int M_NSLOT = 3;
constexpr int M_K = 0, M_V = M_NSLOT * SLOTB;
static_assert(2 * M_NSLOT * SLOTB <= L_WS, "MoBA rings fit in front of the per-wave scratch");
__device__ __forceinline__ void kload8(bf16x8* kf, lds_cptr kp) {
    kf[0] = *(LAS const bf16x8*)(kp);        kf[1] = *(LAS const bf16x8*)(kp + 512);
    kf[2] = *(LAS const bf16x8*)(kp + 2048); kf[3] = *(LAS const bf16x8*)(kp + 2560);
    kf[4] = *(LAS const bf16x8*)(kp + 4096); kf[5] = *(LAS const bf16x8*)(kp + 4608);
    kf[6] = *(LAS const bf16x8*)(kp + 6144); kf[7] = *(LAS const bf16x8*)(kp + 6656);
}
__device__ __forceinline__ void kload2(bf16x8* kf, lds_cptr kp, int j) { kf[2 * j] = *(LAS const bf16x8*)(kp + j * 2048); kf[2 * j + 1] = *(LAS const bf16x8*)(kp + j * 2048 + 512); }
__device__ __forceinline__ s16x4 vtr(lds_cptr p) { return __builtin_bit_cast(s16x4, __builtin_amdgcn_ds_read_tr16_b64_v4i16((LAS v4i16_t*)p)); }

__device__ __forceinline__ void attn_unit_moba(PolB& pol, const bf16* Qc, const bf16* Kc, const bf16* Vc, bf16* Oc, float* ssq, int hh, LAS unsigned char* shm, LAS const float* km) {
    int tid = threadIdx.x; asm volatile("" : "+v"(tid)); const int lane = tid & 63, r32 = lane & 31, hi = lane >> 5; const int wid = __builtin_amdgcn_readfirstlane(tid >> 6);
    const unsigned lds0 = (unsigned)(uintptr_t)shm;
    LAS float* wsf = (LAS float*)(shm + L_WS) + wid * 64;
    const int NT = pol.NT;
    const bf16* ksrc = Kc + ((long)pol.b * SEQ + lane) * D + wid * 8;
    const bf16* vsrc = Vc + ((long)pol.b * SEQ + 16 * (wid & 3) + (lane >> 2)) * D + (wid >> 2) * 32 + (lane & 3) * 8;
    const unsigned kdst = lds0 + M_K + wid * 1024, vdst = lds0 + M_V + wid * 1024;
#define DMA_K(t, slot) glds16(ksrc + (long)(t) * 64 * D, (unsigned)__builtin_amdgcn_readfirstlane(kdst + (slot)))
#define DMA_V(t, slot) glds16(vsrc + (long)(t) * 64 * D, (unsigned)__builtin_amdgcn_readfirstlane(vdst + (slot)))
    bf16x8 qr[4];
    { const bf16* qp = Qc + pol.qrow(wid, r32) * D + hi * 8;
#pragma unroll
      for (int d0 = 0; d0 < 4; ++d0) qr[d0] = *(const bf16x8*)(qp + d0 * 16); }
    DMA_K(0, 0); DMA_V(0, 0); DMA_K(1, SLOTB); DMA_K(2, 2 * SLOTB);
    pol.select(qr, km);
    const lds_cptr shm3 = (lds_cptr)shm; const lds_cptr kp0 = shm3 + M_K + hi * 1024 + r32 * 16; const lds_cptr vp0 = shm3 + M_V + ((lane >> 4) & 1) * 32 + (lane & 3) * 8 + (4 * hi + ((lane & 15) >> 2)) * 64;
    f32x16 o[2]; o[0] = f32x16{}; o[1] = f32x16{}; float l_reg = 0.f;
    bf16x8 kf[8];
    f32x16 pA0, pA1, pB0, pB1;
    int sl_prev = 0, sl_cur = 0, sl_next = SLOTB;
#define ROT() do { sl_prev = sl_cur; sl_cur = sl_next; sl_next = (sl_next == (M_NSLOT - 1) * SLOTB) ? 0 : sl_next + SLOTB; } while (0)
    const float sl2 = pol.sl2, s8 = 8.0f * pol.sl2; const int dq0 = pol.dq0; const unsigned sel = pol.sel; const int i4 = 4 * pol.i;
#define CBASE(tt) const int dqi_ = 64 * (tt) + dq0; float cb0_ = sl2 * (float)dqi_; if (!((sel >> ((tt) >> 2)) & 1u)) cb0_ = ATT_NEG; float cb1_ = cb0_ + 32.0f * sl2
#define CEL(X, B, cb, off, BAND) do { float v0_ = (cb), v1_ = v0_ + sl2, v2_ = v1_ + sl2, v3_ = v2_ + sl2; (cb) = v0_ + s8; \
        if (BAND) { const int c_ = 8 * ((B) >> 2) + (off); if (dqi_ + c_ > 0) v0_ = ATT_NEG; if (dqi_ + c_ + 1 > 0) v1_ = ATT_NEG; if (dqi_ + c_ + 2 > 0) v2_ = ATT_NEG; if (dqi_ + c_ + 3 > 0) v3_ = ATT_NEG; } \
        X[(B)] = v0_; X[(B) + 1] = v1_; X[(B) + 2] = v2_; X[(B) + 3] = v3_; } while (0)
    asm volatile("s_waitcnt vmcnt(3) lgkmcnt(0)\n\ts_barrier" ::: "memory");
    { CBASE(0); const bool band0 = (i4 == 0);
#pragma unroll
      for (int b4 = 0; b4 < 16; b4 += 4) { if (band0) { CEL(pA0, b4, cb0_, 0, true); CEL(pA1, b4, cb1_, 32, true); } else { CEL(pA0, b4, cb0_, 0, false); CEL(pA1, b4, cb1_, 32, false); } }
      qkt(pA0, pA1, kp0, qr);
#pragma unroll
      for (int rr = 0; rr < 16; ++rr) { pA0[rr] = __builtin_amdgcn_exp2f(pA0[rr]); pA1[rr] = __builtin_amdgcn_exp2f(pA1[rr]); } }
    { CBASE(1); const bool band1 = (1 >= i4);
#pragma unroll
      for (int b4 = 0; b4 < 16; b4 += 4) { if (band1) { CEL(pB0, b4, cb0_, 0, true); CEL(pB1, b4, cb1_, 32, true); } else { CEL(pB0, b4, cb0_, 0, false); CEL(pB1, b4, cb1_, 32, false); } } }
    asm volatile("s_waitcnt vmcnt(0) lgkmcnt(0)\n\ts_barrier" ::: "memory");
    DMA_K(3, 0); DMA_V(1, SLOTB);
    ROT();
    kload8(kf, kp0 + sl_cur);
    asm volatile("s_waitcnt vmcnt(2) lgkmcnt(0)\n\ts_barrier" ::: "memory");
    s16x4 vlo[8], vhi[8]; u32x4 pw0, pw1, pw2, pw3;
#define PKW(P, B) cvtpk_s(P[B], P[B + 1])
#define PAF(k) __builtin_bit_cast(bf16x8, pw##k)
#define VFR(i) (bf16x8){vlo[i][0], vlo[i][1], vlo[i][2], vlo[i][3], vhi[i][0], vhi[i][1], vhi[i][2], vhi[i][3]}
#define PIN(x) asm volatile("" : "+v"(x))
#define GAPA(MF, A0, A1, A2, A3, W0, W1, PW) do { MF; sacc += A0; sacc += A1; sacc += A2; sacc += A3; PIN(sacc); W0; W1; PIN(PW); ATT_SBAR(); } while (0)
#define EX(v) __builtin_amdgcn_exp2f(v)
#define GAPB(MF, X, B, Y, CB_, OFF_, CI, BAND) do { MF; X[B] = EX(X[B]); X[B + 1] = EX(X[B + 1]); X[B + 2] = EX(X[B + 2]); X[B + 3] = EX(X[B + 3]); PIN(X); if (CI) { CEL(Y, B, CB_, OFF_, BAND); PIN(Y); } ATT_SBAR(); } while (0)
#define VRD(i) do { vlo[i] = vtr(vp_ + (((i) >> 2) * 4096 + ((i) & 3) * 1024)); vhi[i] = vtr(vp_ + (((i) >> 2) * 4096 + ((i) & 3) * 1024 + 512)); } while (0)
#define KRD(G, j) do { if (G) { kload2(kf, kp0 + sl_next, j); ATT_SBAR(); } } while (0)
#define STEP(C0, C1, P0, P1, t, GK, GV, GL, CI, BAND) do { ATT_SBAR(); \
    const lds_cptr vp_ = vp0 + sl_prev; CBASE((t) + 1); \
    VRD(0); ATT_SBAR(); float sacc = (P0[0] + P0[1]); \
    GAPA(C0 = __builtin_amdgcn_mfma_f32_32x32x16_bf16(kf[0], qr[0], C0, 0, 0, 0), P0[2], P0[3], P0[4], P0[5],     pw0[0] = PKW(P0, 0), pw0[1] = PKW(P0, 2), pw0); \
    VRD(4); ATT_SBAR(); GAPA(C1 = __builtin_amdgcn_mfma_f32_32x32x16_bf16(kf[1], qr[0], C1, 0, 0, 0), P0[6], P0[7], P0[8], P0[9],     pw0[2] = PKW(P0, 4), pw0[3] = PKW(P0, 6), pw0); \
    VRD(1); ATT_SBAR(); GAPA(C0 = __builtin_amdgcn_mfma_f32_32x32x16_bf16(kf[2], qr[1], C0, 0, 0, 0), P0[10], P0[11], P0[12], P0[13], pw1[0] = PKW(P0, 8), pw1[1] = PKW(P0, 10), pw1); \
    VRD(5); ATT_SBAR(); GAPA(C1 = __builtin_amdgcn_mfma_f32_32x32x16_bf16(kf[3], qr[1], C1, 0, 0, 0), P0[14], P0[15], P1[0], P1[1],   pw1[2] = PKW(P0, 12), pw1[3] = PKW(P0, 14), pw1); \
    VRD(2); ATT_SBAR(); GAPA(C0 = __builtin_amdgcn_mfma_f32_32x32x16_bf16(kf[4], qr[2], C0, 0, 0, 0), P1[2], P1[3], P1[4], P1[5],     pw2[0] = PKW(P1, 0), pw2[1] = PKW(P1, 2), pw2); \
    VRD(6); ATT_SBAR(); GAPA(C1 = __builtin_amdgcn_mfma_f32_32x32x16_bf16(kf[5], qr[2], C1, 0, 0, 0), P1[6], P1[7], P1[8], P1[9],     pw2[2] = PKW(P1, 4), pw2[3] = PKW(P1, 6), pw2); \
    VRD(3); ATT_SBAR(); GAPA(C0 = __builtin_amdgcn_mfma_f32_32x32x16_bf16(kf[6], qr[3], C0, 0, 0, 0), P1[10], P1[11], P1[12], P1[13], pw3[0] = PKW(P1, 8), pw3[1] = PKW(P1, 10), pw3); \
    VRD(7); ATT_SBAR(); GAPA(C1 = __builtin_amdgcn_mfma_f32_32x32x16_bf16(kf[7], qr[3], C1, 0, 0, 0), P1[14], P1[15], 0.f, 0.f,       pw3[2] = PKW(P1, 12), pw3[3] = PKW(P1, 14), pw3); \
    l_reg += sacc; \
    if (GK) { DMA_K((t) + 3, sl_cur); } if (GV) { DMA_V((t) + 1, sl_next); } \
    ATT_SBAR(); \
    GAPB(o[0] = __builtin_amdgcn_mfma_f32_32x32x16_bf16(PAF(0), VFR(0), o[0], 0, 0, 0), C0, 0, P0, cb0_, 0, CI, BAND); \
    GAPB(o[1] = __builtin_amdgcn_mfma_f32_32x32x16_bf16(PAF(0), VFR(4), o[1], 0, 0, 0), C0, 4, P0, cb0_, 0, CI, BAND); \
    KRD(GL, 0); GAPB(o[0] = __builtin_amdgcn_mfma_f32_32x32x16_bf16(PAF(1), VFR(1), o[0], 0, 0, 0), C0, 8, P0, cb0_, 0, CI, BAND); \
    KRD(GL, 1); GAPB(o[1] = __builtin_amdgcn_mfma_f32_32x32x16_bf16(PAF(1), VFR(5), o[1], 0, 0, 0), C0, 12, P0, cb0_, 0, CI, BAND); \
    KRD(GL, 2); GAPB(o[0] = __builtin_amdgcn_mfma_f32_32x32x16_bf16(PAF(2), VFR(2), o[0], 0, 0, 0), C1, 0, P1, cb1_, 32, CI, BAND); \
    KRD(GL, 3); GAPB(o[1] = __builtin_amdgcn_mfma_f32_32x32x16_bf16(PAF(2), VFR(6), o[1], 0, 0, 0), C1, 4, P1, cb1_, 32, CI, BAND); \
    GAPB(o[0] = __builtin_amdgcn_mfma_f32_32x32x16_bf16(PAF(3), VFR(3), o[0], 0, 0, 0), C1, 8, P1, cb1_, 32, CI, BAND); \
    GAPB(o[1] = __builtin_amdgcn_mfma_f32_32x32x16_bf16(PAF(3), VFR(7), o[1], 0, 0, 0), C1, 12, P1, cb1_, 32, CI, BAND); \
    } while (0)
#define M_WAIT_BAR(N) asm volatile("s_waitcnt vmcnt(" #N ") lgkmcnt(0)\n\ts_barrier" ::: "memory")
    int t = 1;
    for (; t + 5 < NT; t += 2) {
        STEP(pB0, pB1, pA0, pA1, t, true, true, true, true, false);     M_WAIT_BAR(2); ROT();
        STEP(pA0, pA1, pB0, pB1, t + 1, true, true, true, true, false); M_WAIT_BAR(2); ROT();
    }
#define ENDW(tt) do { if ((tt) + 3 < NT) { M_WAIT_BAR(2); } else if ((tt) + 2 < NT) { M_WAIT_BAR(1); } else { M_WAIT_BAR(0); } } while (0)
    for (; t + 1 < NT; t += 2) {
        STEP(pB0, pB1, pA0, pA1, t, (t + 3 < NT), (t + 1 < NT), (t + 1 < NT), true, true);       ENDW(t);     ROT();
        STEP(pA0, pA1, pB0, pB1, t + 1, (t + 4 < NT), (t + 2 < NT), (t + 2 < NT), (t + 2 < NT), true); ENDW(t + 1); ROT();
    }
    STEP(pB0, pB1, pA0, pA1, NT - 1, false, false, false, false, false);
    { float sacc = pB0[0] + pB0[1];
#pragma unroll
      for (int rr = 2; rr < 16; ++rr) sacc += pB0[rr];
#pragma unroll
      for (int rr = 0; rr < 16; ++rr) sacc += pB1[rr];
      l_reg += sacc;
      pw0 = (u32x4){PKW(pB0, 0), PKW(pB0, 2), PKW(pB0, 4), PKW(pB0, 6)}; pw1 = (u32x4){PKW(pB0, 8), PKW(pB0, 10), PKW(pB0, 12), PKW(pB0, 14)};
      pw2 = (u32x4){PKW(pB1, 0), PKW(pB1, 2), PKW(pB1, 4), PKW(pB1, 6)}; pw3 = (u32x4){PKW(pB1, 8), PKW(pB1, 10), PKW(pB1, 12), PKW(pB1, 14)};
      ATT_SBAR(); pv(o, (int)(lds0 + M_V) + ((lane >> 4) & 1) * 32 + (lane & 3) * 8 + (4 * hi + ((lane & 15) >> 2)) * 64 + sl_cur, PAF(0), PAF(1), PAF(2), PAF(3)); }
#undef PKW
#undef PAF
#undef VFR
#undef PIN
#undef GAPA
#undef GAPB
#undef EX
#undef VRD
#undef KRD
#undef STEP
#undef ENDW
#undef M_WAIT_BAR
#undef CBASE
#undef CEL
#undef ROT
#undef DMA_K
#undef DMA_V
    l_reg += __shfl_xor(l_reg, 32);
    if (hi == 0) wsf[32 + r32] = l_reg;
    asm volatile("s_waitcnt lgkmcnt(0)" ::: "memory");
    float rli[16];
#pragma unroll
    for (int rr = 0; rr < 16; ++rr) rli[rr] = 1.0f / wsf[32 + crow(rr, hi)];
    { LAS unsigned short* stg = (LAS unsigned short*)(shm + L_OST) + wid * 2048;
#pragma unroll
      for (int rr = 0; rr < 16; ++rr) { const int orow = crow(rr, hi);
#pragma unroll
          for (int d0 = 0; d0 < 2; ++d0) stg[orow * 64 + d0 * 32 + r32] = (unsigned short)f2bf(o[d0][rr] * rli[rr]); }
      asm volatile("s_waitcnt lgkmcnt(0)" ::: "memory");
#pragma unroll
      for (int i4_ = 0; i4_ < 4; ++i4_) { const int row = i4_ * 8 + (lane >> 3), ch = lane & 7; const u32x4 v = *(LAS const u32x4*)(stg + row * 64 + ch * 8);
          const long grow = pol.orow(wid, row);
          *(u32x4*)(Oc + grow * D + ch * 8) = v;
          float ss = 0.f;
#pragma unroll
          for (int e = 0; e < 4; ++e) { const float a = __uint_as_float(v[e] << 16), c = __uint_as_float(v[e] & 0xffff0000u); ss += a * a + c * c; }
          ss += __shfl_xor(ss, 1); ss += __shfl_xor(ss, 2); ss += __shfl_xor(ss, 4);
          if (ch == 0) ssq[grow * 16 + hh] = ss; } }
    asm volatile("s_waitcnt vmcnt(0) lgkmcnt(0)\n\ts_barrier" ::: "memory");
}

__device__ __forceinline__ void attn_phase(Frame& F) {
    LAS unsigned char* shm = F.lds + RING_OFF;
    LAS float* tab = (LAS float*)(shm + L_TAB);
    int tid_a = threadIdx.x; asm volatile("" : "+v"(tid_a)); const int r32 = tid_a & 31, hi = (tid_a >> 5) & 1;
    for (int su = F.vcu; su < 256; su += F.G) {
        const int b = su >> 5, h = (su >> 2) & 7, r = su & 3;
        fill_tab_A(tab, h, r, F.tid);
        asm volatile("s_waitcnt lgkmcnt(0)\n\ts_barrier" ::: "memory");
        for (int Tb = 0; Tb < 4; ++Tb) { PolA pol; pol.init(b, r, Tb, F.wave, r32, hi, tab);
            attn_unit<PolA, false>(pol, F.QB + h * 64, F.KB + h * 64, F.VB + h * 64, F.OB + h * 64, F.ssq0, h, shm, nullptr); }
    }
    for (int su = F.vcu; su < 256; su += F.G) {
        const int b = su >> 5, h = (su >> 2) & 7, qt = su & 3;
        for (int idx = F.tid; idx < 1024; idx += NWAVES * 64) { const int n = idx >> 6, d = idx & 63; const float* kp = F.kpart + (size_t)((b * 16 + n) * 2) * 512 + h * 64 + d; tab[idx] = kp[0] + kp[512]; }
        asm volatile("s_waitcnt vmcnt(0) lgkmcnt(0)\n\ts_barrier" ::: "memory");
        for (int u4 = 0; u4 < 4; ++u4) { const int s = 2 * qt + (u4 >> 1); const int i = (u4 & 1) ? 15 - s : s;
            PolB pol; pol.b = b; pol.i = i; pol.NT = 4 * (i + 1); pol.hi = hi; pol.dq0 = 4 * hi - (256 * i + 32 * F.wave + r32); pol.sl2 = exp2f(-(float)(h + 1)) * LOG2E; pol.sel = 0u;
            attn_unit_moba(pol, F.QB + 512 + h * 64, F.KB + 512 + h * 64, F.VB + 512 + h * 64, F.OB + 512 + h * 64, F.ssq0, 8 + h, shm, tab); }
    }
}
#undef ATT_WAIT_BAR
#undef ATT_SBAR
}

__device__ __forceinline__ void final_norm(Frame& F) {
    int tid_f = threadIdx.x; asm volatile("" : "+v"(tid_f)); const int lane_f = tid_f & 63;
    const int gw = F.vcu * NWAVES + F.wave, NGW = F.G * NWAVES;
    f32x4 g[2][2];
#pragma unroll
    for (int j = 0; j < 2; ++j) { g[j][0] = *(const GAS f32x4*)(F.g_final + 512 * j + 8 * lane_f); g[j][1] = *(const GAS f32x4*)(F.g_final + 512 * j + 8 * lane_f + 4); }
    for (int m = gw; m < M; m += NGW) {
        const GAS f32x4* sp = (const GAS f32x4*)(F.ssq3 + (size_t)m * 16);
        const f32x4 a = sp[0], b = sp[1], c = sp[2], d = sp[3];
        const float s = ((a.x + a.y) + (a.z + a.w)) + ((b.x + b.y) + (b.z + b.w)) + ((c.x + c.y) + (c.z + c.w)) + ((d.x + d.y) + (d.z + d.w));
        const float rstd = 1.f / sqrtf(s * (1.f / D) + EPS);
#pragma unroll
        for (int j = 0; j < 2; ++j) { const v4u w = *(const GAS v4u*)(F.XN + (size_t)m * D + 512 * j + 8 * lane_f);
            f32x4 o0 = (f32x4){__uint_as_float(w.x << 16), __uint_as_float(w.x & 0xffff0000u), __uint_as_float(w.y << 16), __uint_as_float(w.y & 0xffff0000u)};
            f32x4 o1 = (f32x4){__uint_as_float(w.z << 16), __uint_as_float(w.z & 0xffff0000u), __uint_as_float(w.w << 16), __uint_as_float(w.w & 0xffff0000u)};
            GAS f32x4* op = (GAS f32x4*)(F.out + (size_t)m * D + 512 * j + 8 * lane_f);
            op[0] = o0 * rstd * g[j][0]; op[1] = o1 * rstd * g[j][1]; }
    }
}

struct Args { const float* in[15]; float* out; unsigned char* ws; int ph_lo, ph_hi, li, pad; };
__global__ void __launch_bounds__(NWAVES * 64, 2) mk_fwd(Args args) {
    extern __shared__ __attribute__((aligned(16))) unsigned char lds[];
    Frame F;
    F.lds = (LAS unsigned char*)lds;
    F.MISC = (volatile LAS unsigned*)(F.lds + MISC_OFF);
    F.tid = threadIdx.x; F.lane = F.tid & 63; F.wave = __builtin_amdgcn_readfirstlane(F.tid >> 6);
    F.G = gridDim.x; { const int bx = blockIdx.x; F.vcu = (F.G % 8 == 0) ? (bx % 8) * (F.G / 8) + bx / 8 : bx; }
    unsigned char* ws = args.ws;
    F.ctl = (gu32*)(ws + WS_CTL);
    F.x = args.in[0]; F.p = args.in[1]; F.g_attn = args.in[2]; F.w_in = args.in[3]; F.g_out_a = args.in[4]; F.g_out_b = args.in[5]; F.w_out = args.in[6]; F.g_mlp = args.in[7];
    F.w_up = args.in[8]; F.w_down = args.in[9]; F.g_ple = args.in[10]; F.w_gate = args.in[11]; F.b_gate = args.in[12]; F.w_proj = args.in[13]; F.g_final = args.in[14]; F.out = args.out;
    F.Wqkv_t = (bf16*)(ws + WS_WQKV); F.Wo_t = (bf16*)(ws + WS_WO); F.Wup_t = (bf16*)(ws + WS_WUP); F.Wdn_t = (bf16*)(ws + WS_WDN); F.Wg_t = (bf16*)(ws + WS_WG); F.Wp_t = (bf16*)(ws + WS_WP);
    F.XN = (bf16*)(ws + WS_XN); F.QB = (bf16*)(ws + WS_Q); F.KB = (bf16*)(ws + WS_K); F.VB = (bf16*)(ws + WS_V); F.OB = (bf16*)(ws + WS_O); F.UB = (bf16*)(ws + WS_U); F.PB = (bf16*)(ws + WS_PB); F.PP = (bf16*)(ws + WS_PP);
    F.ssq0 = (float*)(ws + WS_SSQ0); F.ssq1 = (float*)(ws + WS_SSQ1); F.ssq2 = (float*)(ws + WS_SSQ2); F.ssq3 = (float*)(ws + WS_SSQ3); F.kpart = (float*)(ws + WS_KPART); F.invr0 = (float*)(ws + WS_INVR);
    for (int u = F.tid; u < (LDS_BYTES - LDSCTL_OFF) / 4; u += NWAVES * 64) ((LAS unsigned*)(F.lds + LDSCTL_OFF))[u] = 0u;
    __syncthreads();
    XcdBarrier bar; bar.bar = (unsigned*)(F.ctl + CW_BAR); bar.x = 0; bar.st = nullptr;
    if (N_LAUNCHES == 1) bar = xcd_barrier_post((unsigned*)(F.ctl + CW_BAR), F.MISC + 8);
    PG8_LAS float* tab = (PG8_LAS float*)(F.lds + TAB_OFF);
    const int lo = args.ph_lo, hi = args.ph_hi;
#define IN(k) (lo <= (k) && (k) < hi)
#define SEAM(k) do { if (IN(k) && IN((k) + 1)) xcd_barrier(bar); } while (0)

    if (IN(0)) { p0_prologue(F); SEAM(0); }
    if (IN(1)) {
        { pg8::Gemm g{F.XN, F.Wqkv_t, M, NQKV, D}; pg8::StaticOrder S; S.init(M, NQKV, F.G, (int)blockIdx.x);
          pg8::EpiQKV E{F.QB, (size_t)(WS_K - WS_Q) / 2, F.kpart, C2};
          pg8::gemm_phase<pg8::EpiQKV, pg8::StaticOrder, true, true>(F.lds + RING_OFF, tab, g, S, E); }
        { pg8::Gemm g{F.PB, F.Wp_t, M, D, PLE}; pg8::StaticOrder S; S.init(M, D, F.G, (int)blockIdx.x);
          pg8::EpiBf16Plain E{F.PP, D};
          pg8::gemm_phase<pg8::EpiBf16Plain, pg8::StaticOrder, true, true>(F.lds + RING_OFF, tab, g, S, E); }
        SEAM(1);
    }
#if defined(ATT_NAIVE)
    if (IN(2)) { attn_naive(F); SEAM(2); }
#else
    if (IN(2)) { att::attn_phase(F); SEAM(2); }
#endif
    if (IN(3)) {
        pg8::Gemm g{F.OB, F.Wo_t, M, D, D}; pg8::StaticOrder S; S.init(M, D, F.G, (int)blockIdx.x);
        pg8::EpiRes<1> E{F.invr0, F.XN, F.ssq1, F.ssq0};
        pg8::gemm_phase<pg8::EpiRes<1>, pg8::StaticOrder, true, true>(F.lds + RING_OFF, tab, g, S, E);
        SEAM(3);
    }
    if (IN(4)) {
        pg8::Gemm g{F.XN, F.Wup_t, M, FF, D}; pg8::StaticOrder S; S.init(M, FF, F.G, (int)blockIdx.x);
        pg8::EpiUp E{F.UB, FF, F.ssq1};
        pg8::gemm_phase<pg8::EpiUp, pg8::StaticOrder, true, true>(F.lds + RING_OFF, tab, g, S, E);
        SEAM(4);
    }
    if (IN(5)) {
        pg8::Gemm g{F.UB, F.Wdn_t, M, D, FF}; pg8::StaticOrder S; S.init(M, D, F.G, (int)blockIdx.x);
        pg8::EpiRes<0> E{nullptr, F.XN, F.ssq2, nullptr};
        pg8::gemm_phase<pg8::EpiRes<0>, pg8::StaticOrder, true, true>(F.lds + RING_OFF, tab, g, S, E);
        SEAM(5);
    }
    if (IN(6)) {
        pg8::Gemm g{F.XN, F.Wg_t, M, D, D}; pg8::StaticOrder S; S.init(M, D, F.G, (int)blockIdx.x);
        pg8::EpiGate E{F.XN, F.PP, F.b_gate, F.ssq3, F.ssq2};
        pg8::gemm_phase<pg8::EpiGate, pg8::StaticOrder, true, true>(F.lds + RING_OFF, tab, g, S, E);
        SEAM(6);
    }
    if (IN(7)) { final_norm(F); }
#undef IN
#undef SEAM
}

extern "C" void kernel_launch(void* const* d_in, const int* in_sizes, int n_in, void* d_out, int out_size, void* d_ws, size_t ws_size, hipStream_t stream) {
    static int grid = 0;
    if (grid == 0) {
        if (n_in != 15 || in_sizes[0] != M * D || out_size != M * D || ws_size < WS_END) { fprintf(stderr, "kernel_launch: unexpected shapes (n_in %d, in0 %d, out %d, ws %zu); nothing launched\n", n_in, n_in > 0 ? in_sizes[0] : -1, out_size, ws_size); grid = -1; return; }
        int dev = 0, cus = 0, per_cu = 0;
        if (hipGetDevice(&dev) != hipSuccess || hipDeviceGetAttribute(&cus, hipDeviceAttributeMultiprocessorCount, dev) != hipSuccess) { grid = -1; return; }
        if (hipFuncSetAttribute((const void*)mk_fwd, hipFuncAttributeMaxDynamicSharedMemorySize, LDS_BYTES) != hipSuccess) { fprintf(stderr, "kernel_launch: hipFuncSetAttribute failed\n"); grid = -1; return; }
        if (hipOccupancyMaxActiveBlocksPerMultiprocessor(&per_cu, (const void*)mk_fwd, NWAVES * 64, LDS_BYTES) != hipSuccess || per_cu < 1) { fprintf(stderr, "kernel_launch: occupancy query reports %d blocks per CU\n", per_cu); }
        (void)hipGetLastError();
        grid = cus;
    }
    if (grid < 0) return;
    if (hipMemsetAsync((char*)d_ws + WS_CTL, 0, CTL_ZERO_BYTES, stream) != hipSuccess) { fprintf(stderr, "kernel_launch: hipMemsetAsync failed\n"); return; }
    Args a{};
    for (int i = 0; i < 15; ++i) a.in[i] = (const float*)d_in[i];
    a.out = (float*)d_out; a.ws = (unsigned char*)d_ws;
    for (int li = 0; li < N_LAUNCHES; ++li) {
        a.ph_lo = (N_LAUNCHES == 1) ? 0 : li; a.ph_hi = (N_LAUNCHES == 1) ? NPHASE : li + 1; a.li = li;
        hipLaunchKernelGGL(mk_fwd, dim3(grid), dim3(NWAVES * 64), LDS_BYTES, stream, a);
        const hipError_t le = hipPeekAtLastError();
        if (le != hipSuccess) { fprintf(stderr, "kernel_launch: launch %d failed: %s\n", li, hipGetErrorName(le)); break; }
    }
}
```

```cpp
#include <hip/hip_runtime.h>
#include <cstdio>
#include <cstdint>
namespace pg8 {
#define PG8_LAS __attribute__((address_space(3)))
typedef unsigned short bf16_t;
typedef short bf16x8 __attribute__((ext_vector_type(8)));
typedef float f32x4 __attribute__((ext_vector_type(4)));
typedef unsigned u32x4 __attribute__((ext_vector_type(4)));
constexpr int BM = 256, BK = 64, HALF = 128, HTB = HALF * BK * 2  , STAGE_BYTES = 8 * HTB, NXCD = 8, WGM = 8;

__host__ __device__ __forceinline__ int lds_byte(int r, int c) { const int st = (r >> 4) * 2 + (c >> 5), rr = r & 15, cc = c & 31, ob = rr * 64 + cc * 2; return st * 1024 + (ob ^ (((ob >> 9) & 1) << 5)); }
__host__ __device__ __forceinline__ void stage_rc(int b, int& R, int& C) { const int st = b / 1024, sb = b % 1024, swz = sb ^ (((sb >> 9) & 1) << 5); R = (st >> 1) * 16 + swz / 64; C = (st & 1) * 32 + (swz % 64) / 2; }
__host__ __device__ __forceinline__ int perm32(int rho) { const int n = rho >> 4, i = rho & 15; return 8 * (i >> 2) + 4 * n + (i & 3); }

struct Unit { int pm, pn; };
struct Gemm { const bf16_t* A; const bf16_t* Bt; int M, N, K; };

struct StaticOrder {
    int nM, nN, nwg, G, c;
    __host__ __device__ void init(int M, int N, int G_, int c_) { nM = M / BM; nN = N / BM; nwg = nM * nN; G = G_; c = c_; }
    __host__ __device__ bool next(int i, Unit& u) const {
        const long L = (long)i * G + c; if (L >= nwg) return false;
        int wgid = (int)L; { const int q = nwg / NXCD, r = nwg % NXCD, xcd = wgid % NXCD, off = wgid / NXCD; wgid = (xcd < r ? xcd * (q + 1) : r * (q + 1) + (xcd - r) * q) + off; }
        const int nig = WGM * nN, gid = wgid / nig, fm = gid * WGM, gsz = (nM - fm) < WGM ? (nM - fm) : WGM;
        u.pm = fm + ((wgid % nig) % gsz); u.pn = (wgid % nig) / gsz; return true;
    }
    __device__ __forceinline__ void a_ready(const Unit&) const {}
    __device__ __forceinline__ void done(const Unit&) const {}
};

__device__ __forceinline__ unsigned cvt_pk_bf16(float lo, float hi) { unsigned r; asm volatile("v_cvt_pk_bf16_f32 %0, %1, %2" : "=v"(r) : "v"(lo), "v"(hi)); return r; }
typedef unsigned u32x2 __attribute__((ext_vector_type(2)));
constexpr float RMS_EPS = 1e-6f;
__device__ __forceinline__ float sum4(f32x4 v) { return (v[0] + v[1]) + (v[2] + v[3]); }

struct EpiBf16Plain {
    static constexpr bool PERM = true, AFTER_DRAIN = false, MID = false, TABLE = false;
    bf16_t* O; int ldc;
    __device__ __forceinline__ void operator()(f32x4 (&acc)[2][2][4][2], const Unit& u, int wr, int wc, int fr, int fq, PG8_LAS float*, int) const {
        const int row0 = u.pm * BM + wr * 64 + fr, col0 = u.pn * BM + wc * 32 + 8 * fq;
#pragma unroll
        for (int ai = 0; ai < 2; ++ai)
#pragma unroll
            for (int m = 0; m < 4; ++m) { bf16_t* rowp = O + (size_t)(row0 + ai * HALF + m * 16) * ldc + col0;
#pragma unroll
                for (int bj = 0; bj < 2; ++bj) { const f32x4 v0 = acc[ai][bj][m][0], v1 = acc[ai][bj][m][1];
                    u32x4 w; w.x = cvt_pk_bf16(v0[0], v0[1]); w.y = cvt_pk_bf16(v0[2], v0[3]); w.z = cvt_pk_bf16(v1[0], v1[1]); w.w = cvt_pk_bf16(v1[2], v1[3]);
                    *(u32x4*)(rowp + bj * HALF) = w; } }
    }
};

struct EpiQKV {
    static constexpr bool PERM = true, AFTER_DRAIN = false, MID = false, TABLE = false;
    bf16_t* Q; size_t part_stride; float* kpart; float qscale; unsigned* kmaxb;
    __device__ __forceinline__ void operator()(f32x4 (&acc)[2][2][4][2], const Unit& u, int wr, int wc, int fr, int fq, PG8_LAS float*, int) const {
        const int part = u.pn >> 2, pc = u.pn & 3; const bool ga = pc < 2;
        bf16_t* base = Q + (size_t)part * part_stride; const float sc = part == 0 ? qscale : 1.0f;
        const int row0 = u.pm * BM + wr * 64 + fr, col0 = pc * BM + wc * 32 + 8 * fq;
#pragma unroll
        for (int ai = 0; ai < 2; ++ai)
#pragma unroll
            for (int m = 0; m < 4; ++m) { const int row = row0 + ai * HALF + m * 16;
                const int rowd = ga ? ((row & ~4095) | ((row & 3) << 10) | ((row & 4095) >> 2)) : row;
                bf16_t* rowp = base + (size_t)rowd * 1024 + col0;
#pragma unroll
                for (int bj = 0; bj < 2; ++bj) { const f32x4 v0 = acc[ai][bj][m][0] * sc, v1 = acc[ai][bj][m][1] * sc;
                    u32x4 w; w.x = cvt_pk_bf16(v0[0], v0[1]); w.y = cvt_pk_bf16(v0[2], v0[3]); w.z = cvt_pk_bf16(v1[0], v1[1]); w.w = cvt_pk_bf16(v1[2], v1[3]);
                    *(u32x4*)(rowp + bj * HALF) = w; } }
        if (part == 1) {
#pragma unroll
            for (int bj = 0; bj < 2; ++bj) { float mx = 0.f;
#pragma unroll
                for (int ai = 0; ai < 2; ++ai)
#pragma unroll
                    for (int m = 0; m < 4; ++m)
#pragma unroll
                        for (int n = 0; n < 2; ++n)
#pragma unroll
                            for (int e = 0; e < 4; ++e) mx = fmaxf(mx, fabsf(acc[ai][bj][m][n][e]));
#pragma unroll
                for (int o = 1; o < 64; o <<= 1) mx = fmaxf(mx, __shfl_xor(mx, o));
                if (fr == 0 && fq == 0) atomicMax(kmaxb + (u.pm >> 4) * 16 + pc * 4 + 2 * bj + (wc >> 1), __float_as_uint(mx)); }
        }
        if (part == 1 && !ga) {
#pragma unroll
            for (int bj = 0; bj < 2; ++bj) {
                f32x4 s0 = acc[0][bj][0][0], s1 = acc[0][bj][0][1];
#pragma unroll
                for (int ai = 0; ai < 2; ++ai)
#pragma unroll
                    for (int m = 0; m < 4; ++m) if (ai + m) { s0 += acc[ai][bj][m][0]; s1 += acc[ai][bj][m][1]; }
#pragma unroll
                for (int e = 0; e < 4; ++e) {
#pragma unroll
                    for (int o = 1; o < 16; o <<= 1) { s0[e] += __shfl_xor(s0[e], o); s1[e] += __shfl_xor(s1[e], o); } }
                if (fr == 0) { float* kp = kpart + (size_t)(u.pm * 2 + wr) * 512 + (pc - 2) * BM + bj * HALF + wc * 32 + 8 * fq;
                    *(f32x4*)kp = s0; *(f32x4*)(kp + 4) = s1; }
            }
        }
    }
};

template <int KIND> __device__ __forceinline__ void fill_rowscale(const float* ssq, const Unit& u, int par, PG8_LAS float* tab, int tid) {
    if (tid < 256) {
        const f32x4* p = (const f32x4*)(ssq + (size_t)(u.pm * BM + tid) * 16);
        const f32x4 a0 = p[0], a1 = p[1], b0 = p[2], b1 = p[3];
        const float sa = sum4(a0) + sum4(a1), sb = sum4(b0) + sum4(b1);
        if (KIND == 1) { tab[par * 512 + 2 * tid] = 1.0f / sqrtf((sa + sb) * (1.0f / 1024.0f) + RMS_EPS); }
        else { const float ra = 1.0f / sqrtf(sa * (1.0f / 512.0f) + RMS_EPS), rb = 1.0f / sqrtf(sb * (1.0f / 512.0f) + RMS_EPS);
            tab[par * 512 + 2 * tid] = ra / rb; tab[par * 512 + 2 * tid + 1] = rb; }
    }
}

struct EpiUp {
    static constexpr bool PERM = true, AFTER_DRAIN = false, MID = false, TABLE = true;
    bf16_t* O; int ldc; const float* ssq;
    __device__ __forceinline__ void fill(const Unit& u, int par, PG8_LAS float* tab, int tid) const { fill_rowscale<1>(ssq, u, par, tab, tid); }
    __device__ __forceinline__ void operator()(f32x4 (&acc)[2][2][4][2], const Unit& u, int wr, int wc, int fr, int fq, PG8_LAS float* tab, int par) const {
        const int row0 = u.pm * BM + wr * 64 + fr, col0 = u.pn * BM + wc * 32 + 8 * fq;
#pragma unroll
        for (int ai = 0; ai < 2; ++ai)
#pragma unroll
            for (int m = 0; m < 4; ++m) { const int r = ai * HALF + wr * 64 + m * 16 + fr; const float rs = tab[par * 512 + 2 * r];
                bf16_t* rowp = O + (size_t)(row0 + ai * HALF + m * 16) * ldc + col0;
#pragma unroll
                for (int bj = 0; bj < 2; ++bj) { f32x4 v0 = acc[ai][bj][m][0] * rs, v1 = acc[ai][bj][m][1] * rs;
#pragma unroll
                    for (int e = 0; e < 4; ++e) { const float a = fmaxf(v0[e], 0.f), b = fmaxf(v1[e], 0.f); v0[e] = a * a; v1[e] = b * b; }
                    u32x4 w; w.x = cvt_pk_bf16(v0[0], v0[1]); w.y = cvt_pk_bf16(v0[2], v0[3]); w.z = cvt_pk_bf16(v1[0], v1[1]); w.w = cvt_pk_bf16(v1[2], v1[3]);
                    *(u32x4*)(rowp + bj * HALF) = w; } }
    }
};

template <int KIND> struct EpiRes {
    static constexpr bool PERM = true, AFTER_DRAIN = false, MID = (KIND == 1), TABLE = (KIND == 1);
    const float* invr; bf16_t* hb; float* ssq_out; const float* ssq_in;
    __device__ __forceinline__ void fill(const Unit& u, int par, PG8_LAS float* tab, int tid) const { fill_rowscale<2>(ssq_in, u, par, tab, tid); }
    __device__ __forceinline__ void mid(f32x4 (&acc)[2][2][4][2], int wr, int fr, PG8_LAS float* tab, int par) const {
#pragma unroll
        for (int ai = 0; ai < 2; ++ai)
#pragma unroll
            for (int m = 0; m < 4; ++m) { const float f = tab[par * 512 + 2 * (ai * HALF + wr * 64 + m * 16 + fr)];
#pragma unroll
                for (int bj = 0; bj < 2; ++bj)
#pragma unroll
                    for (int n = 0; n < 2; ++n) acc[ai][bj][m][n] *= f; }
    }
    __device__ __forceinline__ void operator()(f32x4 (&acc)[2][2][4][2], const Unit& u, int wr, int wc, int fr, int fq, PG8_LAS float* tab, int par) const {
        const int col0 = u.pn * BM + wc * 32 + 8 * fq;
#pragma unroll
        for (int ai = 0; ai < 2; ++ai) {
            f32x4 rv[4][2][2];
#pragma unroll
            for (int m = 0; m < 4; ++m) { const size_t off = (size_t)(u.pm * BM + ai * HALF + wr * 64 + m * 16 + fr) * 1024 + col0;
#pragma unroll
                for (int bj = 0; bj < 2; ++bj) {
                    { const u32x4 w = *(const u32x4*)(hb + off + bj * HALF);
                        rv[m][bj][0] = (f32x4){__uint_as_float(w.x << 16), __uint_as_float(w.x & 0xffff0000u), __uint_as_float(w.y << 16), __uint_as_float(w.y & 0xffff0000u)};
                        rv[m][bj][1] = (f32x4){__uint_as_float(w.z << 16), __uint_as_float(w.z & 0xffff0000u), __uint_as_float(w.w << 16), __uint_as_float(w.w & 0xffff0000u)}; } } }
#pragma unroll
            for (int m = 0; m < 4; ++m) { const int r = ai * HALF + wr * 64 + m * 16 + fr; const int rowg = u.pm * BM + r;
                const float rb = (KIND == 1) ? tab[par * 512 + 2 * r + 1] : 1.0f; const float ir = (KIND == 1) ? invr[rowg] : 1.0f;
                const size_t off = (size_t)rowg * 1024 + col0; float ss = 0.f;
#pragma unroll
                for (int bj = 0; bj < 2; ++bj) { const f32x4 v0 = rv[m][bj][0] * ir + acc[ai][bj][m][0] * rb, v1 = rv[m][bj][1] * ir + acc[ai][bj][m][1] * rb;
                    u32x4 w; w.x = cvt_pk_bf16(v0[0], v0[1]); w.y = cvt_pk_bf16(v0[2], v0[3]); w.z = cvt_pk_bf16(v1[0], v1[1]); w.w = cvt_pk_bf16(v1[2], v1[3]);
                    *(u32x4*)(hb + off + bj * HALF) = w;
                    ss += ((v0[0] * v0[0] + v0[1] * v0[1]) + (v0[2] * v0[2] + v0[3] * v0[3])) + ((v1[0] * v1[0] + v1[1] * v1[1]) + (v1[2] * v1[2] + v1[3] * v1[3])); }
                ss += __shfl_xor(ss, 16); ss += __shfl_xor(ss, 32);
                if (fq == 0) ssq_out[(size_t)rowg * 16 + u.pn * 4 + wc] = ss; }
            asm volatile("" ::: "memory");
        }
    }
};

struct EpiGate {
    static constexpr bool PERM = true, AFTER_DRAIN = false, MID = false, TABLE = true;
    bf16_t* hb; const bf16_t* pp; const float* bias; float* ssq_out; const float* ssq_in;
    __device__ __forceinline__ void fill(const Unit& u, int par, PG8_LAS float* tab, int tid) const { fill_rowscale<1>(ssq_in, u, par, tab, tid); }
    __device__ __forceinline__ void operator()(f32x4 (&acc)[2][2][4][2], const Unit& u, int wr, int wc, int fr, int fq, PG8_LAS float* tab, int par) const {
        const int col0 = u.pn * BM + wc * 32 + 8 * fq;
        f32x4 bv[2][2];
#pragma unroll
        for (int bj = 0; bj < 2; ++bj)
#pragma unroll
            for (int n = 0; n < 2; ++n) bv[bj][n] = *(const f32x4*)(bias + col0 + bj * HALF + 4 * n);
#pragma unroll
        for (int ai = 0; ai < 2; ++ai) {
            u32x4 hv[4][2], pv[4][2];
#pragma unroll
            for (int m = 0; m < 4; ++m) { const size_t off = (size_t)(u.pm * BM + ai * HALF + wr * 64 + m * 16 + fr) * 1024 + col0;
#pragma unroll
                for (int bj = 0; bj < 2; ++bj) { hv[m][bj] = *(const u32x4*)(hb + off + bj * HALF); pv[m][bj] = *(const u32x4*)(pp + off + bj * HALF); } }
#pragma unroll
            for (int m = 0; m < 4; ++m) { const int r = ai * HALF + wr * 64 + m * 16 + fr; const int rowg = u.pm * BM + r;
                const float rs = tab[par * 512 + 2 * r];
                const size_t off = (size_t)rowg * 1024 + col0; float ss = 0.f;
#pragma unroll
                for (int bj = 0; bj < 2; ++bj) { float v[8];
#pragma unroll
                    for (int e = 0; e < 8; ++e) { const unsigned hw = hv[m][bj][e >> 1], pw = pv[m][bj][e >> 1];
                        const float h = __uint_as_float((e & 1) ? (hw & 0xffff0000u) : (hw << 16)), p = __uint_as_float((e & 1) ? (pw & 0xffff0000u) : (pw << 16));
                        const float z = acc[ai][bj][m][e >> 2][e & 3] * rs + bv[bj][e >> 2][e & 3];
                        v[e] = h + __builtin_amdgcn_rcpf(1.0f + __builtin_amdgcn_exp2f(-1.4426950408889634f * z)) * p; ss += v[e] * v[e]; }
                    u32x4 w; w.x = cvt_pk_bf16(v[0], v[1]); w.y = cvt_pk_bf16(v[2], v[3]); w.z = cvt_pk_bf16(v[4], v[5]); w.w = cvt_pk_bf16(v[6], v[7]);
                    *(u32x4*)(hb + off + bj * HALF) = w; }
                ss += __shfl_xor(ss, 16); ss += __shfl_xor(ss, 32);
                if (fq == 0) ssq_out[(size_t)rowg * 16 + u.pn * 4 + wc] = ss; }
            asm volatile("" ::: "memory");
        }
    }
};

template <class Epi, class Sched, bool ALIGN_EPI = false, bool SP2 = false>
__device__ __forceinline__ void gemm_phase(PG8_LAS unsigned char* lds, PG8_LAS float* tab, const Gemm g, const Sched& S, const Epi& E) {
    const int tid = threadIdx.x, wid = __builtin_amdgcn_readfirstlane(tid >> 6), lane = tid & 63, wr = wid >> 2, wc = wid & 3, fr = lane & 15, fq = lane >> 4;
    const int K = g.K, nt = K / BK;
    unsigned voffA[2], voffB[2];
#pragma unroll
    for (int i = 0; i < 2; ++i) { int R, C; stage_rc(tid * 16 + i * 8192, R, C); const int Rb = Epi::PERM ? ((R & ~31) + perm32(R & 31)) : R;
        voffA[i] = (unsigned)(R * K + C) * 2u; voffB[i] = (unsigned)(Rb * K + C) * 2u; }
    const size_t kstep = (size_t)(BK * 2);
    const size_t hstep = (size_t)HALF * K * 2;
    const size_t tstep = 2 * hstep;
    const unsigned ldsw = (unsigned)wid * 1024u;
    const int aoff = lds_byte(wr * 64 + fr, fq * 8), boff = lds_byte(wc * 32 + fr, fq * 8);
#define PG8_SA(b, h) (((b) * 2 + (h)) * HTB)
#define PG8_SB(b, h) ((4 + (b) * 2 + (h)) * HTB)
#define PG8_STAGE(bufoff, gbase, voff) do { _Pragma("unroll") for (int _i = 0; _i < 2; ++_i) \
        __builtin_amdgcn_global_load_lds((const unsigned*)((const char*)(gbase) + (voff)[_i]), (PG8_LAS unsigned*)(lds + (bufoff) + ldsw + _i * 8192), 16, 0, 0); } while (0)
#define PG8_LDA(dst, b, h) do { _Pragma("unroll") for (int m = 0; m < 4; ++m) _Pragma("unroll") for (int k = 0; k < 2; ++k) dst[m][k] = *(const PG8_LAS bf16x8*)(lds + PG8_SA(b, h) + aoff + m * 2048 + k * 1024); } while (0)
#define PG8_LDB(dst, b, h) do { _Pragma("unroll") for (int n = 0; n < 2; ++n) _Pragma("unroll") for (int k = 0; k < 2; ++k) dst[n][k] = *(const PG8_LAS bf16x8*)(lds + PG8_SB(b, h) + boff + n * 2048 + k * 1024); } while (0)
#define PG8_MMA(ai, bj, At, Bt) do { __builtin_amdgcn_s_setprio(1); _Pragma("unroll") for (int m = 0; m < 4; ++m) _Pragma("unroll") for (int n = 0; n < 2; ++n) _Pragma("unroll") for (int k = 0; k < 2; ++k) \
        acc[ai][bj][m][n] = __builtin_amdgcn_mfma_f32_16x16x32_bf16(Bt[n][k], At[m][k], acc[ai][bj][m][n], 0, 0, 0); __builtin_amdgcn_s_setprio(0); } while (0)
#define PG8_WAIT_V(n) asm volatile("s_waitcnt vmcnt(" #n ")" ::: "memory")
#define PG8_WAIT_L(n) asm volatile("s_waitcnt lgkmcnt(" #n ")" ::: "memory")
#define PG8_BAR __builtin_amdgcn_s_barrier()
#define PG8_SCHED __builtin_amdgcn_sched_barrier(0)
    Unit cur, nxt; int ui = 0;
    if (!S.next(0, cur)) return;
    if constexpr (Epi::TABLE) E.fill(cur, 0, tab, tid);
    f32x4 acc[2][2][4][2];
#pragma unroll
    for (int a = 0; a < 2; ++a)
#pragma unroll
        for (int b = 0; b < 2; ++b)
#pragma unroll
            for (int m = 0; m < 4; ++m)
#pragma unroll
                for (int n = 0; n < 2; ++n) acc[a][b][m][n] = (f32x4){0.f, 0.f, 0.f, 0.f};
    bf16x8 At[4][2], B0[2][2], B1[2][2];
    const char* cA = (const char*)g.A + (size_t)cur.pm * tstep; const char* cB = (const char*)g.Bt + (size_t)cur.pn * tstep;
    S.a_ready(cur);
    if constexpr (SP2) {
        PG8_STAGE(PG8_SB(0, 0), cB, voffB); PG8_STAGE(PG8_SB(0, 1), cB + hstep, voffB); PG8_STAGE(PG8_SA(0, 0), cA, voffA); PG8_STAGE(PG8_SA(0, 1), cA + hstep, voffA);
        if (wr == 1) PG8_BAR;
        PG8_WAIT_V(2); PG8_BAR;
        PG8_STAGE(PG8_SB(1, 0), cB + kstep, voffB); PG8_STAGE(PG8_SA(1, 0), cA + kstep, voffA); PG8_STAGE(PG8_SB(1, 1), cB + hstep + kstep, voffB);
        PG8_WAIT_V(6); PG8_BAR;
    } else {
        PG8_STAGE(PG8_SB(0, 0), cB, voffB); PG8_STAGE(PG8_SA(0, 0), cA, voffA); PG8_STAGE(PG8_SB(0, 1), cB + hstep, voffB); PG8_STAGE(PG8_SA(0, 1), cA + hstep, voffA);
        if (wr == 1) PG8_BAR;
        PG8_WAIT_V(4); PG8_BAR;
        PG8_STAGE(PG8_SB(1, 0), cB + kstep, voffB); PG8_STAGE(PG8_SA(1, 0), cA + kstep, voffA); PG8_STAGE(PG8_SB(1, 1), cB + hstep + kstep, voffB);
        PG8_WAIT_V(6); PG8_BAR;
    }
    for (;;) {
        const bool has_next = S.next(ui + 1, nxt);
        const char* nA = has_next ? (const char*)g.A + (size_t)nxt.pm * tstep : cA; const char* nB = has_next ? (const char*)g.Bt + (size_t)nxt.pn * tstep : cB;
        for (int t = 0; t < nt; t += 2) {
            const bool last = (t == nt - 2);
            if constexpr (Epi::MID) { if (t == (nt >> 1)) E.mid(acc, wr, fr, tab, ui & 1); }
            const char* a1 = cA + (size_t)(t + 1) * kstep;
            const char* a2 = last ? nA : cA + (size_t)(t + 2) * kstep; const char* b2 = last ? nB : cB + (size_t)(t + 2) * kstep;
            const char* a3 = a2 + kstep; const char* b3 = b2 + kstep;
            if (last && has_next) S.a_ready(nxt);
            if constexpr (SP2) {
            PG8_LDB(B0, 0, 0); PG8_LDB(B1, 0, 1); PG8_SCHED; PG8_LDA(At, 0, 0); PG8_STAGE(PG8_SA(1, 1), a1 + hstep, voffA);
            PG8_WAIT_V(8); PG8_WAIT_L(0); PG8_BAR; PG8_MMA(0, 0, At, B0); PG8_MMA(0, 1, At, B1); PG8_BAR; PG8_SCHED;
            PG8_LDA(At, 0, 1); PG8_STAGE(PG8_SB(0, 0), b2, voffB); PG8_STAGE(PG8_SB(0, 1), b2 + hstep, voffB); PG8_STAGE(PG8_SA(0, 0), a2, voffA);
            PG8_WAIT_V(8); PG8_WAIT_L(0); PG8_BAR; PG8_MMA(1, 0, At, B0); PG8_MMA(1, 1, At, B1); PG8_BAR; PG8_SCHED;
            PG8_LDB(B0, 1, 0); PG8_LDB(B1, 1, 1); PG8_SCHED; PG8_LDA(At, 1, 0); PG8_STAGE(PG8_SA(0, 1), a2 + hstep, voffA);
            PG8_WAIT_V(8); PG8_WAIT_L(0); PG8_BAR; PG8_MMA(0, 0, At, B0); PG8_MMA(0, 1, At, B1); PG8_BAR; PG8_SCHED;
            PG8_LDA(At, 1, 1); PG8_STAGE(PG8_SB(1, 0), b3, voffB); PG8_STAGE(PG8_SB(1, 1), b3 + hstep, voffB); PG8_STAGE(PG8_SA(1, 0), a3, voffA);
            PG8_WAIT_V(8); PG8_WAIT_L(0); PG8_BAR; PG8_MMA(1, 0, At, B0); PG8_MMA(1, 1, At, B1); PG8_BAR; PG8_SCHED;
            } else {
            PG8_LDB(B0, 0, 0); PG8_SCHED; PG8_LDA(At, 0, 0); PG8_STAGE(PG8_SA(1, 1), a1 + hstep, voffA);
            PG8_WAIT_L(8); PG8_BAR; PG8_WAIT_L(0); PG8_MMA(0, 0, At, B0); PG8_BAR; PG8_SCHED;
            PG8_LDB(B1, 0, 1); PG8_STAGE(PG8_SB(0, 0), b2, voffB);
            PG8_BAR; PG8_WAIT_L(0); PG8_MMA(0, 1, At, B1); PG8_BAR;
            PG8_LDA(At, 0, 1); PG8_STAGE(PG8_SA(0, 0), a2, voffA);
            PG8_BAR; PG8_WAIT_L(0); PG8_MMA(1, 0, At, B0); PG8_BAR; PG8_SCHED;
            PG8_STAGE(PG8_SB(0, 1), b2 + hstep, voffB);
            PG8_WAIT_V(6); PG8_BAR; PG8_MMA(1, 1, At, B1); PG8_BAR;
            PG8_LDB(B0, 1, 0); PG8_SCHED; PG8_LDA(At, 1, 0); PG8_STAGE(PG8_SA(0, 1), a2 + hstep, voffA);
            PG8_WAIT_L(8); PG8_BAR; PG8_WAIT_L(0); PG8_MMA(0, 0, At, B0); PG8_BAR; PG8_SCHED;
            PG8_LDB(B1, 1, 1); PG8_STAGE(PG8_SB(1, 0), b3, voffB);
            PG8_BAR; PG8_WAIT_L(0); PG8_MMA(0, 1, At, B1); PG8_BAR;
            PG8_LDA(At, 1, 1); PG8_STAGE(PG8_SA(1, 0), a3, voffA);
            PG8_BAR; PG8_WAIT_L(0); PG8_MMA(1, 0, At, B0); PG8_BAR; PG8_SCHED;
            PG8_STAGE(PG8_SB(1, 1), b3 + hstep, voffB);
            PG8_WAIT_V(6); PG8_BAR; PG8_MMA(1, 1, At, B1); PG8_BAR;
            }
        }
        if constexpr (ALIGN_EPI) { if (wr == 0) PG8_BAR; }
        if constexpr (!Epi::AFTER_DRAIN) { int tid_e = threadIdx.x; asm volatile("" : "+v"(tid_e)); const int lane_e = tid_e & 63;
            E(acc, cur, wr, wc, lane_e & 15, lane_e >> 4, tab, ui & 1); S.done(cur); }
        if (!has_next) break;
#pragma unroll
        for (int a = 0; a < 2; ++a)
#pragma unroll
            for (int b = 0; b < 2; ++b)
#pragma unroll
                for (int m = 0; m < 4; ++m)
#pragma unroll
                    for (int n = 0; n < 2; ++n) acc[a][b][m][n] = (f32x4){0.f, 0.f, 0.f, 0.f};
        cur = nxt; cA = nA; cB = nB; ++ui;
        if constexpr (Epi::TABLE) E.fill(cur, ui & 1, tab, tid);
        if constexpr (ALIGN_EPI) { if (wr == 1) PG8_BAR; }
    }
    PG8_WAIT_V(0);
    if constexpr (!ALIGN_EPI) { if (wr == 0) PG8_BAR; }
    PG8_BAR;
    if constexpr (Epi::AFTER_DRAIN) { E.fused(acc, cur, wr, wc, fr, fq, lds, wid, lane); S.done(cur); }
#undef PG8_SA
#undef PG8_SB
#undef PG8_STAGE
#undef PG8_LDA
#undef PG8_LDB
#undef PG8_MMA
#undef PG8_WAIT_V
#undef PG8_WAIT_L
#undef PG8_BAR
#undef PG8_SCHED
}
}
#define GAS __attribute__((address_space(1)))
#define LAS __attribute__((address_space(3)))
typedef unsigned short bf16;
typedef unsigned v4u __attribute__((ext_vector_type(4)));
typedef float f32x4 __attribute__((ext_vector_type(4)));
typedef short bf16x8 __attribute__((ext_vector_type(8)));
typedef GAS unsigned gu32;
typedef GAS unsigned long long gu64;
#define RLX_AGENT __ATOMIC_RELAXED, __HIP_MEMORY_SCOPE_AGENT
#define LDS_WAIT() asm volatile("s_waitcnt lgkmcnt(0)" ::: "memory")
#define VM_WAIT() asm volatile("s_waitcnt vmcnt(0)" ::: "memory")
__device__ __forceinline__ unsigned long long rt() { return __builtin_amdgcn_s_memrealtime(); }
__device__ __forceinline__ unsigned f2bf(float f) { unsigned u = __builtin_bit_cast(unsigned, f); return (u + 0x7fffu + ((u >> 16) & 1u)) >> 16; }
__device__ __forceinline__ unsigned pk2(float lo, float hi) { return f2bf(lo) | (f2bf(hi) << 16); }

#define XB_TMO      128
#define XB_XCNT(j)  (256  + 64 * (j))
#define XB_XSUB(j)  (1280 + 64 * (j))
#define XB_XGEN(j)  (2304 + 64 * (j))
#define XB_TOP      3328
#define XB_TOPGEN   3392
#define XCD_BAR_WORDS 3456
#define XB_SPIN_CAP (1u << 18)

__device__ __forceinline__ unsigned xb_ld(unsigned* p)              { return __hip_atomic_load(p, __ATOMIC_RELAXED, __HIP_MEMORY_SCOPE_AGENT); }
__device__ __forceinline__ unsigned xb_add(unsigned* p, unsigned v) { return __hip_atomic_fetch_add(p, v, __ATOMIC_RELAXED, __HIP_MEMORY_SCOPE_AGENT); }
__device__ __forceinline__ unsigned xb_xcc_id() { return (unsigned)__builtin_amdgcn_s_getreg((3 << 11) | 20) & 0xFu; }
#define XB_SPIN(cond, bar) do { unsigned _sp = 0; while (cond) { __builtin_amdgcn_s_sleep(1); \
    if ((++_sp & 255u) == 0u) { if (xb_ld(&(bar)[XB_TMO])) break; if (_sp > XB_SPIN_CAP) { atomicAdd(&(bar)[XB_TMO], 1u); break; } } } } while (0)

struct XcdBarrier {
    unsigned* bar; unsigned x;
    volatile LAS unsigned* st;
};

__device__ __forceinline__ XcdBarrier xcd_barrier_post(unsigned* bar, volatile LAS unsigned* st) {
    XcdBarrier b; b.bar = bar; b.x = xb_xcc_id(); b.st = st;
    if (threadIdx.x == 0) (void)xb_add(&bar[XB_XCNT(b.x)], 1u);
    return b;
}
__device__ __forceinline__ void xcd_barrier_complete(unsigned* bar, unsigned x, unsigned& nloc, unsigned& nx) {
    const unsigned G = gridDim.x * gridDim.y * gridDim.z;
    unsigned sum, cnt, mine, sp = 0u;
    for (;;) {
        sum = 0u; cnt = 0u; mine = 0u;
#pragma unroll
        for (unsigned j = 0; j < 16; ++j) { const unsigned c = xb_ld(&bar[XB_XCNT(j)]); sum += c; cnt += (c > 0u) ? 1u : 0u; mine = (j == x) ? c : mine; }
        if (sum == G) break;
        __builtin_amdgcn_s_sleep(1);
        if ((++sp & 255u) == 0u) { if (xb_ld(&bar[XB_TMO])) break; if (sp > XB_SPIN_CAP) { atomicAdd(&bar[XB_TMO], 1u); break; } }
    }
    nloc = mine > 0u ? mine : 1u; nx = cnt > 0u ? cnt : 1u;
}

__device__ __forceinline__ void xcd_barrier(const XcdBarrier& b) {
    asm volatile("s_waitcnt vmcnt(0)" ::: "memory");
    __syncthreads();
    if (threadIdx.x == 0) {
        unsigned* bar = b.bar;
        __builtin_amdgcn_s_waitcnt(0);
        unsigned nloc = b.st[0], nx = b.st[1];
        if (nloc == 0u) { xcd_barrier_complete(bar, b.x, nloc, nx); b.st[0] = nloc; b.st[1] = nx; }
        const unsigned old = xb_add(&bar[XB_XSUB(b.x)], 1u);
        const unsigned gen = old / nloc;
        if (old + 1u == (gen + 1u) * nloc) {
            __builtin_amdgcn_fence(__ATOMIC_RELEASE, "agent");
            asm volatile("s_waitcnt vmcnt(0)" ::: "memory");
            const unsigned og = xb_add(&bar[XB_TOP], 1u);
            const unsigned tg = og / nx;
            if (og + 1u == (tg + 1u) * nx) xb_add(&bar[XB_TOPGEN], 1u);
            else XB_SPIN(xb_ld(&bar[XB_TOPGEN]) == tg, bar);
            __builtin_amdgcn_fence(__ATOMIC_ACQUIRE, "agent");
            xb_add(&bar[XB_XGEN(b.x)], 1u);
            asm volatile("s_waitcnt vmcnt(0)" ::: "memory");
        } else {
            XB_SPIN(xb_ld(&bar[XB_XGEN(b.x)]) == gen, bar);
            __builtin_amdgcn_fence(__ATOMIC_ACQUIRE, "agent");
            asm volatile("s_waitcnt vmcnt(0)" ::: "memory");
        }
    }
    __syncthreads();
}

constexpr int NWAVES = 8;
#ifndef MK_N_LAUNCHES
#define MK_N_LAUNCHES 1
#endif
constexpr int N_LAUNCHES = MK_N_LAUNCHES;
constexpr int NPHASE = 8;
static_assert(N_LAUNCHES == 1 || N_LAUNCHES == NPHASE, "MK_N_LAUNCHES is 1 or NPHASE");

constexpr int BATCH = 8, SEQ = 4096, D = 1024, NH = 16, HD = 64, FF = 4096, PLE = 256;
constexpr int M = BATCH * SEQ;
constexpr int NQKV = 3 * D;
constexpr float EPS = 1e-6f;
constexpr float LOG2E = 1.4426950408889634f;
constexpr float C2 = 0.125f * LOG2E;

constexpr size_t MiB = 1u << 20;
constexpr size_t WS_CTL = 0, CTL_ZERO_BYTES = 64 * 1024;
constexpr size_t WS_WQKV = 1 * MiB, WS_WO = 7 * MiB, WS_WUP = 9 * MiB, WS_WDN = 17 * MiB, WS_WG = 25 * MiB, WS_WP = 27 * MiB;
constexpr size_t WS_SSQ0 = 28 * MiB, WS_SSQ1 = 30 * MiB, WS_SSQ2 = 32 * MiB, WS_SSQ3 = 34 * MiB;
constexpr size_t WS_KPART = 36 * MiB;
constexpr size_t WS_INVR = 37 * MiB;
constexpr size_t WS_PB = 40 * MiB;
constexpr size_t WS_PP = 56 * MiB;
constexpr size_t WS_XN = 120 * MiB;
constexpr size_t WS_Q = 184 * MiB, WS_K = 248 * MiB, WS_V = 312 * MiB, WS_O = 376 * MiB;
constexpr size_t WS_U = 184 * MiB;
constexpr size_t WS_END = 440 * MiB;
constexpr int CW_BAR = 1024;
constexpr int CW_KMAX = 8192;

constexpr int RING_OFF = 0, RING_BYTES = 131072;
constexpr int LDSCTL_OFF = RING_BYTES, MISC_OFF = LDSCTL_OFF + 320;
constexpr int TAB_OFF = RING_BYTES + 1024;
constexpr int LDS_BYTES = 147456;
static_assert(TAB_OFF + 4096 <= LDS_BYTES, "LDS map");

struct Frame {
    LAS unsigned char* lds;
    volatile LAS unsigned* MISC;
    gu32* ctl;
    int tid, lane, wave;
    int vcu, G;
    const float *x, *p, *g_attn, *w_in, *g_out_a, *g_out_b, *w_out, *g_mlp, *w_up, *w_down, *g_ple, *w_gate, *b_gate, *w_proj, *g_final;
    float* out;
    bf16 *Wqkv_t, *Wo_t, *Wup_t, *Wdn_t, *Wg_t, *Wp_t;
    bf16 *XN, *QB, *KB, *VB, *OB, *UB, *PB, *PP;
    float *ssq0, *ssq1, *ssq2, *ssq3, *kpart, *invr0;
};

__device__ __forceinline__ float wave_sum(float v) {
#pragma unroll
    for (int o = 1; o < 64; o <<= 1) v += __shfl_xor(v, o);
    return v;
}
__device__ __forceinline__ void p0_transpose_item(const float* W, int K, int N, bf16* dst, const float* g, LAS float* scr, int k0, int n0, int lane) {
    f32x4 wv[8];
#pragma unroll
    for (int i = 0; i < 8; ++i) wv[i] = *(const GAS f32x4*)(W + (size_t)(k0 + 8 * i + (lane >> 3)) * N + n0 + 4 * (lane & 7));
#pragma unroll
    for (int i = 0; i < 8; ++i) { const int kk = 8 * i + (lane >> 3); f32x4 v = wv[i]; if (g) v = v * g[k0 + kk]; LAS float* d = scr + kk * 33 + 4 * (lane & 7); d[0] = v.x; d[1] = v.y; d[2] = v.z; d[3] = v.w; }
    LDS_WAIT(); asm volatile("" ::: "memory");
    const int c = lane & 7;
#pragma unroll
    for (int j = 0; j < 4; ++j) { const int n = (lane >> 3) + 8 * j; const LAS float* s = scr + (8 * c) * 33 + n;
        v4u o; o.x = pk2(s[0 * 33], s[1 * 33]); o.y = pk2(s[2 * 33], s[3 * 33]); o.z = pk2(s[4 * 33], s[5 * 33]); o.w = pk2(s[6 * 33], s[7 * 33]);
        *(GAS v4u*)(dst + (size_t)n * K + k0 + 8 * c) = o; }
    LDS_WAIT(); asm volatile("" ::: "memory");
}
__device__ __forceinline__ int qkv_dst_row(int n0) {
    if (n0 < 1536) return (n0 / 512) * 1024 + (n0 % 512);
    const int n1 = n0 - 1536; return (n1 / 512) * 1024 + 512 + (n1 % 512);
}
__device__ __forceinline__ void p0_prologue(Frame& F) {
    LAS float* scr = (LAS float*)(F.lds + RING_OFF + F.wave * 16384);
    const int gw = F.vcu * NWAVES + F.wave, NGW = F.G * NWAVES;
    constexpr int I_IN = (D / 64) * (NQKV / 32), I_O = (D / 64) * (D / 32), I_UP = (D / 64) * (FF / 32), I_DN = (FF / 64) * (D / 32), I_G = I_O, I_P = (PLE / 64) * (D / 32);
    constexpr int NITEMS = I_IN + I_O + I_UP + I_DN + I_G + I_P;
    for (int it = gw; it < NITEMS; it += NGW) {
        int r = it;
        if (r < I_IN) { const int nb = r % (NQKV / 32), kb = r / (NQKV / 32); p0_transpose_item(F.w_in, D, NQKV, F.Wqkv_t + (size_t)qkv_dst_row(32 * nb) * D, F.g_attn, scr, 64 * kb, 32 * nb, F.lane); continue; } r -= I_IN;
        if (r < I_O) { const int nb = r % (D / 32), kb = r / (D / 32); const float* g = (64 * kb < 512) ? F.g_out_a : (F.g_out_b - 512);
            p0_transpose_item(F.w_out, D, D, F.Wo_t + (size_t)(32 * nb) * D, g, scr, 64 * kb, 32 * nb, F.lane); continue; } r -= I_O;
        if (r < I_UP) { const int nb = r % (FF / 32), kb = r / (FF / 32); p0_transpose_item(F.w_up, D, FF, F.Wup_t + (size_t)(32 * nb) * D, F.g_mlp, scr, 64 * kb, 32 * nb, F.lane); continue; } r -= I_UP;
        if (r < I_DN) { const int nb = r % (D / 32), kb = r / (D / 32); p0_transpose_item(F.w_down, FF, D, F.Wdn_t + (size_t)(32 * nb) * FF, nullptr, scr, 64 * kb, 32 * nb, F.lane); continue; } r -= I_DN;
        if (r < I_G) { const int nb = r % (D / 32), kb = r / (D / 32); p0_transpose_item(F.w_gate, D, D, F.Wg_t + (size_t)(32 * nb) * D, F.g_ple, scr, 64 * kb, 32 * nb, F.lane); continue; } r -= I_G;
        { const int nb = r % (D / 32), kb = r / (D / 32); p0_transpose_item(F.w_proj, PLE, D, F.Wp_t + (size_t)(32 * nb) * PLE, nullptr, scr, 64 * kb, 32 * nb, F.lane); }
    }
    for (int m0 = 2 * gw; m0 < M; m0 += 2 * NGW) {
        f32x4 v[2][4]; f32x4 pv[2]; float s[2] = {0.f, 0.f};
#pragma unroll
        for (int q = 0; q < 2; ++q) { const GAS f32x4* xr = (const GAS f32x4*)(F.x + (size_t)(m0 + q) * D) + F.lane;
#pragma unroll
            for (int j = 0; j < 4; ++j) v[q][j] = xr[64 * j];
            pv[q] = ((const GAS f32x4*)(F.p + (size_t)(m0 + q) * PLE))[F.lane]; }
#pragma unroll
        for (int q = 0; q < 2; ++q) {
#pragma unroll
            for (int j = 0; j < 4; ++j) s[q] += (v[q][j].x * v[q][j].x + v[q][j].y * v[q][j].y) + (v[q][j].z * v[q][j].z + v[q][j].w * v[q][j].w);
            const float ms_ = wave_sum(s[q]) * (1.f / D) + EPS; const float rstd = 1.f / sqrtf(ms_);
            if (F.lane == 0) F.invr0[m0 + q] = sqrtf(ms_);
            GAS unsigned long long* o8 = (GAS unsigned long long*)(F.XN + (size_t)(m0 + q) * D) + F.lane;
#pragma unroll
            for (int j = 0; j < 4; ++j) o8[64 * j] = (unsigned long long)pk2(v[q][j].x * rstd, v[q][j].y * rstd) | ((unsigned long long)pk2(v[q][j].z * rstd, v[q][j].w * rstd) << 32);
            ((GAS unsigned long long*)(F.PB + (size_t)(m0 + q) * PLE))[F.lane] = (unsigned long long)pk2(pv[q].x, pv[q].y) | ((unsigned long long)pk2(pv[q].z, pv[q].w) << 32); }
    }
}

__device__ __forceinline__ float bf2f(unsigned short h) { return __uint_as_float((unsigned)h << 16); }
__device__ __forceinline__ void naive_key(const bf16* kp, const bf16* vp, const float (&q)[64], float bias, float& mx, float& l, float (&acc)[64]) {
    float s = 0.f;
#pragma unroll
    for (int c = 0; c < 8; ++c) { const v4u kw = *(const v4u*)(kp + 8 * c);
        s += q[8 * c + 0] * __uint_as_float(kw.x << 16) + q[8 * c + 1] * __uint_as_float(kw.x & 0xffff0000u) + q[8 * c + 2] * __uint_as_float(kw.y << 16) + q[8 * c + 3] * __uint_as_float(kw.y & 0xffff0000u)
           + q[8 * c + 4] * __uint_as_float(kw.z << 16) + q[8 * c + 5] * __uint_as_float(kw.z & 0xffff0000u) + q[8 * c + 6] * __uint_as_float(kw.w << 16) + q[8 * c + 7] * __uint_as_float(kw.w & 0xffff0000u); }
    s += bias;
    const float mn = fmaxf(mx, s), sc = __builtin_amdgcn_exp2f(mx - mn), pe = __builtin_amdgcn_exp2f(s - mn);
    mx = mn; l = l * sc + pe;
#pragma unroll
    for (int c = 0; c < 8; ++c) { const v4u vw = *(const v4u*)(vp + 8 * c);
        acc[8 * c + 0] = acc[8 * c + 0] * sc + pe * __uint_as_float(vw.x << 16); acc[8 * c + 1] = acc[8 * c + 1] * sc + pe * __uint_as_float(vw.x & 0xffff0000u);
        acc[8 * c + 2] = acc[8 * c + 2] * sc + pe * __uint_as_float(vw.y << 16); acc[8 * c + 3] = acc[8 * c + 3] * sc + pe * __uint_as_float(vw.y & 0xffff0000u);
        acc[8 * c + 4] = acc[8 * c + 4] * sc + pe * __uint_as_float(vw.z << 16); acc[8 * c + 5] = acc[8 * c + 5] * sc + pe * __uint_as_float(vw.z & 0xffff0000u);
        acc[8 * c + 6] = acc[8 * c + 6] * sc + pe * __uint_as_float(vw.w << 16); acc[8 * c + 7] = acc[8 * c + 7] * sc + pe * __uint_as_float(vw.w & 0xffff0000u); }
}
__device__ __forceinline__ void attn_naive(Frame& F) {
    const long NT = (long)F.G * NWAVES * 64;
    for (long idx = (long)blockIdx.x * (NWAVES * 64) + F.tid; idx < (long)M * NH; idx += NT) {
        const int tok = (int)(idx % M), hh = (int)(idx / M); const int b = tok / SEQ, t = tok % SEQ; const int grp = hh >> 3, h = hh & 7;
        float q[64], acc[64]; float mx = -1e30f, l = 0.f;
#pragma unroll
        for (int d = 0; d < 64; ++d) acc[d] = 0.f;
        if (grp == 0) {
            const float sl2 = exp2f(-0.5f * (float)(2 * h + 1)) * LOG2E;
            const size_t qrow = (size_t)b * SEQ + (size_t)(t & 3) * 1024 + (t >> 2);
            const bf16* qp = F.QB + qrow * D + h * 64;
#pragma unroll
            for (int d = 0; d < 64; ++d) q[d] = bf2f(qp[d]);
            for (int br = 0; br < 3; ++br) { const int dil = br == 0 ? 1 : (br == 1 ? 4 : 16);
                for (int mm = 0; mm <= 128; ++mm) { const int key = t - dil * mm; if (key < 0) break;
                    const size_t krow = (size_t)b * SEQ + (size_t)(key & 3) * 1024 + (key >> 2);
                    naive_key(F.KB + krow * D + h * 64, F.VB + krow * D + h * 64, q, -sl2 * (float)(dil * mm), mx, l, acc); } }
        } else {
            const float sl2 = exp2f(-(float)(h + 1)) * LOG2E;
            const bf16* qp = F.QB + (size_t)tok * D + 512 + h * 64;
#pragma unroll
            for (int d = 0; d < 64; ++d) q[d] = bf2f(qp[d]);
            const int own = t >> 8; int i0 = -1, i1 = -1, i2 = -1; float g0 = -INFINITY, g1 = -INFINITY, g2 = -INFINITY;
            for (int n = 0; n < own; ++n) { const float* k0 = F.kpart + (size_t)((b * 16 + n) * 2) * 512 + h * 64; const float* k1 = k0 + 512; float g = 0.f;
#pragma unroll
                for (int d = 0; d < 64; ++d) g += q[d] * (k0[d] + k1[d]);
                if (g > g0) { g2 = g1; i2 = i1; g1 = g0; i1 = i0; g0 = g; i0 = n; } else if (g > g1) { g2 = g1; i2 = i1; g1 = g; i1 = n; } else if (g > g2) { g2 = g; i2 = n; } }
            for (int j = 0; j < 4; ++j) { const int n = j == 0 ? i0 : (j == 1 ? i1 : (j == 2 ? i2 : own)); if (n < 0) continue;
                const int kend = (j == 3) ? t : 256 * n + 255;
                for (int key = 256 * n; key <= kend; ++key) { const size_t krow = (size_t)b * SEQ + key;
                    naive_key(F.KB + krow * D + 512 + h * 64, F.VB + krow * D + 512 + h * 64, q, -sl2 * (float)(t - key), mx, l, acc); } }
        }
        const float rl = 1.0f / l; float ss = 0.f; bf16* op = F.OB + (size_t)tok * D + grp * 512 + h * 64;
#pragma unroll
        for (int d = 0; d < 64; d += 2) { const float a = acc[d] * rl, c = acc[d + 1] * rl; ss += a * a + c * c; *(unsigned*)(op + d) = pk2(a, c); }
        F.ssq0[(size_t)tok * 16 + hh] = ss;
    }
}


namespace att {
typedef short bf16x8 __attribute__((ext_vector_type(8)));
typedef short s16x4 __attribute__((ext_vector_type(4)));
typedef float f32x16 __attribute__((ext_vector_type(16)));
typedef unsigned u32x4 __attribute__((ext_vector_type(4)));
typedef LAS const char* lds_cptr;
constexpr int NSLOT = 4, SLOTB = 8192;
constexpr int L_K = 0, L_V = 5 * SLOTB, L_WS = 10 * SLOTB, L_OST = L_WS + 8 * 256, L_TAB = L_OST + 8 * 4096, L_END = L_TAB + 12288;
static_assert(L_END <= RING_BYTES, "attention LDS map");
typedef short v4i16_t __attribute__((ext_vector_type(4)));
#define ATT_NEG (-INFINITY)
__device__ __forceinline__ int crow(int r, int hi) { return (r & 3) + 8 * (r >> 2) + 4 * hi; }
__device__ __forceinline__ void glds16(const void* gsrc, unsigned lds_dst) { unsigned keep;
    asm volatile("s_mov_b32 %0, m0\n\ts_mov_b32 m0, %2\n\ts_nop 0\n\tglobal_load_lds_dwordx4 %1, off\n\ts_mov_b32 m0, %0" : "=&s"(keep) : "v"(gsrc), "s"(lds_dst) : "memory"); }
typedef float f32x2_t __attribute__((ext_vector_type(2))); typedef __bf16 bf16x2_t __attribute__((ext_vector_type(2)));
__device__ __forceinline__ unsigned cvtpk_s(float lo, float hi) { f32x2_t v = {lo, hi}; bf16x2_t b = __builtin_convertvector(v, bf16x2_t); return __builtin_bit_cast(unsigned, b); }
#define ATT_WAIT_BAR(N) asm volatile("s_waitcnt vmcnt(" #N ") lgkmcnt(0)\n\ts_barrier" ::: "memory")
#define ATT_SBAR() __builtin_amdgcn_sched_barrier(0)

__device__ __forceinline__ void qkt(f32x16& p0, f32x16& p1, lds_cptr kb, const bf16x8 (&qr)[4]) {
#pragma unroll
    for (int d0 = 0; d0 < 4; ++d0) {
        const bf16x8 b0 = *(LAS const bf16x8*)(kb + d0 * 2048);
        const bf16x8 b1 = *(LAS const bf16x8*)(kb + d0 * 2048 + 512);
        p0 = __builtin_amdgcn_mfma_f32_32x32x16_bf16(b0, qr[d0], p0, 0, 0, 0);
        p1 = __builtin_amdgcn_mfma_f32_32x32x16_bf16(b1, qr[d0], p1, 0, 0, 0); }
}
__device__ __forceinline__ void pv(f32x16 (&o)[2], int vb, bf16x8 pa0, bf16x8 pa1, bf16x8 pa2, bf16x8 pa3) {
#pragma unroll
    for (int d0 = 0; d0 < 2; ++d0) { s16x4 lo[4], hi[4];
#pragma unroll
        for (int ks = 0; ks < 4; ++ks) {
            asm volatile("ds_read_b64_tr_b16 %0,%1 offset:%c2" : "=&v"(lo[ks]) : "v"(vb), "i"(d0 * 4096 + ks * 1024) : "memory");
            asm volatile("ds_read_b64_tr_b16 %0,%1 offset:%c2" : "=&v"(hi[ks]) : "v"(vb), "i"(d0 * 4096 + ks * 1024 + 512) : "memory"); }
        asm volatile("s_waitcnt lgkmcnt(0)" ::: "memory"); ATT_SBAR();
#define ATT_PK(k) (bf16x8){lo[k][0], lo[k][1], lo[k][2], lo[k][3], hi[k][0], hi[k][1], hi[k][2], hi[k][3]}
        o[d0] = __builtin_amdgcn_mfma_f32_32x32x16_bf16(pa0, ATT_PK(0), o[d0], 0, 0, 0);
        o[d0] = __builtin_amdgcn_mfma_f32_32x32x16_bf16(pa1, ATT_PK(1), o[d0], 0, 0, 0);
        o[d0] = __builtin_amdgcn_mfma_f32_32x32x16_bf16(pa2, ATT_PK(2), o[d0], 0, 0, 0);
        o[d0] = __builtin_amdgcn_mfma_f32_32x32x16_bf16(pa3, ATT_PK(3), o[d0], 0, 0, 0);
#undef ATT_PK
    }
}

__device__ __forceinline__ void qkt2(f32x16& p0, f32x16& p1, lds_cptr kpA, lds_cptr kpB, const bf16x8 (&qr)[4]) {
#pragma unroll
    for (int d0 = 0; d0 < 4; ++d0) {
        const bf16x8 b0 = *(LAS const bf16x8*)(kpA + d0 * 2048);
        const bf16x8 b1 = *(LAS const bf16x8*)(kpB + d0 * 2048);
        p0 = __builtin_amdgcn_mfma_f32_32x32x16_bf16(b0, qr[d0], p0, 0, 0, 0);
        p1 = __builtin_amdgcn_mfma_f32_32x32x16_bf16(b1, qr[d0], p1, 0, 0, 0); }
}
__device__ __forceinline__ void pv2(f32x16 (&o)[2], int vbA, int vbB, bf16x8 pa0, bf16x8 pa1, bf16x8 pa2, bf16x8 pa3) {
#pragma unroll
    for (int d0 = 0; d0 < 2; ++d0) { s16x4 lo[4], hi[4];
#pragma unroll
        for (int ks = 0; ks < 4; ++ks) {
            asm volatile("ds_read_b64_tr_b16 %0,%1 offset:%c2" : "=&v"(lo[ks]) : "v"(ks < 2 ? vbA : vbB), "i"(d0 * 4096 + ks * 1024) : "memory");
            asm volatile("ds_read_b64_tr_b16 %0,%1 offset:%c2" : "=&v"(hi[ks]) : "v"(ks < 2 ? vbA : vbB), "i"(d0 * 4096 + ks * 1024 + 512) : "memory"); }
        asm volatile("s_waitcnt lgkmcnt(0)" ::: "memory"); ATT_SBAR();
#define ATT_PK(k) (bf16x8){lo[k][0], lo[k][1], lo[k][2], lo[k][3], hi[k][0], hi[k][1], hi[k][2], hi[k][3]}
        o[d0] = __builtin_amdgcn_mfma_f32_32x32x16_bf16(pa0, ATT_PK(0), o[d0], 0, 0, 0);
        o[d0] = __builtin_amdgcn_mfma_f32_32x32x16_bf16(pa1, ATT_PK(1), o[d0], 0, 0, 0);
        o[d0] = __builtin_amdgcn_mfma_f32_32x32x16_bf16(pa2, ATT_PK(2), o[d0], 0, 0, 0);
        o[d0] = __builtin_amdgcn_mfma_f32_32x32x16_bf16(pa3, ATT_PK(3), o[d0], 0, 0, 0);
#undef ATT_PK
    }
}

struct PolA {
    int b, r, T0, NT, NT_own, jmin, jpmin, per, iq;
    LAS const float* tab; int hi;
    __device__ __forceinline__ void init(int b_, int r_, int Tblk, int wid, int r32, int hi_, LAS const float* tab_) {
        b = b_; r = r_; T0 = 256 * Tblk; jmin = T0 >= 512 ? 0 : (512 - T0) / 64; NT_own = 12 - jmin; jpmin = T0 == 0 ? 1 : 0; per = 5 - jpmin; NT = NT_own;
        iq = T0 + 32 * wid + r32; tab = tab_; hi = hi_; }
    __device__ __forceinline__ void tile(int t, int& rho, int& ik0, int& k) const {
        if (t < NT_own) { k = 0; rho = r; ik0 = T0 - 512 + 64 * (jmin + t); }
        else { const int tp = t - NT_own; k = 1 + tp / per; rho = (r + k) & 3; ik0 = T0 - 64 + 64 * (jpmin + tp % per); } }
    __device__ __forceinline__ long row0(int t) const { int rho, ik0, k; tile(t, rho, ik0, k); return (long)b * SEQ + rho * 1024 + ik0; }
    __device__ __forceinline__ long qrow(int wid, int r32) const { return (long)b * SEQ + r * 1024 + T0 + 32 * wid + r32; }
    __device__ __forceinline__ long orow(int wid, int row) const { return (long)b * SEQ + 4 * (T0 + 32 * wid + row) + r; }
    __device__ __forceinline__ bool active(int t, int wid) const {
        int rho, ik0, k; tile(t, rho, ik0, k); const int dmax = T0 + 32 * wid + 31 - ik0, dmin = T0 + 32 * wid - ik0 - 63; return dmax >= 0 && dmin <= (k == 0 ? 512 : 32); }
    __device__ __forceinline__ void cinit(int t, f32x16& p0, f32x16& p1) const {
        int rho, ik0, k; tile(t, rho, ik0, k);
        LAS const float* tb = tab + (k == 0 ? 0 : 1024 + (k - 1) * 576) + (iq - ik0 - 4 * hi + 256 - 63);
#pragma unroll
        for (int rr = 0; rr < 16; ++rr) { const int c = (rr & 3) + 8 * (rr >> 2); p0[rr] = tb[63 - c]; p1[rr] = tb[31 - c]; }
    }
};
__device__ __forceinline__ void fill_tab_A(LAS float* tab, int h, int r, int tid) {
    const float sl2 = exp2f(-0.5f * (float)(2 * h + 1)) * LOG2E;
    for (int idx = tid; idx < 1024; idx += NWAVES * 64) { const int dl = idx - 256; float v = ATT_NEG;
        if (dl >= 0 && dl <= 512) { const int w = (dl <= 32 ? 1 : 0) + (dl <= 128 ? 1 : 0) + ((dl & 3) == 0 ? 1 : 0);
            if (w > 0) v = (w == 1 ? 0.f : (w == 2 ? 1.f : 1.5849625007211562f)) - sl2 * (float)(4 * dl); }
        tab[idx] = v; }
    for (int idx = tid; idx < 3 * 576; idx += NWAVES * 64) { const int k = 1 + idx / 576, dl = idx % 576 - 256; const int rho = (r + k) & 3; const int dist = 4 * dl + (r - rho);
        tab[1024 + idx] = (dist >= 0 && dist <= 128) ? -sl2 * (float)dist : ATT_NEG; }
}

struct PolB {
    int b, i, NT, dq0, hi; unsigned sel; float sl2, kinf; bool skipok;
    __device__ __forceinline__ long row0(int t) const { return (long)b * SEQ + 64 * t; }
    __device__ __forceinline__ long qrow(int wid, int r32) const { return (long)b * SEQ + 256 * i + 32 * wid + r32; }
    __device__ __forceinline__ long orow(int wid, int row) const { return (long)b * SEQ + 256 * i + 32 * wid + row; }
    __device__ __forceinline__ bool active(int t, int) const { return __any((int)((sel >> (t >> 2)) & 1u)) != 0; }
    __device__ __forceinline__ void cinit(int t, f32x16& p0, f32x16& p1) const {
        const int dqi = 64 * t + dq0;
        float base = sl2 * (float)dqi; if (!((sel >> (t >> 2)) & 1u)) base = ATT_NEG;
        const float base1 = base + 32.0f * sl2;
#pragma unroll
        for (int rr = 0; rr < 16; ++rr) { const int c = (rr & 3) + 8 * (rr >> 2); p0[rr] = base + sl2 * (float)c; p1[rr] = base1 + sl2 * (float)c; }
        if (t >= 4 * i) {
            asm volatile("; causal band tile" ::: "memory");
#pragma unroll
            for (int rr = 0; rr < 16; ++rr) { const int c = (rr & 3) + 8 * (rr >> 2); if (dqi + c > 0) p0[rr] = ATT_NEG; if (dqi + c + 32 > 0) p1[rr] = ATT_NEG; }
        }
    }
    __device__ __forceinline__ void select(const bf16x8 (&qr)[4], LAS const float* km) {
        float qf[32];
#pragma unroll
        for (int d0 = 0; d0 < 4; ++d0)
#pragma unroll
            for (int j = 0; j < 8; ++j) qf[8 * d0 + j] = __uint_as_float((unsigned)(unsigned short)qr[d0][j] << 16);
        int i0 = -1, i1 = -1, i2 = -1; float g0 = ATT_NEG, g1 = ATT_NEG, g2 = ATT_NEG;
        for (int n = 0; n < i; ++n) { float g = 0.f;
#pragma unroll
            for (int d0 = 0; d0 < 4; ++d0) { const f32x4 ka = *(LAS const f32x4*)(km + n * 64 + 16 * d0 + 8 * hi), kb = *(LAS const f32x4*)(km + n * 64 + 16 * d0 + 8 * hi + 4);
                g += (qf[8 * d0 + 0] * ka.x + qf[8 * d0 + 1] * ka.y) + (qf[8 * d0 + 2] * ka.z + qf[8 * d0 + 3] * ka.w) + (qf[8 * d0 + 4] * kb.x + qf[8 * d0 + 5] * kb.y) + (qf[8 * d0 + 6] * kb.z + qf[8 * d0 + 7] * kb.w); }
            g += __shfl_xor(g, 32);
            if (g > g0) { g2 = g1; i2 = i1; g1 = g0; i1 = i0; g0 = g; i0 = n; } else if (g > g1) { g2 = g1; i2 = i1; g1 = g; i1 = n; } else if (g > g2) { g2 = g; i2 = n; } }
        sel = 1u << i; if (i0 >= 0) sel |= 1u << i0; if (i1 >= 0) sel |= 1u << i1; if (i2 >= 0) sel |= 1u << i2;
    }
};

template <class P, bool SELECT>
__device__ __forceinline__ void attn_unit(P& pol, const bf16* Qc, const bf16* Kc, const bf16* Vc, bf16* Oc, float* ssq, int hh, LAS unsigned char* shm, LAS const float* km) {
    int tid = threadIdx.x; asm volatile("" : "+v"(tid)); const int lane = tid & 63, r32 = lane & 31, hi = lane >> 5; const int wid = __builtin_amdgcn_readfirstlane(tid >> 6);
    const unsigned lds0 = (unsigned)(uintptr_t)shm;
    LAS float* wsf = (LAS float*)(shm + L_WS) + wid * 64;
    const int NT = pol.NT;
    const bf16* ksrc = Kc + (long)lane * D + wid * 8;
    const bf16* vsrc = Vc + (long)(16 * (wid & 3) + (lane >> 2)) * D + (wid >> 2) * 32 + (lane & 3) * 8;
    const unsigned kdst = lds0 + L_K + wid * 1024, vdst = lds0 + L_V + wid * 1024;
#define ATT_DMA(t, slot) do { const long r0_ = pol.row0(t); glds16(ksrc + r0_ * D, (unsigned)__builtin_amdgcn_readfirstlane(kdst + (slot))); glds16(vsrc + r0_ * D, (unsigned)__builtin_amdgcn_readfirstlane(vdst + (slot))); } while (0)
    bf16x8 qr[4];
    { const bf16* qp = Qc + pol.qrow(wid, r32) * D + hi * 8;
#pragma unroll
      for (int d0 = 0; d0 < 4; ++d0) qr[d0] = *(const bf16x8*)(qp + d0 * 16); }
    ATT_DMA(0, 0); ATT_DMA(1, SLOTB); ATT_DMA(2, 2 * SLOTB);
    if constexpr (SELECT) pol.select(qr, km);
    f32x16 o[2]; o[0] = f32x16{}; o[1] = f32x16{}; float l_reg = 0.f;
    const lds_cptr kp0 = (lds_cptr)shm + L_K + hi * 1024 + r32 * 16;
    const int vb0 = (int)(lds0 + L_V) + ((lane >> 4) & 1) * 32 + (lane & 3) * 8 + (4 * hi + ((lane & 15) >> 2)) * 64;
#define ATT_EXP(P0, P1) do { _Pragma("unroll") for (int rr = 0; rr < 16; ++rr) { P0[rr] = __builtin_amdgcn_exp2f(P0[rr]); P1[rr] = __builtin_amdgcn_exp2f(P1[rr]); } } while (0)
#define ATT_SOFTMAX_PV(P0, P1, slotoff) do { float sacc = 0.f; \
        _Pragma("unroll") for (int rr = 0; rr < 16; ++rr) { sacc += P0[rr] + P1[rr]; } \
        l_reg += sacc; \
        const u32x4 pw0 = (u32x4){cvtpk_s(P0[0], P0[1]), cvtpk_s(P0[2], P0[3]), cvtpk_s(P0[4], P0[5]), cvtpk_s(P0[6], P0[7])}; \
        const u32x4 pw1 = (u32x4){cvtpk_s(P0[8], P0[9]), cvtpk_s(P0[10], P0[11]), cvtpk_s(P0[12], P0[13]), cvtpk_s(P0[14], P0[15])}; \
        const u32x4 pw2 = (u32x4){cvtpk_s(P1[0], P1[1]), cvtpk_s(P1[2], P1[3]), cvtpk_s(P1[4], P1[5]), cvtpk_s(P1[6], P1[7])}; \
        const u32x4 pw3 = (u32x4){cvtpk_s(P1[8], P1[9]), cvtpk_s(P1[10], P1[11]), cvtpk_s(P1[12], P1[13]), cvtpk_s(P1[14], P1[15])}; \
        ATT_SBAR(); pv(o, vb0 + (slotoff), __builtin_bit_cast(bf16x8, pw0), __builtin_bit_cast(bf16x8, pw1), __builtin_bit_cast(bf16x8, pw2), __builtin_bit_cast(bf16x8, pw3)); ATT_SBAR(); } while (0)
#define ATT_BODY(PC0, PC1, PN0, PN1, t) do { \
        if ((t) + 2 < NT) { ATT_WAIT_BAR(2); } else { ATT_WAIT_BAR(0); } \
        if ((t) + 3 < NT) ATT_DMA((t) + 3, (((t) + 3) & 3) * SLOTB); \
        const bool an_ = ((t) + 1 < NT) && pol.active((t) + 1, wid); const int tn_ = ((t) + 1 < NT) ? (t) + 1 : (t); \
        if (acur || an_) { pol.cinit(tn_, PN0, PN1); ATT_SBAR(); qkt(PN0, PN1, kp0 + (tn_ & 3) * SLOTB, qr); ATT_EXP(PC0, PC1); ATT_SBAR(); ATT_SOFTMAX_PV(PC0, PC1, ((t) & 3) * SLOTB); } \
        else { _Pragma("unroll") for (int rr = 0; rr < 16; ++rr) { PN0[rr] = ATT_NEG; PN1[rr] = ATT_NEG; } } \
        acur = an_; } while (0)
    f32x16 pA0, pA1, pB0, pB1;
    asm volatile("s_waitcnt vmcnt(4) lgkmcnt(0)\n\ts_barrier" ::: "memory");
    bool acur = pol.active(0, wid);
    { pol.cinit(0, pA0, pA1); qkt(pA0, pA1, kp0, qr); }
    for (int t = 0; t < NT; t += 2) {
        ATT_BODY(pA0, pA1, pB0, pB1, t);
        if (t + 1 < NT) ATT_BODY(pB0, pB1, pA0, pA1, t + 1);
    }
    if constexpr (!SELECT) {
        const bool even = !(wid & 1); const int sA = even ? (wid >> 1) : ((wid + 1) >> 1), sB = even ? sA + 1 : sA;
        const lds_cptr kpA = kp0 + sA * SLOTB + (even ? 512 : 0), kpB = kp0 + sB * SLOTB + (even ? 0 : 512);
        const int vbA = vb0 + sA * SLOTB + (even ? 2048 : 0), vbB = vb0 + sB * SLOTB - (even ? 2048 : 0);
        for (int k = 1; k <= 3; ++k) {
            const long rowk = (long)pol.b * SEQ + ((pol.r + k) & 3) * 1024 + pol.T0 - 64;
            asm volatile("s_waitcnt lgkmcnt(0)\n\ts_barrier" ::: "memory");
            for (int j = pol.jpmin; j < 5; ++j) { glds16(ksrc + (rowk + 64 * j) * D, (unsigned)__builtin_amdgcn_readfirstlane(kdst + j * SLOTB)); glds16(vsrc + (rowk + 64 * j) * D, (unsigned)__builtin_amdgcn_readfirstlane(vdst + j * SLOTB)); }
            f32x16 p0, p1;
            { LAS const float* tb = pol.tab + 1024 + (k - 1) * 576 + (r32 + 32 - 4 * hi + 256 - 63);
#pragma unroll
              for (int rr = 0; rr < 16; ++rr) { const int c = (rr & 3) + 8 * (rr >> 2); p0[rr] = tb[63 - c]; p1[rr] = tb[31 - c]; }
              if (pol.T0 == 0 && wid == 0) {
#pragma unroll
                  for (int rr = 0; rr < 16; ++rr) p0[rr] = ATT_NEG; } }
            asm volatile("s_waitcnt vmcnt(0) lgkmcnt(0)\n\ts_barrier" ::: "memory");
            qkt2(p0, p1, kpA, kpB, qr);
            float sacc = 0.f;
#pragma unroll
            for (int rr = 0; rr < 16; ++rr) { p0[rr] = __builtin_amdgcn_exp2f(p0[rr]); p1[rr] = __builtin_amdgcn_exp2f(p1[rr]); sacc += p0[rr] + p1[rr]; }
            l_reg += sacc;
            const u32x4 pw0 = (u32x4){cvtpk_s(p0[0], p0[1]), cvtpk_s(p0[2], p0[3]), cvtpk_s(p0[4], p0[5]), cvtpk_s(p0[6], p0[7])};
            const u32x4 pw1 = (u32x4){cvtpk_s(p0[8], p0[9]), cvtpk_s(p0[10], p0[11]), cvtpk_s(p0[12], p0[13]), cvtpk_s(p0[14], p0[15])};
            const u32x4 pw2 = (u32x4){cvtpk_s(p1[0], p1[1]), cvtpk_s(p1[2], p1[3]), cvtpk_s(p1[4], p1[5]), cvtpk_s(p1[6], p1[7])};
            const u32x4 pw3 = (u32x4){cvtpk_s(p1[8], p1[9]), cvtpk_s(p1[10], p1[11]), cvtpk_s(p1[12], p1[13]), cvtpk_s(p1[14], p1[15])};
            ATT_SBAR();
            pv2(o, vbA, vbB, __builtin_bit_cast(bf16x8, pw0), __builtin_bit_cast(bf16x8, pw1), __builtin_bit_cast(bf16x8, pw2), __builtin_bit_cast(bf16x8, pw3));
        }
    }
#undef ATT_BODY
#undef ATT_SOFTMAX_PV
#undef ATT_EXP
#undef ATT_DMA
    l_reg += __shfl_xor(l_reg, 32);
    if (hi == 0) wsf[32 + r32] = l_reg;
    asm volatile("s_waitcnt lgkmcnt(0)" ::: "memory");
    float rli[16];
#pragma unroll
    for (int rr = 0; rr < 16; ++rr) rli[rr] = 1.0f / wsf[32 + crow(rr, hi)];
    { LAS unsigned short* stg = (LAS unsigned short*)(shm + L_OST) + wid * 2048;
#pragma unroll
      for (int rr = 0; rr < 16; ++rr) { const int orow = crow(rr, hi);
#pragma unroll
          for (int d0 = 0; d0 < 2; ++d0) stg[orow * 64 + d0 * 32 + r32] = (unsigned short)f2bf(o[d0][rr] * rli[rr]); }
      asm volatile("s_waitcnt lgkmcnt(0)" ::: "memory");
#pragma unroll
      for (int i4 = 0; i4 < 4; ++i4) { const int row = i4 * 8 + (lane >> 3), ch = lane & 7; const u32x4 v = *(LAS const u32x4*)(stg + row * 64 + ch * 8);
          const long grow = pol.orow(wid, row);
          *(u32x4*)(Oc + grow * D + ch * 8) = v;
          float ss = 0.f;
#pragma unroll
          for (int e = 0; e < 4; ++e) { const float a = __uint_as_float(v[e] << 16), c = __uint_as_float(v[e] & 0xffff0000u); ss += a * a + c * c; }
          ss += __shfl_xor(ss, 1); ss += __shfl_xor(ss, 2); ss += __shfl_xor(ss, 4);
          if (ch == 0) ssq[grow * 16 + hh] = ss; } }
    asm volatile("s_waitcnt vmcnt(0) lgkmcnt(0)\n\ts_barrier" ::: "memory");
}


constexpr int M_NSLOT = 3;
constexpr int M_K = 0, M_V = M_NSLOT * SLOTB;
static_assert(2 * M_NSLOT * SLOTB <= L_WS, "MoBA rings fit in front of the per-wave scratch");
__device__ __forceinline__ void kload8(bf16x8* kf, lds_cptr kp) {
    kf[0] = *(LAS const bf16x8*)(kp);        kf[1] = *(LAS const bf16x8*)(kp + 512);
    kf[2] = *(LAS const bf16x8*)(kp + 2048); kf[3] = *(LAS const bf16x8*)(kp + 2560);
    kf[4] = *(LAS const bf16x8*)(kp + 4096); kf[5] = *(LAS const bf16x8*)(kp + 4608);
    kf[6] = *(LAS const bf16x8*)(kp + 6144); kf[7] = *(LAS const bf16x8*)(kp + 6656);
}
__device__ __forceinline__ void kload2(bf16x8* kf, lds_cptr kp, int j) { kf[2 * j] = *(LAS const bf16x8*)(kp + j * 2048); kf[2 * j + 1] = *(LAS const bf16x8*)(kp + j * 2048 + 512); }
__device__ __forceinline__ s16x4 vtr(lds_cptr p) { return __builtin_bit_cast(s16x4, __builtin_amdgcn_ds_read_tr16_b64_v4i16((LAS v4i16_t*)p)); }

__device__ __forceinline__ void attn_unit_moba(PolB& pol, const bf16* Qc, const bf16* Kc, const bf16* Vc, bf16* Oc, float* ssq, int hh, LAS unsigned char* shm, LAS const float* km) {
    int tid = threadIdx.x; asm volatile("" : "+v"(tid)); const int lane = tid & 63, r32 = lane & 31, hi = lane >> 5; const int wid = __builtin_amdgcn_readfirstlane(tid >> 6);
    const unsigned lds0 = (unsigned)(uintptr_t)shm;
    LAS float* wsf = (LAS float*)(shm + L_WS) + wid * 64;
    const bf16* ksrc = Kc + ((long)pol.b * SEQ + lane) * D + wid * 8;
    const bf16* vsrc = Vc + ((long)pol.b * SEQ + 16 * (wid & 3) + (lane >> 2)) * D + (wid >> 2) * 32 + (lane & 3) * 8;
    const unsigned kdst = lds0 + M_K + wid * 1024, vdst = lds0 + M_V + wid * 1024;
#define DMA_K(t, slot) glds16(ksrc + (long)((t) + t0) * 64 * D, (unsigned)__builtin_amdgcn_readfirstlane(kdst + (slot)))
#define DMA_V(t, slot) glds16(vsrc + (long)((t) + t0) * 64 * D, (unsigned)__builtin_amdgcn_readfirstlane(vdst + (slot)))
    bf16x8 qr[4];
    { const bf16* qp = Qc + pol.qrow(wid, r32) * D + hi * 8;
#pragma unroll
      for (int d0 = 0; d0 < 4; ++d0) qr[d0] = *(const bf16x8*)(qp + d0 * 16); }
    int t0 = 0;
    if (pol.skipok && pol.i > 1) {
        float n1 = 0.f;
#pragma unroll
        for (int d0 = 0; d0 < 4; ++d0)
#pragma unroll
            for (int j = 0; j < 8; ++j) n1 += fabsf(__uint_as_float((unsigned)(unsigned short)qr[d0][j] << 16));
        n1 += __shfl_xor(n1, 32);
#pragma unroll
        for (int o = 1; o < 32; o <<= 1) n1 = fmaxf(n1, __shfl_xor(n1, o));
        if (lane == 0) wsf[0] = n1;
        asm volatile("s_waitcnt lgkmcnt(0)\n\ts_barrier" ::: "memory");
        float nm = 0.f;
#pragma unroll
        for (int w = 0; w < 8; ++w) nm = fmaxf(nm, ((LAS const float*)(shm + L_WS))[w * 64]);
        const float X = (145.0f + nm * pol.kinf * 1.01f) / pol.sl2;
        int nf = 0; while (nf < pol.i - 1 && (float)(256 * (pol.i - nf) - 255) > X) ++nf;
        t0 = 4 * __builtin_amdgcn_readfirstlane(nf);
    }
    const int NT = pol.NT - t0;
    DMA_K(0, 0); DMA_V(0, 0); DMA_K(1, SLOTB); DMA_K(2, 2 * SLOTB);
    pol.select(qr, km);
    const lds_cptr shm3 = (lds_cptr)shm; const lds_cptr kp0 = shm3 + M_K + hi * 1024 + r32 * 16; const lds_cptr vp0 = shm3 + M_V + ((lane >> 4) & 1) * 32 + (lane & 3) * 8 + (4 * hi + ((lane & 15) >> 2)) * 64;
    f32x16 o[2]; o[0] = f32x16{}; o[1] = f32x16{}; float l_reg = 0.f;
    bf16x8 kf[8];
    f32x16 pA0, pA1, pB0, pB1;
    int sl_prev = 0, sl_cur = 0, sl_next = SLOTB;
#define ROT() do { sl_prev = sl_cur; sl_cur = sl_next; sl_next = (sl_next == (M_NSLOT - 1) * SLOTB) ? 0 : sl_next + SLOTB; } while (0)
    const float sl2 = pol.sl2, s8 = 8.0f * pol.sl2; const int dq0 = pol.dq0; const unsigned sel = pol.sel; const int i4 = 4 * pol.i - t0;
#define CBASE(tt) const int dqi_ = 64 * ((tt) + t0) + dq0; float cb0_ = sl2 * (float)dqi_; if (!((sel >> (((tt) + t0) >> 2)) & 1u)) cb0_ = ATT_NEG; float cb1_ = cb0_ + 32.0f * sl2
#define CEL(X, B, cb, off, BAND) do { float v0_ = (cb), v1_ = v0_ + sl2, v2_ = v1_ + sl2, v3_ = v2_ + sl2; (cb) = v0_ + s8; \
        if (BAND) { const int c_ = 8 * ((B) >> 2) + (off); if (dqi_ + c_ > 0) v0_ = ATT_NEG; if (dqi_ + c_ + 1 > 0) v1_ = ATT_NEG; if (dqi_ + c_ + 2 > 0) v2_ = ATT_NEG; if (dqi_ + c_ + 3 > 0) v3_ = ATT_NEG; } \
        X[(B)] = v0_; X[(B) + 1] = v1_; X[(B) + 2] = v2_; X[(B) + 3] = v3_; } while (0)
    asm volatile("s_waitcnt vmcnt(3) lgkmcnt(0)\n\ts_barrier" ::: "memory");
    { CBASE(0); const bool band0 = (i4 == 0);
#pragma unroll
      for (int b4 = 0; b4 < 16; b4 += 4) { if (band0) { CEL(pA0, b4, cb0_, 0, true); CEL(pA1, b4, cb1_, 32, true); } else { CEL(pA0, b4, cb0_, 0, false); CEL(pA1, b4, cb1_, 32, false); } }
      qkt(pA0, pA1, kp0, qr);
#pragma unroll
      for (int rr = 0; rr < 16; ++rr) { pA0[rr] = __builtin_amdgcn_exp2f(pA0[rr]); pA1[rr] = __builtin_amdgcn_exp2f(pA1[rr]); } }
    { CBASE(1); const bool band1 = (1 >= i4);
#pragma unroll
      for (int b4 = 0; b4 < 16; b4 += 4) { if (band1) { CEL(pB0, b4, cb0_, 0, true); CEL(pB1, b4, cb1_, 32, true); } else { CEL(pB0, b4, cb0_, 0, false); CEL(pB1, b4, cb1_, 32, false); } } }
    asm volatile("s_waitcnt vmcnt(0) lgkmcnt(0)\n\ts_barrier" ::: "memory");
    DMA_K(3, 0); DMA_V(1, SLOTB);
    ROT();
    kload8(kf, kp0 + sl_cur);
    asm volatile("s_waitcnt vmcnt(2) lgkmcnt(0)\n\ts_barrier" ::: "memory");
    s16x4 vlo[8], vhi[8]; u32x4 pw0, pw1, pw2, pw3;
#define PKW(P, B) cvtpk_s(P[B], P[B + 1])
#define PAF(k) __builtin_bit_cast(bf16x8, pw##k)
#define VFR(i) (bf16x8){vlo[i][0], vlo[i][1], vlo[i][2], vlo[i][3], vhi[i][0], vhi[i][1], vhi[i][2], vhi[i][3]}
#define PIN(x) asm volatile("" : "+v"(x))
#define GAPA(MF, A0, A1, A2, A3, W0, W1, PW) do { MF; sacc += A0; sacc += A1; sacc += A2; sacc += A3; PIN(sacc); W0; W1; PIN(PW); ATT_SBAR(); } while (0)
#define EX(v) __builtin_amdgcn_exp2f(v)
#define GAPB(MF, X, B, Y, CB_, OFF_, CI, BAND) do { MF; X[B] = EX(X[B]); X[B + 1] = EX(X[B + 1]); X[B + 2] = EX(X[B + 2]); X[B + 3] = EX(X[B + 3]); PIN(X); if (CI) { CEL(Y, B, CB_, OFF_, BAND); PIN(Y); } ATT_SBAR(); } while (0)
#define VRD(i) do { vlo[i] = vtr(vp_ + (((i) >> 2) * 4096 + ((i) & 3) * 1024)); vhi[i] = vtr(vp_ + (((i) >> 2) * 4096 + ((i) & 3) * 1024 + 512)); } while (0)
#define KRD(G, j) do { if (G) { kload2(kf, kp0 + sl_next, j); ATT_SBAR(); } } while (0)
#define STEP(C0, C1, P0, P1, t, GK, GV, GL, CI, BAND) do { ATT_SBAR(); \
    const lds_cptr vp_ = vp0 + sl_prev; CBASE((t) + 1); \
    VRD(0); ATT_SBAR(); float sacc = (P0[0] + P0[1]); \
    GAPA(C0 = __builtin_amdgcn_mfma_f32_32x32x16_bf16(kf[0], qr[0], C0, 0, 0, 0), P0[2], P0[3], P0[4], P0[5],     pw0[0] = PKW(P0, 0), pw0[1] = PKW(P0, 2), pw0); \
    VRD(4); ATT_SBAR(); GAPA(C1 = __builtin_amdgcn_mfma_f32_32x32x16_bf16(kf[1], qr[0], C1, 0, 0, 0), P0[6], P0[7], P0[8], P0[9],     pw0[2] = PKW(P0, 4), pw0[3] = PKW(P0, 6), pw0); \
    VRD(1); ATT_SBAR(); GAPA(C0 = __builtin_amdgcn_mfma_f32_32x32x16_bf16(kf[2], qr[1], C0, 0, 0, 0), P0[10], P0[11], P0[12], P0[13], pw1[0] = PKW(P0, 8), pw1[1] = PKW(P0, 10), pw1); \
    VRD(5); ATT_SBAR(); GAPA(C1 = __builtin_amdgcn_mfma_f32_32x32x16_bf16(kf[3], qr[1], C1, 0, 0, 0), P0[14], P0[15], P1[0], P1[1],   pw1[2] = PKW(P0, 12), pw1[3] = PKW(P0, 14), pw1); \
    VRD(2); ATT_SBAR(); GAPA(C0 = __builtin_amdgcn_mfma_f32_32x32x16_bf16(kf[4], qr[2], C0, 0, 0, 0), P1[2], P1[3], P1[4], P1[5],     pw2[0] = PKW(P1, 0), pw2[1] = PKW(P1, 2), pw2); \
    VRD(6); ATT_SBAR(); GAPA(C1 = __builtin_amdgcn_mfma_f32_32x32x16_bf16(kf[5], qr[2], C1, 0, 0, 0), P1[6], P1[7], P1[8], P1[9],     pw2[2] = PKW(P1, 4), pw2[3] = PKW(P1, 6), pw2); \
    VRD(3); ATT_SBAR(); GAPA(C0 = __builtin_amdgcn_mfma_f32_32x32x16_bf16(kf[6], qr[3], C0, 0, 0, 0), P1[10], P1[11], P1[12], P1[13], pw3[0] = PKW(P1, 8), pw3[1] = PKW(P1, 10), pw3); \
    VRD(7); ATT_SBAR(); GAPA(C1 = __builtin_amdgcn_mfma_f32_32x32x16_bf16(kf[7], qr[3], C1, 0, 0, 0), P1[14], P1[15], 0.f, 0.f,       pw3[2] = PKW(P1, 12), pw3[3] = PKW(P1, 14), pw3); \
    l_reg += sacc; \
    if (GK) { DMA_K((t) + 3, sl_cur); } if (GV) { DMA_V((t) + 1, sl_next); } \
    ATT_SBAR(); \
    GAPB(o[0] = __builtin_amdgcn_mfma_f32_32x32x16_bf16(PAF(0), VFR(0), o[0], 0, 0, 0), C0, 0, P0, cb0_, 0, CI, BAND); \
    GAPB(o[1] = __builtin_amdgcn_mfma_f32_32x32x16_bf16(PAF(0), VFR(4), o[1], 0, 0, 0), C0, 4, P0, cb0_, 0, CI, BAND); \
    KRD(GL, 0); GAPB(o[0] = __builtin_amdgcn_mfma_f32_32x32x16_bf16(PAF(1), VFR(1), o[0], 0, 0, 0), C0, 8, P0, cb0_, 0, CI, BAND); \
    KRD(GL, 1); GAPB(o[1] = __builtin_amdgcn_mfma_f32_32x32x16_bf16(PAF(1), VFR(5), o[1], 0, 0, 0), C0, 12, P0, cb0_, 0, CI, BAND); \
    KRD(GL, 2); GAPB(o[0] = __builtin_amdgcn_mfma_f32_32x32x16_bf16(PAF(2), VFR(2), o[0], 0, 0, 0), C1, 0, P1, cb1_, 32, CI, BAND); \
    KRD(GL, 3); GAPB(o[1] = __builtin_amdgcn_mfma_f32_32x32x16_bf16(PAF(2), VFR(6), o[1], 0, 0, 0), C1, 4, P1, cb1_, 32, CI, BAND); \
    GAPB(o[0] = __builtin_amdgcn_mfma_f32_32x32x16_bf16(PAF(3), VFR(3), o[0], 0, 0, 0), C1, 8, P1, cb1_, 32, CI, BAND); \
    GAPB(o[1] = __builtin_amdgcn_mfma_f32_32x32x16_bf16(PAF(3), VFR(7), o[1], 0, 0, 0), C1, 12, P1, cb1_, 32, CI, BAND); \
    } while (0)
#define M_WAIT_BAR(N) asm volatile("s_waitcnt vmcnt(" #N ") lgkmcnt(0)\n\ts_barrier" ::: "memory")
    int t = 1;
    for (; t + 5 < NT; t += 2) {
        STEP(pB0, pB1, pA0, pA1, t, true, true, true, true, false);     M_WAIT_BAR(2); ROT();
        STEP(pA0, pA1, pB0, pB1, t + 1, true, true, true, true, false); M_WAIT_BAR(2); ROT();
    }
#define ENDW(tt) do { if ((tt) + 3 < NT) { M_WAIT_BAR(2); } else if ((tt) + 2 < NT) { M_WAIT_BAR(1); } else { M_WAIT_BAR(0); } } while (0)
    for (; t + 1 < NT; t += 2) {
        STEP(pB0, pB1, pA0, pA1, t, (t + 3 < NT), (t + 1 < NT), (t + 1 < NT), true, true);       ENDW(t);     ROT();
        STEP(pA0, pA1, pB0, pB1, t + 1, (t + 4 < NT), (t + 2 < NT), (t + 2 < NT), (t + 2 < NT), true); ENDW(t + 1); ROT();
    }
    STEP(pB0, pB1, pA0, pA1, NT - 1, false, false, false, false, false);
    { float sacc = pB0[0] + pB0[1];
#pragma unroll
      for (int rr = 2; rr < 16; ++rr) sacc += pB0[rr];
#pragma unroll
      for (int rr = 0; rr < 16; ++rr) sacc += pB1[rr];
      l_reg += sacc;
      pw0 = (u32x4){PKW(pB0, 0), PKW(pB0, 2), PKW(pB0, 4), PKW(pB0, 6)}; pw1 = (u32x4){PKW(pB0, 8), PKW(pB0, 10), PKW(pB0, 12), PKW(pB0, 14)};
      pw2 = (u32x4){PKW(pB1, 0), PKW(pB1, 2), PKW(pB1, 4), PKW(pB1, 6)}; pw3 = (u32x4){PKW(pB1, 8), PKW(pB1, 10), PKW(pB1, 12), PKW(pB1, 14)};
      ATT_SBAR(); pv(o, (int)(lds0 + M_V) + ((lane >> 4) & 1) * 32 + (lane & 3) * 8 + (4 * hi + ((lane & 15) >> 2)) * 64 + sl_cur, PAF(0), PAF(1), PAF(2), PAF(3)); }
#undef PKW
#undef PAF
#undef VFR
#undef PIN
#undef GAPA
#undef GAPB
#undef EX
#undef VRD
#undef KRD
#undef STEP
#undef ENDW
#undef M_WAIT_BAR
#undef CBASE
#undef CEL
#undef ROT
#undef DMA_K
#undef DMA_V
    l_reg += __shfl_xor(l_reg, 32);
    if (hi == 0) wsf[32 + r32] = l_reg;
    asm volatile("s_waitcnt lgkmcnt(0)" ::: "memory");
    float rli[16];
#pragma unroll
    for (int rr = 0; rr < 16; ++rr) rli[rr] = 1.0f / wsf[32 + crow(rr, hi)];
    { LAS unsigned short* stg = (LAS unsigned short*)(shm + L_OST) + wid * 2048;
#pragma unroll
      for (int rr = 0; rr < 16; ++rr) { const int orow = crow(rr, hi);
#pragma unroll
          for (int d0 = 0; d0 < 2; ++d0) stg[orow * 64 + d0 * 32 + r32] = (unsigned short)f2bf(o[d0][rr] * rli[rr]); }
      asm volatile("s_waitcnt lgkmcnt(0)" ::: "memory");
#pragma unroll
      for (int i4_ = 0; i4_ < 4; ++i4_) { const int row = i4_ * 8 + (lane >> 3), ch = lane & 7; const u32x4 v = *(LAS const u32x4*)(stg + row * 64 + ch * 8);
          const long grow = pol.orow(wid, row);
          *(u32x4*)(Oc + grow * D + ch * 8) = v;
          float ss = 0.f;
#pragma unroll
          for (int e = 0; e < 4; ++e) { const float a = __uint_as_float(v[e] << 16), c = __uint_as_float(v[e] & 0xffff0000u); ss += a * a + c * c; }
          ss += __shfl_xor(ss, 1); ss += __shfl_xor(ss, 2); ss += __shfl_xor(ss, 4);
          if (ch == 0) ssq[grow * 16 + hh] = ss; } }
    asm volatile("s_waitcnt vmcnt(0) lgkmcnt(0)\n\ts_barrier" ::: "memory");
}

__device__ __forceinline__ void attn_phase(Frame& F) {
    LAS unsigned char* shm = F.lds + RING_OFF;
    LAS float* tab = (LAS float*)(shm + L_TAB);
    int tid_a = threadIdx.x; asm volatile("" : "+v"(tid_a)); const int r32 = tid_a & 31, hi = (tid_a >> 5) & 1;
    for (int su = F.vcu; su < 256; su += F.G) {
        const int b = su >> 5, h = (su >> 2) & 7, r = su & 3;
        fill_tab_A(tab, h, r, F.tid);
        asm volatile("s_waitcnt lgkmcnt(0)\n\ts_barrier" ::: "memory");
        for (int Tb = 0; Tb < 4; ++Tb) { PolA pol; pol.init(b, r, Tb, F.wave, r32, hi, tab);
            attn_unit<PolA, false>(pol, F.QB + h * 64, F.KB + h * 64, F.VB + h * 64, F.OB + h * 64, F.ssq0, h, shm, nullptr); }
    }
    static const unsigned char moba_tab[128] = {127, 42, 98, 1, 111, 41, 82, 112, 95, 40, 66, 96, 79, 39, 50, 80, 126, 46, 21, 64, 110, 45, 20, 48, 94, 44, 19, 32, 78, 43, 114, 11, 125, 85, 31, 10, 109, 69, 30, 9, 93, 53, 29, 8, 77, 47, 28, 7, 124, 70, 27, 6, 108, 54, 26, 5, 92, 117, 38, 16, 76, 101, 37, 0, 123, 55, 25, 4, 107, 118, 116, 3, 91, 102, 100, 2, 75, 86, 84, 113, 122, 119, 68, 97, 106, 103, 52, 81, 90, 87, 36, 65, 74, 71, 115, 34, 121, 59, 24, 49, 105, 58, 23, 33, 89, 57, 22, 17, 73, 120, 99, 18, 63, 104, 83, 15, 62, 88, 67, 14, 61, 72, 51, 13, 60, 56, 35, 12};
    for (int su = F.vcu; su < 256; su += F.G) {
        const int b = su >> 5, c = su & 31;
        for (int u4 = 0; u4 < 4; ++u4) { const int hv = moba_tab[c * 4 + u4]; const int h = hv >> 4, i = hv & 15;
            for (int idx = F.tid; idx < 1024; idx += NWAVES * 64) { const int n = idx >> 6, d = idx & 63; const float* kp = F.kpart + (size_t)((b * 16 + n) * 2) * 512 + h * 64 + d; tab[idx] = kp[0] + kp[512]; }
            asm volatile("s_waitcnt vmcnt(0) lgkmcnt(0)\n\ts_barrier" ::: "memory");
            const float kinf_b = __uint_as_float(__builtin_amdgcn_readfirstlane(__hip_atomic_load(F.ctl + CW_KMAX + b * 16 + 8 + h, __ATOMIC_RELAXED, __HIP_MEMORY_SCOPE_AGENT)));
            PolB pol; pol.b = b; pol.i = i; pol.NT = 4 * (i + 1); pol.hi = hi; pol.dq0 = 4 * hi - (256 * i + 32 * F.wave + r32); pol.sl2 = exp2f(-(float)(h + 1)) * LOG2E; pol.sel = 0u; pol.kinf = kinf_b; pol.skipok = (h <= 3);
            attn_unit_moba(pol, F.QB + 512 + h * 64, F.KB + 512 + h * 64, F.VB + 512 + h * 64, F.OB + 512 + h * 64, F.ssq0, 8 + h, shm, tab); }
    }
}
#undef ATT_WAIT_BAR
#undef ATT_SBAR
}

__device__ __forceinline__ void final_norm(Frame& F) {
    int tid_f = threadIdx.x; asm volatile("" : "+v"(tid_f)); const int lane_f = tid_f & 63;
    const int gw = F.vcu * NWAVES + F.wave, NGW = F.G * NWAVES;
    f32x4 g[2][2];
#pragma unroll
    for (int j = 0; j < 2; ++j) { g[j][0] = *(const GAS f32x4*)(F.g_final + 512 * j + 8 * lane_f); g[j][1] = *(const GAS f32x4*)(F.g_final + 512 * j + 8 * lane_f + 4); }
    for (int m = gw; m < M; m += NGW) {
        const GAS f32x4* sp = (const GAS f32x4*)(F.ssq3 + (size_t)m * 16);
        const f32x4 a = sp[0], b = sp[1], c = sp[2], d = sp[3];
        const float s = ((a.x + a.y) + (a.z + a.w)) + ((b.x + b.y) + (b.z + b.w)) + ((c.x + c.y) + (c.z + c.w)) + ((d.x + d.y) + (d.z + d.w));
        const float rstd = 1.f / sqrtf(s * (1.f / D) + EPS);
#pragma unroll
        for (int j = 0; j < 2; ++j) { const v4u w = *(const GAS v4u*)(F.XN + (size_t)m * D + 512 * j + 8 * lane_f);
            f32x4 o0 = (f32x4){__uint_as_float(w.x << 16), __uint_as_float(w.x & 0xffff0000u), __uint_as_float(w.y << 16), __uint_as_float(w.y & 0xffff0000u)};
            f32x4 o1 = (f32x4){__uint_as_float(w.z << 16), __uint_as_float(w.z & 0xffff0000u), __uint_as_float(w.w << 16), __uint_as_float(w.w & 0xffff0000u)};
            GAS f32x4* op = (GAS f32x4*)(F.out + (size_t)m * D + 512 * j + 8 * lane_f);
            op[0] = o0 * rstd * g[j][0]; op[1] = o1 * rstd * g[j][1]; }
    }
}

struct Args { const float* in[15]; float* out; unsigned char* ws; int ph_lo, ph_hi, li, pad; };
__global__ void __launch_bounds__(NWAVES * 64, 2) mk_fwd(Args args) {
    extern __shared__ __attribute__((aligned(16))) unsigned char lds[];
    Frame F;
    F.lds = (LAS unsigned char*)lds;
    F.MISC = (volatile LAS unsigned*)(F.lds + MISC_OFF);
    F.tid = threadIdx.x; F.lane = F.tid & 63; F.wave = __builtin_amdgcn_readfirstlane(F.tid >> 6);
    F.G = gridDim.x; { const int bx = blockIdx.x; F.vcu = (F.G % 8 == 0) ? (bx % 8) * (F.G / 8) + bx / 8 : bx; }
    unsigned char* ws = args.ws;
    F.ctl = (gu32*)(ws + WS_CTL);
    F.x = args.in[0]; F.p = args.in[1]; F.g_attn = args.in[2]; F.w_in = args.in[3]; F.g_out_a = args.in[4]; F.g_out_b = args.in[5]; F.w_out = args.in[6]; F.g_mlp = args.in[7];
    F.w_up = args.in[8]; F.w_down = args.in[9]; F.g_ple = args.in[10]; F.w_gate = args.in[11]; F.b_gate = args.in[12]; F.w_proj = args.in[13]; F.g_final = args.in[14]; F.out = args.out;
    F.Wqkv_t = (bf16*)(ws + WS_WQKV); F.Wo_t = (bf16*)(ws + WS_WO); F.Wup_t = (bf16*)(ws + WS_WUP); F.Wdn_t = (bf16*)(ws + WS_WDN); F.Wg_t = (bf16*)(ws + WS_WG); F.Wp_t = (bf16*)(ws + WS_WP);
    F.XN = (bf16*)(ws + WS_XN); F.QB = (bf16*)(ws + WS_Q); F.KB = (bf16*)(ws + WS_K); F.VB = (bf16*)(ws + WS_V); F.OB = (bf16*)(ws + WS_O); F.UB = (bf16*)(ws + WS_U); F.PB = (bf16*)(ws + WS_PB); F.PP = (bf16*)(ws + WS_PP);
    F.ssq0 = (float*)(ws + WS_SSQ0); F.ssq1 = (float*)(ws + WS_SSQ1); F.ssq2 = (float*)(ws + WS_SSQ2); F.ssq3 = (float*)(ws + WS_SSQ3); F.kpart = (float*)(ws + WS_KPART); F.invr0 = (float*)(ws + WS_INVR);
    for (int u = F.tid; u < (LDS_BYTES - LDSCTL_OFF) / 4; u += NWAVES * 64) ((LAS unsigned*)(F.lds + LDSCTL_OFF))[u] = 0u;
    __syncthreads();
    XcdBarrier bar; bar.bar = (unsigned*)(F.ctl + CW_BAR); bar.x = 0; bar.st = nullptr;
    if (N_LAUNCHES == 1) bar = xcd_barrier_post((unsigned*)(F.ctl + CW_BAR), F.MISC + 8);
    PG8_LAS float* tab = (PG8_LAS float*)(F.lds + TAB_OFF);
    const int lo = args.ph_lo, hi = args.ph_hi;
#define IN(k) (lo <= (k) && (k) < hi)
#define SEAM(k) do { if (IN(k) && IN((k) + 1)) xcd_barrier(bar); } while (0)

    if (IN(0)) { p0_prologue(F); SEAM(0); }
    if (IN(1)) {
        { pg8::Gemm g{F.XN, F.Wqkv_t, M, NQKV, D}; pg8::StaticOrder S; S.init(M, NQKV, F.G, (int)blockIdx.x);
          pg8::EpiQKV E{F.QB, (size_t)(WS_K - WS_Q) / 2, F.kpart, C2, (unsigned*)(F.ctl + CW_KMAX)};
          pg8::gemm_phase<pg8::EpiQKV, pg8::StaticOrder, true, true>(F.lds + RING_OFF, tab, g, S, E); }
        { pg8::Gemm g{F.PB, F.Wp_t, M, D, PLE}; pg8::StaticOrder S; S.init(M, D, F.G, (int)blockIdx.x);
          pg8::EpiBf16Plain E{F.PP, D};
          pg8::gemm_phase<pg8::EpiBf16Plain, pg8::StaticOrder, true, true>(F.lds + RING_OFF, tab, g, S, E); }
        SEAM(1);
    }
#if defined(ATT_NAIVE)
    if (IN(2)) { attn_naive(F); SEAM(2); }
#else
    if (IN(2)) { att::attn_phase(F); SEAM(2); }
#endif
    if (IN(3)) {
        pg8::Gemm g{F.OB, F.Wo_t, M, D, D}; pg8::StaticOrder S; S.init(M, D, F.G, (int)blockIdx.x);
        pg8::EpiRes<1> E{F.invr0, F.XN, F.ssq1, F.ssq0};
        pg8::gemm_phase<pg8::EpiRes<1>, pg8::StaticOrder, true, true>(F.lds + RING_OFF, tab, g, S, E);
        SEAM(3);
    }
    if (IN(4)) {
        pg8::Gemm g{F.XN, F.Wup_t, M, FF, D}; pg8::StaticOrder S; S.init(M, FF, F.G, (int)blockIdx.x);
        pg8::EpiUp E{F.UB, FF, F.ssq1};
        pg8::gemm_phase<pg8::EpiUp, pg8::StaticOrder, true, true>(F.lds + RING_OFF, tab, g, S, E);
        SEAM(4);
    }
    if (IN(5)) {
        pg8::Gemm g{F.UB, F.Wdn_t, M, D, FF}; pg8::StaticOrder S; S.init(M, D, F.G, (int)blockIdx.x);
        pg8::EpiRes<0> E{nullptr, F.XN, F.ssq2, nullptr};
        pg8::gemm_phase<pg8::EpiRes<0>, pg8::StaticOrder, true, true>(F.lds + RING_OFF, tab, g, S, E);
        SEAM(5);
    }
    if (IN(6)) {
        pg8::Gemm g{F.XN, F.Wg_t, M, D, D}; pg8::StaticOrder S; S.init(M, D, F.G, (int)blockIdx.x);
        pg8::EpiGate E{F.XN, F.PP, F.b_gate, F.ssq3, F.ssq2};
        pg8::gemm_phase<pg8::EpiGate, pg8::StaticOrder, true, true>(F.lds + RING_OFF, tab, g, S, E);
        SEAM(6);
    }
    if (IN(7)) { final_norm(F); }
#undef IN
#undef SEAM
}

extern "C" void kernel_launch(void* const* d_in, const int* in_sizes, int n_in, void* d_out, int out_size, void* d_ws, size_t ws_size, hipStream_t stream) {
    static int grid = 0;
    if (grid == 0) {
        if (n_in != 15 || in_sizes[0] != M * D || out_size != M * D || ws_size < WS_END) { fprintf(stderr, "kernel_launch: unexpected shapes (n_in %d, in0 %d, out %d, ws %zu); nothing launched\n", n_in, n_in > 0 ? in_sizes[0] : -1, out_size, ws_size); grid = -1; return; }
        int dev = 0, cus = 0, per_cu = 0;
        if (hipGetDevice(&dev) != hipSuccess || hipDeviceGetAttribute(&cus, hipDeviceAttributeMultiprocessorCount, dev) != hipSuccess) { grid = -1; return; }
        if (hipFuncSetAttribute((const void*)mk_fwd, hipFuncAttributeMaxDynamicSharedMemorySize, LDS_BYTES) != hipSuccess) { fprintf(stderr, "kernel_launch: hipFuncSetAttribute failed\n"); grid = -1; return; }
        if (hipOccupancyMaxActiveBlocksPerMultiprocessor(&per_cu, (const void*)mk_fwd, NWAVES * 64, LDS_BYTES) != hipSuccess || per_cu < 1) { fprintf(stderr, "kernel_launch: occupancy query reports %d blocks per CU\n", per_cu); }
        (void)hipGetLastError();
        grid = cus;
    }
    if (grid < 0) return;
    if (hipMemsetAsync((char*)d_ws + WS_CTL, 0, CTL_ZERO_BYTES, stream) != hipSuccess) { fprintf(stderr, "kernel_launch: hipMemsetAsync failed\n"); return; }
    Args a{};
    for (int i = 0; i < 15; ++i) a.in[i] = (const float*)d_in[i];
    a.out = (float*)d_out; a.ws = (unsigned char*)d_ws;
    for (int li = 0; li < N_LAUNCHES; ++li) {
        a.ph_lo = (N_LAUNCHES == 1) ? 0 : li; a.ph_hi = (N_LAUNCHES == 1) ? NPHASE : li + 1; a.li = li;
        hipLaunchKernelGGL(mk_fwd, dim3(grid), dim3(NWAVES * 64), LDS_BYTES, stream, a);
        const hipError_t le = hipPeekAtLastError();
        if (le != hipSuccess) { fprintf(stderr, "kernel_launch: launch %d failed: %s\n", li, hipGetErrorName(le)); break; }
    }
}
```
